# Optimizing an MI355X kernel written in HIP

```python
import math
import jax, jax.numpy as jnp
from jax import lax
import numpy as np

D_MODEL = 1024
BATCH = 8
SEQ = 4096
DEPTH = 2

MIX_WIDTH = 2 * D_MODEL
GROUP_WIDTH = MIX_WIDTH // 4
MEM_LEN = 256
EPS = 1e-6

MOBA_HEADS = 8
MOBA_HEAD_DIM = GROUP_WIDTH // MOBA_HEADS
MOBA_BLOCK = 256
MOBA_TOPK = 3
MOBA_Q_CHUNK = 16

NSA_HEADS = 8
NSA_KV_HEADS = 2
NSA_HEAD_DIM = GROUP_WIDTH // NSA_HEADS
NSA_KV_WIDTH = NSA_KV_HEADS * NSA_HEAD_DIM
NSA_CMP_LEN = 32
NSA_CMP_STRIDE = 16
NSA_CMP_HIDDEN = 128
NSA_SLC_BLOCK = 64
NSA_SLC_TOPK = 16
NSA_WINDOW = 512
NSA_Q_CHUNK = 64

RET_HEADS = 4
RET_KEY_DIM = 64
RET_VAL_DIM = GROUP_WIDTH // RET_HEADS
RET_QK_WIDTH = RET_HEADS * RET_KEY_DIM
RET_CHUNK = 128

MEM_HEADS = 4
MEM_HEAD_DIM = GROUP_WIDTH // MEM_HEADS

IN_SPLITS = (
    GROUP_WIDTH, GROUP_WIDTH, GROUP_WIDTH,
    GROUP_WIDTH,
    NSA_KV_WIDTH, NSA_KV_WIDTH,
    NSA_KV_WIDTH, NSA_KV_WIDTH,
    NSA_KV_WIDTH, NSA_KV_WIDTH,
    3 * NSA_HEADS,
    RET_QK_WIDTH, RET_QK_WIDTH, GROUP_WIDTH,
    GROUP_WIDTH,
    MIX_WIDTH,
)
IN_COLS = sum(IN_SPLITS)

kernel_name = "hybrid_moba_nsa_retention_block"


def rms_norm(x, g):
    xf = x.astype(jnp.float32)
    y = xf * lax.rsqrt(jnp.mean(xf * xf, axis=-1, keepdims=True) + EPS)
    return (y * g.astype(jnp.float32)).astype(x.dtype)


def split_cols(t, sizes):
    offs = np.cumsum(np.array(sizes))[:-1].tolist()
    return jnp.split(t, offs, axis=-1)


def masked_softmax(s, mask):
    s = jnp.where(mask, s.astype(jnp.float32), -jnp.inf)
    m = jnp.max(s, axis=-1, keepdims=True)
    m = jnp.where(jnp.isfinite(m), m, 0.0)
    p = jnp.exp(s - m)
    den = jnp.sum(p, axis=-1, keepdims=True)
    return p / jnp.where(den > 0, den, 1.0)


def moba_attention(q, k, v):
    B, S, H, Dh = q.shape
    nb = -(-S // MOBA_BLOCK)
    pad = nb * MOBA_BLOCK - S
    top = min(MOBA_TOPK, nb)
    qc_len = MOBA_Q_CHUNK
    nc = S // qc_len
    scale = Dh ** -0.5
    kp = jnp.pad(k, ((0, 0), (0, pad), (0, 0), (0, 0)))
    vp = jnp.pad(v, ((0, 0), (0, pad), (0, 0), (0, 0)))
    kb = kp.reshape(B, nb, MOBA_BLOCK, H, Dh).transpose(0, 3, 1, 2, 4)
    vb = vp.reshape(B, nb, MOBA_BLOCK, H, Dh).transpose(0, 3, 1, 2, 4)
    k_mean = jnp.mean(kb.astype(jnp.float32), axis=3)
    own = jnp.arange(S) // MOBA_BLOCK
    past = jnp.arange(nb)[None, :] < own[:, None]
    gate = jnp.einsum('bshd,bhnd->bhsn', q.astype(jnp.float32), k_mean)
    _, sel = lax.top_k(jnp.where(past, gate, -jnp.inf), top)
    valid = sel < own[None, None, :, None]

    q_ch = q.reshape(B, nc, qc_len, H, Dh).transpose(1, 0, 2, 3, 4)
    sel_ch = sel.reshape(B, H, nc, qc_len, top).transpose(2, 0, 1, 3, 4)
    val_ch = valid.reshape(B, H, nc, qc_len, top).transpose(2, 0, 1, 3, 4)
    starts = jnp.arange(nc, dtype=jnp.int32) * qc_len
    bi = jnp.arange(B)[:, None, None, None]
    hi = jnp.arange(H)[None, :, None, None]

    def chunk(args):
        qc, sc, vc_ok, t0 = args
        tq = t0 + jnp.arange(qc_len)
        ks = kb[bi, hi, sc]
        vs = vb[bi, hi, sc]
        s_sel = jnp.einsum('bqhd,bhqjkd->bhqjk', qc, ks) * scale
        m_sel = jnp.broadcast_to(vc_ok[..., None], s_sel.shape)
        n0 = (t0 // MOBA_BLOCK) * MOBA_BLOCK
        ko = lax.dynamic_slice_in_dim(kp, n0, MOBA_BLOCK, axis=1)
        vo = lax.dynamic_slice_in_dim(vp, n0, MOBA_BLOCK, axis=1)
        s_own = jnp.einsum('bqhd,bkhd->bhqk', qc, ko) * scale
        m_own = (n0 + jnp.arange(MOBA_BLOCK))[None, :] <= tq[:, None]
        n_sel = top * MOBA_BLOCK
        s = jnp.concatenate([s_sel.reshape(B, H, qc_len, n_sel), s_own], axis=-1)
        m = jnp.concatenate([m_sel.reshape(B, H, qc_len, n_sel),
                             jnp.broadcast_to(m_own, (B, H, qc_len, MOBA_BLOCK))], axis=-1)
        p = masked_softmax(s, m).astype(v.dtype)
        p_sel = p[..., :n_sel].reshape(B, H, qc_len, top, MOBA_BLOCK)
        p_own = p[..., n_sel:]
        return (jnp.einsum('bhqjk,bhqjkd->bqhd', p_sel, vs)
                + jnp.einsum('bhqk,bkhd->bqhd', p_own, vo))

    o = lax.map(chunk, (q_ch, sel_ch, val_ch, starts))
    return o.transpose(1, 0, 2, 3, 4).reshape(B, S, H * Dh).astype(q.dtype)


def _cmp_to_slc_matrix(n_cmp, n_slc):
    rs = NSA_SLC_BLOCK // NSA_CMP_STRIDE
    rc = NSA_CMP_LEN // NSA_CMP_STRIDE
    j = np.arange(n_slc)[:, None, None]
    i = np.broadcast_to(rs * j + np.arange(rs)[None, :, None] - np.arange(rc)[None, None, :], (n_slc, rs, rc))
    jj = np.broadcast_to(j, i.shape)
    ok = (i >= 0) & (i < n_cmp)
    mat = np.zeros((n_cmp, n_slc), np.float32)
    np.add.at(mat, (i[ok], jj[ok]), 1.0)
    return jnp.asarray(mat)


def nsa_attention(q, k_cmp, v_cmp, k_slc, v_slc, k_win, v_win, gate_logits,
                  pe_k, w1_k, w2_k, pe_v, w1_v, w2_v):
    B, S, H, Dh = q.shape
    G = k_cmp.shape[2]
    P = H // G
    scale = Dh ** -0.5
    n_cmp = (S - NSA_CMP_LEN) // NSA_CMP_STRIDE + 1
    n_slc = S // NSA_SLC_BLOCK
    top = min(NSA_SLC_TOPK, n_slc)
    qc_len = NSA_Q_CHUNK
    nc = S // qc_len
    W = NSA_WINDOW

    cmp_idx = NSA_CMP_STRIDE * np.arange(n_cmp)[:, None] + np.arange(NSA_CMP_LEN)[None, :]

    def compress(t, pe, w1, w2):
        blk = t[:, cmp_idx] + pe[None, None, :, None, :]
        flat = blk.transpose(0, 1, 3, 2, 4).reshape(B, n_cmp, G, NSA_CMP_LEN * Dh)
        return jax.nn.silu(flat @ w1) @ w2

    kc = compress(k_cmp, pe_k, w1_k, w2_k)
    vc = compress(v_cmp, pe_v, w1_v, w2_v)
    cmp_end = NSA_CMP_STRIDE * jnp.arange(n_cmp) + NSA_CMP_LEN - 1
    cmp_to_slc = _cmp_to_slc_matrix(n_cmp, n_slc)

    kb = k_slc.reshape(B, n_slc, NSA_SLC_BLOCK, G, Dh).transpose(0, 3, 1, 2, 4)
    vb = v_slc.reshape(B, n_slc, NSA_SLC_BLOCK, G, Dh).transpose(0, 3, 1, 2, 4)
    kw = jnp.pad(k_win, ((0, 0), (W, 0), (0, 0), (0, 0)))
    vw = jnp.pad(v_win, ((0, 0), (W, 0), (0, 0), (0, 0)))
    gates = jax.nn.sigmoid(gate_logits.astype(jnp.float32)).reshape(B, S, G, P, 3)

    q_ch = q.reshape(B, nc, qc_len, G, P, Dh).transpose(1, 0, 2, 3, 4, 5)
    g_ch = gates.reshape(B, nc, qc_len, G, P, 3).transpose(1, 0, 2, 3, 4, 5)
    starts = jnp.arange(nc, dtype=jnp.int32) * qc_len
    bi = jnp.arange(B)[:, None, None, None]
    gi = jnp.arange(G)[None, :, None, None]
    blk_ids = jnp.arange(n_slc)

    def chunk(args):
        qc, gc, t0 = args
        tq = t0 + jnp.arange(qc_len)
        s = jnp.einsum('bqgpd,bngd->bgpqn', qc, kc) * scale
        p_cmp = masked_softmax(s, cmp_end[None, :] <= tq[:, None])
        o_cmp = jnp.einsum('bgpqn,bngd->bqgpd', p_cmp.astype(vc.dtype), vc)
        imp = jnp.einsum('bgpqn,ns->bgqs', p_cmp, cmp_to_slc)
        own = tq // NSA_SLC_BLOCK
        forced = ((blk_ids[None, :] == 0) | (blk_ids[None, :] == own[:, None])
                  | (blk_ids[None, :] == own[:, None] - 1))
        imp = jnp.where(forced, jnp.inf, imp)
        imp = jnp.where(blk_ids[None, :] <= own[:, None], imp, -jnp.inf)
        _, sel = lax.top_k(imp, top)
        ks = kb[bi, gi, sel]
        vs = vb[bi, gi, sel]
        kpos = (sel[..., None] * NSA_SLC_BLOCK + jnp.arange(NSA_SLC_BLOCK)).reshape(
            B, G, 1, qc_len, top * NSA_SLC_BLOCK)
        s = jnp.einsum('bqgpd,bgqjkd->bgpqjk', qc, ks).reshape(
            B, G, P, qc_len, top * NSA_SLC_BLOCK) * scale
        p = masked_softmax(s, kpos <= tq[:, None]).astype(vs.dtype)
        o_slc = jnp.einsum('bgpqjk,bgqjkd->bqgpd',
                           p.reshape(B, G, P, qc_len, top, NSA_SLC_BLOCK), vs)
        kwc = lax.dynamic_slice_in_dim(kw, t0, W + qc_len, axis=1)
        vwc = lax.dynamic_slice_in_dim(vw, t0, W + qc_len, axis=1)
        kp = t0 - W + jnp.arange(W + qc_len)
        wmask = ((kp[None, :] <= tq[:, None]) & (kp[None, :] > tq[:, None] - W)
                 & (kp[None, :] >= 0))
        s = jnp.einsum('bqgpd,bkgd->bgpqk', qc, kwc) * scale
        p = masked_softmax(s, wmask).astype(vwc.dtype)
        o_win = jnp.einsum('bgpqk,bkgd->bqgpd', p, vwc)
        return gc[..., 0:1] * o_cmp + gc[..., 1:2] * o_slc + gc[..., 2:3] * o_win

    o = lax.map(chunk, (q_ch, g_ch, starts))
    return o.transpose(1, 0, 2, 3, 4, 5).reshape(B, S, H * Dh).astype(q.dtype)


def _rotate(t, cos, sin):
    t1, t2 = jnp.split(t, 2, axis=-1)
    c = cos[None, :, None, :]
    s = sin[None, :, None, :]
    return jnp.concatenate([t1 * c - t2 * s, t1 * s + t2 * c], axis=-1)


def retention(q, k, v, gn_g):
    B, S, H, Dk = q.shape
    Dv = v.shape[-1]
    C = RET_CHUNK
    nc = S // C
    gamma = 1.0 - 2.0 ** (-5.0 - np.arange(H))
    log_g = jnp.asarray(np.log(gamma).astype(np.float32))
    inv_freq = jnp.asarray((1.0 / (10000.0 ** np.linspace(0.0, 1.0, Dk // 2))).astype(np.float32))
    ang = jnp.arange(S, dtype=jnp.float32)[:, None] * inv_freq[None, :]
    cos, sin = jnp.cos(ang), jnp.sin(ang)
    qf = _rotate(q.astype(jnp.float32), cos, sin)
    kf = _rotate(k.astype(jnp.float32), cos, sin) * (Dk ** -0.5)
    vf = v.astype(jnp.float32)
    q_ch = qf.reshape(B, nc, C, H, Dk).transpose(1, 0, 3, 2, 4)
    k_ch = kf.reshape(B, nc, C, H, Dk).transpose(1, 0, 3, 2, 4)
    v_ch = vf.reshape(B, nc, C, H, Dv).transpose(1, 0, 3, 2, 4)
    idx = jnp.arange(C, dtype=jnp.float32)
    diff = idx[:, None] - idx[None, :]
    intra = jnp.where(diff >= 0, jnp.exp(log_g[:, None, None] * jnp.maximum(diff, 0.0)), 0.0)
    cross = jnp.exp(log_g[:, None] * (idx[None, :] + 1.0))[None, :, :, None]
    kdec = jnp.exp(log_g[:, None] * (C - 1.0 - idx[None, :]))[None, :, :, None]
    chunk_dec = jnp.exp(log_g * C)[None, :, None, None]

    def step(R, xs):
        qc, kc, vc = xs
        s = jnp.einsum('bhid,bhjd->bhij', qc, kc) * intra
        o = (jnp.einsum('bhij,bhjv->bhiv', s, vc)
             + jnp.einsum('bhid,bhdv->bhiv', qc, R) * cross)
        R = R * chunk_dec + jnp.einsum('bhjd,bhjv->bhdv', kc * kdec, vc)
        return R, o

    R0 = jnp.zeros((B, H, Dk, Dv), jnp.float32)
    _, o = lax.scan(step, R0, (q_ch, k_ch, v_ch))
    o = o.transpose(1, 0, 3, 2, 4).reshape(B, S, H, Dv)
    mu = jnp.mean(o, axis=-1, keepdims=True)
    var = jnp.mean(jnp.square(o - mu), axis=-1, keepdims=True)
    o = (o - mu) * lax.rsqrt(var + EPS)
    return (o.reshape(B, S, H * Dv) * gn_g.astype(jnp.float32)).astype(v.dtype)


def memory_attention(q, mem_k, mem_v):
    B, S, H, Dh = q.shape
    s = jnp.einsum('bshd,bmhd->bhsm', q, mem_k).astype(jnp.float32) * (Dh ** -0.5)
    p = jax.nn.softmax(s, axis=-1).astype(mem_v.dtype)
    return jnp.einsum('bhsm,bmhd->bshd', p, mem_v).reshape(B, S, H * Dh).astype(q.dtype)


def hybrid_layer(x, mem, pre_g, post_g, mem_g, w_in, w_mem_kv,
                 pe_k, w1_k, w2_k, pe_v, w1_v, w2_v, ret_gn_g, w_out):
    B, S, _ = x.shape
    h = rms_norm(x, pre_g)
    proj = h @ w_in
    (mq, mk, mv, nq, nkc, nvc, nks, nvs, nkw, nvw, ngate,
     rq, rk, rv, cq, z) = split_cols(proj, IN_SPLITS)

    def heads(t, n, d):
        return t.reshape(B, S, n, d)

    o_moba = moba_attention(heads(mq, MOBA_HEADS, MOBA_HEAD_DIM),
                            heads(mk, MOBA_HEADS, MOBA_HEAD_DIM),
                            heads(mv, MOBA_HEADS, MOBA_HEAD_DIM))
    kvh = lambda t: heads(t, NSA_KV_HEADS, NSA_HEAD_DIM)
    o_nsa = nsa_attention(heads(nq, NSA_HEADS, NSA_HEAD_DIM),
                          kvh(nkc), kvh(nvc), kvh(nks), kvh(nvs), kvh(nkw), kvh(nvw),
                          ngate.reshape(B, S, NSA_HEADS, 3),
                          pe_k, w1_k, w2_k, pe_v, w1_v, w2_v)
    o_ret = retention(heads(rq, RET_HEADS, RET_KEY_DIM), heads(rk, RET_HEADS, RET_KEY_DIM),
                      heads(rv, RET_HEADS, RET_VAL_DIM), ret_gn_g)
    mem_n = rms_norm(mem, mem_g)
    mem_k, mem_v = jnp.split(mem_n @ w_mem_kv, 2, axis=-1)
    M = mem.shape[1]
    o_mem = memory_attention(heads(cq, MEM_HEADS, MEM_HEAD_DIM),
                             mem_k.reshape(B, M, MEM_HEADS, MEM_HEAD_DIM),
                             mem_v.reshape(B, M, MEM_HEADS, MEM_HEAD_DIM))
    o = jnp.concatenate([o_moba, o_nsa, o_ret, o_mem], axis=-1) * jax.nn.silu(z)
    y = o @ w_out
    return x + rms_norm(y, post_g)


def setup_inputs(seed: int = 0) -> dict:
    key = jax.random.key(seed)
    ks = jax.random.split(key, 16)
    f32 = jnp.float32

    def normal(k, shape, scale):
        return jax.random.normal(k, shape, f32) * scale

    L = DEPTH
    cmp_in = NSA_CMP_LEN * NSA_HEAD_DIM
    return {
        "x": normal(ks[0], (BATCH, SEQ, D_MODEL), 1.0),
        "mem": normal(ks[1], (BATCH, MEM_LEN, D_MODEL), 1.0),
        "pre_norm_g": 1.0 + normal(ks[2], (L, D_MODEL), 0.02),
        "post_norm_g": 1.0 + normal(ks[3], (L, D_MODEL), 0.02),
        "mem_norm_g": 1.0 + normal(ks[4], (L, D_MODEL), 0.02),
        "w_in": normal(ks[5], (L, D_MODEL, IN_COLS), D_MODEL ** -0.5),
        "w_mem_kv": normal(ks[6], (L, D_MODEL, 2 * GROUP_WIDTH), D_MODEL ** -0.5),
        "nsa_pe_k": normal(ks[7], (L, NSA_CMP_LEN, NSA_HEAD_DIM), 0.1),
        "nsa_w1_k": normal(ks[8], (L, cmp_in, NSA_CMP_HIDDEN), cmp_in ** -0.5),
        "nsa_w2_k": normal(ks[9], (L, NSA_CMP_HIDDEN, NSA_HEAD_DIM), NSA_CMP_HIDDEN ** -0.5),
        "nsa_pe_v": normal(ks[10], (L, NSA_CMP_LEN, NSA_HEAD_DIM), 0.1),
        "nsa_w1_v": normal(ks[11], (L, cmp_in, NSA_CMP_HIDDEN), cmp_in ** -0.5),
        "nsa_w2_v": normal(ks[12], (L, NSA_CMP_HIDDEN, NSA_HEAD_DIM), NSA_CMP_HIDDEN ** -0.5),
        "ret_gn_g": 1.0 + normal(ks[13], (L, GROUP_WIDTH), 0.02),
        "w_out": normal(ks[14], (L, MIX_WIDTH, D_MODEL), MIX_WIDTH ** -0.5),
    }


def reference(x, mem, pre_norm_g, post_norm_g, mem_norm_g, w_in, w_mem_kv,
              nsa_pe_k, nsa_w1_k, nsa_w2_k, nsa_pe_v, nsa_w1_v, nsa_w2_v,
              ret_gn_g, w_out):
    for l in range(DEPTH):
        x = hybrid_layer(x, mem, pre_norm_g[l], post_norm_g[l], mem_norm_g[l],
                         w_in[l], w_mem_kv[l],
                         nsa_pe_k[l], nsa_w1_k[l], nsa_w2_k[l],
                         nsa_pe_v[l], nsa_w1_v[l], nsa_w2_v[l],
                         ret_gn_g[l], w_out[l])
    return x
```

```cpp
#include <hip/hip_runtime.h>
#include <hip/hip_cooperative_groups.h>
#include <stdint.h>
#include <cstdio>
namespace cg = cooperative_groups;

typedef unsigned short bf16_t;
typedef short bf16x8 __attribute__((ext_vector_type(8)));
typedef float f32x16 __attribute__((ext_vector_type(16)));
typedef float f32x4 __attribute__((ext_vector_type(4)));
typedef float f32x2 __attribute__((ext_vector_type(2)));
typedef unsigned u32x4 __attribute__((ext_vector_type(4)));
typedef unsigned u32x2 __attribute__((ext_vector_type(2)));
typedef __bf16 bf16v2 __attribute__((ext_vector_type(2)));
typedef unsigned long long u64;
#define DI __device__ __forceinline__
#define MFMA(a, b, c) __builtin_amdgcn_mfma_f32_32x32x16_bf16((a), (b), (c), 0, 0, 0)

constexpr int SEQ = 4096, DM = 1024, NTOK = 32768;
constexpr int NA = 3096;
constexpr int NZ = 2048;
constexpr int NVT = 1280;
constexpr int NIN = 6656;
constexpr float EPS = 1e-6f;
DI size_t kbm(int row, int k, int nrows) { return ((size_t)(k >> 5) * nrows + row) * 32 + (k & 31); }
constexpr float LOG2E = 1.4426950408889634f;

constexpr int CA_MQ = 0, CA_MK = 512, CA_NQ = 1024, CA_NKC = 1536, CA_NVC = 1664, CA_NKS = 1792, CA_NKW = 1920,
              CA_RQ = 2048, CA_RK = 2304, CA_CQ = 2560, CA_GATE = 3072;
constexpr int CV_MV = 0, CV_NVS = 512, CV_NVW = 640, CV_RV = 768;

constexpr size_t OFF_BUFA = 0;
constexpr size_t OFF_VT   = OFF_BUFA + (size_t)NTOK * NA * 2;
constexpr size_t OFF_BUFZ = OFF_VT + (size_t)8 * NVT * SEQ * 2;
constexpr size_t OFF_H    = OFF_BUFZ + (size_t)NTOK * NZ * 2;
constexpr size_t OFF_WIN  = OFF_H + (size_t)NTOK * DM * 2;
constexpr size_t OFF_WOUT = OFF_WIN + (size_t)NIN * 1024 * 2;
constexpr size_t OFF_WMEM = OFF_WOUT + (size_t)1024 * 2048 * 2;
constexpr size_t OFF_W1K  = OFF_WMEM + (size_t)1024 * 1024 * 2;
constexpr size_t OFF_W1V  = OFF_W1K + (size_t)128 * 2048 * 2;
constexpr size_t OFF_ROPE = OFF_W1V + (size_t)128 * 2048 * 2;
constexpr size_t OFF_MEMN = OFF_ROPE + (size_t)SEQ * 32 * 8;
constexpr size_t OFF_MEMK = OFF_MEMN + (size_t)2048 * 1024 * 2;
constexpr size_t OFF_MEMV = OFF_MEMK + (size_t)2048 * 512 * 2;
constexpr size_t OFF_BIAS = OFF_MEMV + (size_t)8 * 512 * 256 * 2;
constexpr size_t OFF_CTR  = OFF_BIAS + 16384;
constexpr size_t OFF_BAR  = OFF_CTR + 1024;
constexpr size_t OFF_RKT  = OFF_BAR + 16384;
constexpr size_t WS_NEED  = OFF_RKT + (size_t)8 * 4 * 64 * SEQ * 2;
constexpr size_t OFF_KMEAN = OFF_H;
constexpr size_t OFF_KC    = OFF_KMEAN + (size_t)8 * 8 * 16 * 64 * 4;
constexpr size_t OFF_VCT   = OFF_KC + (size_t)16 * 256 * 64 * 2;
constexpr size_t OFF_U = OFF_H + ((size_t)24 << 20);
constexpr size_t OFF_CPART = OFF_H + ((size_t)4 << 20);
constexpr size_t OFF_Y = OFF_BUFA;

constexpr int LDS_BYTES = 73728;
#ifndef REP1
#define REP1 1
#endif
#ifndef REP_NSA
#define REP_NSA 1
#endif
#ifndef REP_MOBA
#define REP_MOBA 1
#endif
#ifndef REP_RET
#define REP_RET 1
#endif
#ifndef REP_MEM
#define REP_MEM 1
#endif
#ifndef REP0
#define REP0 1
#endif
#ifndef REP2
#define REP2 1
#endif
#ifndef REP4
#define REP4 1
#endif
#ifndef REP123
#define REP123 1
#endif

struct Params {
    const float *x, *mem, *pre_g, *post_g, *mem_g, *w_in, *w_mem, *pe_k, *w1_k, *w2_k, *pe_v, *w1_v, *w2_v, *gn_g, *w_out;
    float* out;
    char* ws;
};

DI int my_tid() { int t = threadIdx.x; asm volatile("" : "+v"(t)); return t; }
DI unsigned pack2(float a, float b) { f32x2 v = {a, b}; bf16v2 r = __builtin_convertvector(v, bf16v2); return __builtin_bit_cast(unsigned, r); }
DI float bflo(unsigned u) { return __uint_as_float(u << 16); }
DI float bfhi(unsigned u) { return __uint_as_float(u & 0xffff0000u); }
DI float bf2f(bf16_t v) { return __uint_as_float(((unsigned)v) << 16); }
DI int crow(int reg, int h) { return (reg & 3) + 8 * (reg >> 2) + 4 * h; }
DI float ex2(float x) { return __builtin_amdgcn_exp2f(x); }
DI float ret_lg(int hh) { return (hh == 0) ? -0.045803688f : (hh == 1 ? -0.022720077f : (hh == 2 ? -0.011315314f : -0.0056465633f)); }
DI float mx2(float a, float b) { return __builtin_amdgcn_fmed3f(a, b, INFINITY); }
DI float shx(float v, int m) { return __shfl_xor(v, m, 64); }
DI float wave_sum(float v) { v += shx(v, 32); v += shx(v, 16); v += shx(v, 8); v += shx(v, 4); v += shx(v, 2); v += shx(v, 1); return v; }
DI float silu_f(float v) { return v * __builtin_amdgcn_rcpf(1.f + __expf(-v)); }
DI float sigm_f(float v) { return __builtin_amdgcn_rcpf(1.f + __expf(-v)); }
DI f32x16 zero16() { f32x16 z; for (int i = 0; i < 16; ++i) z[i] = 0.f; return z; }

DI int in_col_src(int n) {
    if (n < 1024) return n;
    if (n < 1920) return n + 512;
    if (n < 2048) return n + 640;
    if (n < 2560) return n + 792;
    if (n < 3072) return n + 1304;
    if (n < 3584) return n - 2048;
    if (n < 3712) return n - 1152;
    if (n < 3840) return n - 1024;
    if (n < 4352) return n - 488;
    if (n < 6400) return n + 24;
    if (n < 6424) return n - 3584;
    return -1;
}

constexpr int GSTR = 144;
constexpr int GBUF = 36864;
constexpr int GBOFF = 18432;

DI void glds16(const void* g, unsigned lds_addr);
template <int N> DI void wait_vm();
#define RAW_BARRIER() do { asm volatile("s_waitcnt lgkmcnt(0)" ::: "memory"); __builtin_amdgcn_s_barrier(); asm volatile("" ::: "memory"); } while (0)
template <bool SWAP, class AOff, class Epi>
DI void gemm_tile(char* lds, const bf16_t* __restrict__ A, AOff aoff, long a_kstride, const bf16_t* __restrict__ Bt, long ldb, int nk64, Epi epi) {
    constexpr int TB = 16384, NI = 4;
    const int tid = my_tid(), lane = tid & 63, w = __builtin_amdgcn_readfirstlane(tid >> 6), r = lane & 31, h = lane >> 5;
    const int wm = w >> 1, wn = w & 1;
    const int nk = nk64 * 2;
    const int lr = lane >> 2, ls = lane & 3;
    const bf16_t* ap[2];
    const bf16_t* bp[2];
#pragma unroll
    for (int i = 0; i < 2; ++i) {
        const int row = 16 * (w + 4 * i) + lr, c = ls ^ ((row >> 2) & 3);
        ap[i] = A + aoff(row) + c * 8;
        bp[i] = Bt + (long)row * ldb + c * 8;
    }
    const unsigned sbase = (unsigned)(size_t)lds;
    f32x16 acc[2][2];
#pragma unroll
    for (int i = 0; i < 2; ++i)
#pragma unroll
        for (int j = 0; j < 2; ++j) acc[i][j] = zero16();
    int issued = 0;
#pragma unroll 1
    for (int a = 0; a < 3; ++a) {
        if (issued < nk) {
            const long ko_a = (long)(issued >> 1) * a_kstride + (issued & 1) * 32, ko_b = (long)issued * 32;
            const unsigned st = sbase + (issued & 3) * TB + w * 1024;
            glds16(ap[0] + ko_a, st); glds16(bp[0] + ko_b, st + 8192);
            glds16(ap[1] + ko_a, st + 4096); glds16(bp[1] + ko_b, st + 8192 + 4096);
            ++issued;
        }
    }
    const int fa = (wm * 64 + r) * 64, fb = 8192 + (wn * 64 + r) * 64, sw = (r >> 2) & 3;
#pragma unroll 1
    for (int kb = 0; kb < nk; ++kb) {
        const int ahead = issued - 1 - kb;
        if (ahead >= 2) wait_vm<2 * NI>(); else if (ahead == 1) wait_vm<NI>(); else wait_vm<0>();
        RAW_BARRIER();
        if (issued < nk) {
            const long ko_a = (long)(issued >> 1) * a_kstride + (issued & 1) * 32, ko_b = (long)issued * 32;
            const unsigned st = sbase + (issued & 3) * TB + w * 1024;
            glds16(ap[0] + ko_a, st); glds16(bp[0] + ko_b, st + 8192);
            glds16(ap[1] + ko_a, st + 4096); glds16(bp[1] + ko_b, st + 8192 + 4096);
            ++issued;
        }
        const char* cur = lds + (kb & 3) * TB;
        bf16x8 af[2][2], bfr[2][2];
#pragma unroll
        for (int kk = 0; kk < 2; ++kk) {
            const int so = ((2 * kk + h) ^ sw) * 16;
#pragma unroll
            for (int i = 0; i < 2; ++i) af[kk][i] = *(const bf16x8*)(cur + fa + i * 2048 + so);
#pragma unroll
            for (int j = 0; j < 2; ++j) bfr[kk][j] = *(const bf16x8*)(cur + fb + j * 2048 + so);
        }
#pragma unroll
        for (int kk = 0; kk < 2; ++kk)
#pragma unroll
            for (int i = 0; i < 2; ++i)
#pragma unroll
                for (int j = 0; j < 2; ++j) acc[i][j] = SWAP ? MFMA(bfr[kk][j], af[kk][i], acc[i][j]) : MFMA(af[kk][i], bfr[kk][j], acc[i][j]);
    }
    RAW_BARRIER();
    epi(acc, wm, wn, r, h);
}

template <bool SWAP, class AOff, class Epi>
DI void gemm_wide(char* lds, const bf16_t* __restrict__ A, AOff aoff, const bf16_t* __restrict__ Bt, long ldb, int nk64, Epi epi, long a_ks = 32, long b_ks = 32) {
    constexpr int TB = 24576, NI = 6;
    const int tid = my_tid(), lane = tid & 63, w = __builtin_amdgcn_readfirstlane(tid >> 6), r = lane & 31, h = lane >> 5;
    const int wm = w >> 1, wn = w & 1;
    const int nk = nk64 * 2;
    const int lr = lane >> 2, ls = lane & 3;
    const bf16_t* ap[2];
    const bf16_t* bp[4];
#pragma unroll
    for (int i = 0; i < 2; ++i) { const int row = 16 * (w + 4 * i) + lr, c = ls ^ ((row >> 2) & 3); ap[i] = A + aoff(row) + c * 8; }
#pragma unroll
    for (int i = 0; i < 4; ++i) { const int row = 16 * (w + 4 * i) + lr, c = ls ^ ((row >> 2) & 3); bp[i] = Bt + (long)row * ldb + c * 8; }
    const unsigned sbase = (unsigned)(size_t)lds;
    f32x16 acc[2][4];
#pragma unroll
    for (int i = 0; i < 2; ++i)
#pragma unroll
        for (int j = 0; j < 4; ++j) acc[i][j] = zero16();
    int issued = 0, si = 0;
#pragma unroll 1
    for (int a = 0; a < 2; ++a) {
        if (issued < nk) {
            const long ko = (long)issued * a_ks, kob = (long)issued * b_ks;
            const unsigned st = sbase + si * TB + w * 1024;
            glds16(ap[0] + ko, st); glds16(ap[1] + ko, st + 4096);
            glds16(bp[0] + kob, st + 8192); glds16(bp[1] + kob, st + 8192 + 4096); glds16(bp[2] + kob, st + 8192 + 8192); glds16(bp[3] + kob, st + 8192 + 12288);
            ++issued; si = (si == 2) ? 0 : si + 1;
        }
    }
    const int fa = (wm * 64 + r) * 64, fb = 8192 + (wn * 128 + r) * 64, sw = (r >> 2) & 3;
    int sc_ = 0;
#pragma unroll 1
    for (int kb = 0; kb < nk; ++kb) {
        if (issued - 1 - kb >= 1) wait_vm<NI>(); else wait_vm<0>();
        RAW_BARRIER();
        if (issued < nk) {
            const long ko = (long)issued * a_ks, kob = (long)issued * b_ks;
            const unsigned st = sbase + si * TB + w * 1024;
            glds16(ap[0] + ko, st); glds16(ap[1] + ko, st + 4096);
            glds16(bp[0] + kob, st + 8192); glds16(bp[1] + kob, st + 8192 + 4096); glds16(bp[2] + kob, st + 8192 + 8192); glds16(bp[3] + kob, st + 8192 + 12288);
            ++issued; si = (si == 2) ? 0 : si + 1;
        }
        const char* cur = lds + sc_ * TB;
        sc_ = (sc_ == 2) ? 0 : sc_ + 1;
#pragma unroll
        for (int kk = 0; kk < 2; ++kk) {
            const int so = ((2 * kk + h) ^ sw) * 16;
            bf16x8 af[2], bfr[4];
#pragma unroll
            for (int i = 0; i < 2; ++i) af[i] = *(const bf16x8*)(cur + fa + i * 2048 + so);
#pragma unroll
            for (int j = 0; j < 4; ++j) bfr[j] = *(const bf16x8*)(cur + fb + j * 2048 + so);
#pragma unroll
            for (int i = 0; i < 2; ++i)
#pragma unroll
                for (int j = 0; j < 4; ++j) acc[i][j] = SWAP ? MFMA(bfr[j], af[i], acc[i][j]) : MFMA(af[i], bfr[j], acc[i][j]);
        }
    }
    RAW_BARRIER();
    epi(acc, wm, wn, r, h);
}

struct ARowLin { long ld; DI long operator()(int r) const { return (long)r * ld; } };

enum { EM_PLAIN = 0, EM_ROPEQ = 1, EM_ROPEK = 2, EM_SILU = 3, EM_GATE = 4 };
struct EpiRow {
    bf16_t* dst; long ld; int row0; int col0; int mode; const f32x2* rope; bool zblk = false; bf16_t* rkt = nullptr;
    template <int NJ> DI void operator()(f32x16 (&acc)[2][NJ], int wm, int wn, int r, int h) const {
#pragma unroll
        for (int i = 0; i < 2; ++i) {
            const int row = row0 + wm * 64 + 32 * i + r;
            if (mode == EM_ROPEQ || mode == EM_ROPEK) {
                const int pos = row & (SEQ - 1);
                const float scl = (mode == EM_ROPEK) ? 0.125f : 1.f;
#pragma unroll
                for (int jp = 0; jp < NJ; jp += 2)
#pragma unroll
                for (int c4 = 0; c4 < 4; ++c4) {
                    float n1[4], n2[4];
#pragma unroll
                    for (int e = 0; e < 4; ++e) {
                        const int d = 8 * c4 + 4 * h + e;
                        const f32x2 cs = rope[pos * 32 + d];
                        const float t1 = acc[i][jp][4 * c4 + e], t2 = acc[i][jp + 1][4 * c4 + e];
                        n1[e] = (t1 * cs.x - t2 * cs.y) * scl;
                        n2[e] = (t1 * cs.y + t2 * cs.x) * scl;
                    }
                    bf16_t* d1 = dst + (long)row * ld + col0 + wn * (32 * NJ) + 32 * jp + 8 * c4 + 4 * h;
                    u32x2 o1 = {pack2(n1[0], n1[1]), pack2(n1[2], n1[3])};
                    u32x2 o2 = {pack2(n2[0], n2[1]), pack2(n2[2], n2[3])};
                    *(u32x2*)d1 = o1;
                    *(u32x2*)(d1 + 32) = o2;
                    if (mode == EM_ROPEK && rkt != nullptr) {
                        const int hh = (wn * (32 * NJ) + 32 * jp) >> 6;
                        const float wgt = ex2(ret_lg(hh) * (float)(127 - (pos & 127)));
                        bf16_t* tp = rkt + ((size_t)((row >> 12) * 4 + hh) * 64 + 8 * c4 + 4 * h) * SEQ + pos;
#pragma unroll
                        for (int e = 0; e < 4; ++e) {
                            tp[(size_t)e * SEQ] = (bf16_t)(pack2(n1[e] * wgt, 0.f) & 0xffffu);
                            tp[(size_t)(e + 32) * SEQ] = (bf16_t)(pack2(n2[e] * wgt, 0.f) & 0xffffu);
                        }
                    }
                }
            } else {
#pragma unroll
                for (int j = 0; j < NJ; ++j)
#pragma unroll
                    for (int c4 = 0; c4 < 4; ++c4) {
                        const int cl = wn * (32 * NJ) + 32 * j + 8 * c4 + 4 * h;
                        float v[4];
#pragma unroll
                        for (int e = 0; e < 4; ++e) v[e] = acc[i][j][4 * c4 + e];
                        if (mode == EM_SILU) {
#pragma unroll
                            for (int e = 0; e < 4; ++e) v[e] = silu_f(v[e]);
                        }
                        if (mode == EM_GATE) {
                            if (cl >= 24) continue;
#pragma unroll
                            for (int e = 0; e < 4; ++e) v[e] = sigm_f(v[e]);
                        }
                        u32x2 o = {pack2(v[0], v[1]), pack2(v[2], v[3])};
                        *(u32x2*)(dst + (zblk ? kbm(row, col0 + cl, NTOK) : (size_t)((long)row * ld + col0 + cl))) = o;
                    }
            }
        }
    }
};
struct EpiVT {
    bf16_t* dst; int ncols; int seq; int row0; int col0;
    template <int NJ> DI void operator()(f32x16 (&acc)[2][NJ], int wm, int wn, int r, int h) const {
#pragma unroll
        for (int i = 0; i < 2; ++i)
#pragma unroll
            for (int j = 0; j < NJ; ++j) {
                const int col = col0 + wn * (32 * NJ) + 32 * j + r;
#pragma unroll
                for (int c4 = 0; c4 < 4; ++c4) {
                    const int row = row0 + wm * 64 + 32 * i + 8 * c4 + 4 * h;
                    const int b = row / seq, s = row - b * seq;
                    u32x2 o = {pack2(acc[i][j][4 * c4], acc[i][j][4 * c4 + 1]), pack2(acc[i][j][4 * c4 + 2], acc[i][j][4 * c4 + 3])};
                    *(u32x2*)(dst + ((long)b * ncols + col) * seq + s) = o;
                }
            }
    }
};
struct EpiY {
    bf16_t* dst; int row0; int col0;
    template <int NJ> DI void operator()(f32x16 (&acc)[2][NJ], int wm, int wn, int r, int h) const {
#pragma unroll
        for (int i = 0; i < 2; ++i) {
            const int row = row0 + wm * 64 + 32 * i + r;
#pragma unroll
            for (int j = 0; j < NJ; ++j)
#pragma unroll
                for (int c4 = 0; c4 < 4; ++c4) {
                    u32x2 o = {pack2(acc[i][j][4 * c4], acc[i][j][4 * c4 + 1]), pack2(acc[i][j][4 * c4 + 2], acc[i][j][4 * c4 + 3])};
                    *(u32x2*)(dst + (long)row * DM + col0 + wn * (32 * NJ) + 32 * j + 8 * c4 + 4 * h) = o;
                }
        }
    }
};
constexpr int HSTR = 272;
struct EpiCmp {
    char* lds; const float* bias;
    DI void operator()(f32x16 (&acc)[2][2], int wm, int wn, int r, int h) const {
#pragma unroll
        for (int i = 0; i < 2; ++i) {
            const int row = wm * 64 + 32 * i + r;
#pragma unroll
            for (int j = 0; j < 2; ++j)
#pragma unroll
                for (int c4 = 0; c4 < 4; ++c4) {
                    const int cl = wn * 64 + 32 * j + 8 * c4 + 4 * h;
                    float v[4];
#pragma unroll
                    for (int e = 0; e < 4; ++e) v[e] = silu_f(acc[i][j][4 * c4 + e] + bias[cl + e]);
                    u32x2 o = {pack2(v[0], v[1]), pack2(v[2], v[3])};
                    *(u32x2*)(lds + row * HSTR + cl * 2) = o;
                }
        }
    }
};
struct EpiPart {
    float* dst;
    DI void operator()(f32x16 (&acc)[2][2], int wm, int wn, int r, int h) const {
#pragma unroll
        for (int i = 0; i < 2; ++i) {
            const int row = wm * 64 + 32 * i + r;
#pragma unroll
            for (int j = 0; j < 2; ++j)
#pragma unroll
                for (int c4 = 0; c4 < 4; ++c4) {
                    f32x4 o = {acc[i][j][4 * c4], acc[i][j][4 * c4 + 1], acc[i][j][4 * c4 + 2], acc[i][j][4 * c4 + 3]};
                    *(f32x4*)(dst + row * 128 + wn * 64 + 32 * j + 8 * c4 + 4 * h) = o;
                }
        }
    }
};
struct ARowCmp {
    int row0; int colbase;
    DI long operator()(int r) const {
        const int R = row0 + r, bg = R >> 8; int i = R & 255; if (i > 254) i = 254;
        const int b = bg >> 1, g = bg & 1;
        return ((long)(b * SEQ + 16 * i)) * NA + colbase + g * 64;
    }
};

enum { FM_NONE = 0, FM_MOBA = 1, FM_CMP = 2, FM_SLC = 3, FM_WIN = 4, FM_RET = 5 };
constexpr int VSTR = 144;

template <int DK, int DV>
struct TileRegs { u32x4 k[DK / 32]; u32x4 v[DV / 32]; };

template <int DK, int DV>
DI void tile_load(TileRegs<DK, DV>& t, const bf16_t* __restrict__ Kp, long kstride, const bf16_t* __restrict__ Vt, long vstride, int key0, bool loadv) {
    const int tid = my_tid();
#pragma unroll
    for (int j = 0; j < DK / 32; ++j) {
        const int c = tid + 256 * j, row = c / (DK / 8), kc = c % (DK / 8);
        t.k[j] = *(const u32x4*)(Kp + (long)(key0 + row) * kstride + kc * 8);
    }
    if (loadv) {
#pragma unroll
        for (int j = 0; j < DV / 32; ++j) {
            const int c = tid + 256 * j, row = c >> 3, kc = c & 7;
            t.v[j] = *(const u32x4*)(Vt + (long)row * vstride + key0 + kc * 8);
        }
    }
}
template <int DK, int DV>
DI void tile_store(const TileRegs<DK, DV>& t, char* buf, bool storev) {
    constexpr int KSTR = (DK + 8) * 2;
    const int tid = my_tid();
#pragma unroll
    for (int j = 0; j < DK / 32; ++j) {
        const int c = tid + 256 * j, row = c / (DK / 8), kc = c % (DK / 8);
        *(u32x4*)(buf + row * KSTR + kc * 16) = t.k[j];
    }
    if (storev) {
#pragma unroll
        for (int j = 0; j < DV / 32; ++j) {
            const int c = tid + 256 * j, row = c >> 3, kc = c & 7;
            *(u32x4*)(buf + 64 * KSTR + row * VSTR + kc * 16) = t.v[j];
        }
    }
}

template <int MODE>
DI bool fpred(int key, int tq) {
    if (MODE == FM_NONE) return true;
    if (MODE == FM_CMP) return (16 * key + 31) <= tq;
    if (MODE == FM_WIN) return (key <= tq) && (key > tq - 512);
    return key <= tq;
}

DI void glds16(const void* g, unsigned lds_addr) {
    lds_addr = __builtin_amdgcn_readfirstlane(lds_addr);
    asm volatile("s_mov_b32 m0, %0\n\ts_nop 0\n\tglobal_load_lds_dwordx4 %1, off" ::"s"(lds_addr), "v"(g) : "memory", "m0");
}
template <int DK, int DV>
struct TileSrc { const bf16_t* k[DK / 32]; const bf16_t* v[DV / 32]; unsigned woff; };
template <int DK, int DV>
DI void tile_src_init(TileSrc<DK, DV>& ts, const bf16_t* __restrict__ Kp, long kstride, const bf16_t* __restrict__ Vt, long vstride) {
    constexpr int NK = DK / 8, NV = DV / 8;
    const int tid = my_tid(), lane = tid & 63, w = __builtin_amdgcn_readfirstlane(tid >> 6);
    ts.woff = (unsigned)w * 1024u;
#pragma unroll
    for (int i = 0; i < NK / 4; ++i) {
        const int g = w + 4 * i;
        int row, c;
        if (DK == 64) { row = 8 * g + (lane >> 3); c = (lane & 7) ^ ((row >> 1) & 7); }
        else { row = 4 * g + (lane >> 4); c = (lane & 15) ^ (row & 15); }
        ts.k[i] = Kp + (long)row * kstride + c * 8;
    }
#pragma unroll
    for (int i = 0; i < NV / 4; ++i) {
        const int g = w + 4 * i;
        const int row = 8 * g + (lane >> 3), c = (lane & 7) ^ ((row >> 1) & 7);
        ts.v[i] = Vt + (long)row * vstride + c * 8;
    }
}
template <int DK, int DV>
DI void tile_issue(char* stage, const TileSrc<DK, DV>& ts, long kstride, int key0) {
    constexpr int NK = DK / 8, NV = DV / 8;
    const unsigned sbase = (unsigned)(size_t)stage + ts.woff;
    const long koff = (long)key0 * kstride;
#pragma unroll
    for (int i = 0; i < NK / 4; ++i) glds16(ts.k[i] + koff, sbase + i * 4096);
#pragma unroll
    for (int i = 0; i < NV / 4; ++i) glds16(ts.v[i] + key0, sbase + NK * 1024 + i * 4096);
}
template <int N> DI void wait_vm() { asm volatile("s_waitcnt vmcnt(%0)" ::"n"(N) : "memory"); }

template <int DK, int DV, int MODE>
DI void flash(char* lds, const bf16x8 (&qf)[DK / 16], const bf16_t* __restrict__ Kp, long kstride, const bf16_t* __restrict__ Vt, long vstride,
              u64 tiles, u64 wtiles, int tq, u64 aux, float sc, float lg, f32x16 (&o)[DV / 32], float& m, float& l, int nst_cap = 4) {
    constexpr int NK = DK / 8, NV = DV / 8, NI = (NK + NV) / 4;
    constexpr int TB = (NK + NV) * 1024;
    constexpr int NSTMAX = (LDS_BYTES / TB) > 4 ? 4 : (LDS_BYTES / TB);
    const int NST = NSTMAX < nst_cap ? NSTMAX : nst_cap;
    const int lane = my_tid() & 63, r = lane & 31, h = lane >> 5;
    tiles = ((u64)(unsigned)__builtin_amdgcn_readfirstlane((unsigned)(tiles >> 32)) << 32) | (unsigned)__builtin_amdgcn_readfirstlane((unsigned)tiles);
    wtiles = ((u64)(unsigned)__builtin_amdgcn_readfirstlane((unsigned)(wtiles >> 32)) << 32) | (unsigned)__builtin_amdgcn_readfirstlane((unsigned)wtiles);
    u64 rem_i = tiles, rem_c = tiles;
    const int n = __builtin_popcountll(tiles);
    if (n == 0) return;
    TileSrc<DK, DV> ts;
    tile_src_init<DK, DV>(ts, Kp, kstride, Vt, vstride);
    int issued = 0, slot_i = 0, slot_c = 0;
#pragma unroll 1
    for (int a = 0; a < NST - 1; ++a) {
        if (rem_i) {
            const int t = __builtin_ctzll(rem_i); rem_i &= rem_i - 1;
            tile_issue<DK, DV>(lds + slot_i * TB, ts, kstride, t * 64);
            ++issued; slot_i = (slot_i + 1 == NST) ? 0 : slot_i + 1;
        }
    }
#pragma unroll 1
    for (int j = 0; j < n; ++j) {
        const int cur = __builtin_ctzll(rem_c); rem_c &= rem_c - 1;
        const int ahead = issued - 1 - j;
        if (ahead >= 2) wait_vm<2 * NI>(); else if (ahead == 1) wait_vm<NI>(); else wait_vm<0>();
        RAW_BARRIER();
        if (rem_i) {
            const int t = __builtin_ctzll(rem_i); rem_i &= rem_i - 1;
            tile_issue<DK, DV>(lds + slot_i * TB, ts, kstride, t * 64);
            ++issued; slot_i = (slot_i + 1 == NST) ? 0 : slot_i + 1;
        }
        const char* Ks = lds + slot_c * TB;
        const char* Vs = Ks + NK * 1024;
        slot_c = (slot_c + 1 == NST) ? 0 : slot_c + 1;
        if ((wtiles >> cur) & 1ull) {
            const int q0w = __builtin_amdgcn_readfirstlane(tq);
            const int kt0 = cur * 64;
            bool need_mask = false;
            if (MODE == FM_MOBA || MODE == FM_SLC || MODE == FM_RET) need_mask = (kt0 + 63 > q0w);
            if (MODE == FM_CMP) need_mask = (16 * (kt0 + 63) + 31 > q0w);
            if (MODE == FM_WIN) need_mask = (kt0 + 63 > q0w) || (kt0 <= q0w + 31 - 512);
            bool lane_on = true;
            if (MODE == FM_MOBA) lane_on = (((unsigned)aux >> (cur >> 2)) & 1u) != 0u;
            if (MODE == FM_SLC) lane_on = ((aux >> cur) & 1ull) != 0ull;
            f32x16 s[2];
            if (DK == 64) {
                bf16x8 kf[2][DK / 16];
#pragma unroll
                for (int t = 0; t < 2; ++t)
#pragma unroll
                    for (int kk = 0; kk < DK / 16; ++kk) {
                        const int krow = 32 * t + r;
                        kf[t][kk] = *(const bf16x8*)(Ks + krow * (DK * 2) + (((2 * kk + h) ^ ((krow >> 1) & 7)) * 16));
                    }
                __builtin_amdgcn_sched_barrier(0);
#pragma unroll
                for (int t = 0; t < 2; ++t) {
                    s[t] = zero16();
#pragma unroll
                    for (int kk = 0; kk < DK / 16; ++kk) s[t] = MFMA(kf[t][kk], qf[kk], s[t]);
                }
            } else {
#pragma unroll
                for (int t = 0; t < 2; ++t) {
                    bf16x8 kf[DK / 16];
#pragma unroll
                    for (int kk = 0; kk < DK / 16; ++kk) {
                        const int krow = 32 * t + r;
                        kf[kk] = *(const bf16x8*)(Ks + krow * (DK * 2) + (((2 * kk + h) ^ (krow & 15)) * 16));
                    }
                    s[t] = zero16();
#pragma unroll
                    for (int kk = 0; kk < DK / 16; ++kk) s[t] = MFMA(kf[kk], qf[kk], s[t]);
                    __builtin_amdgcn_sched_barrier(0);
                }
            }
            u32x4 vf0[2][DV / 32];
#pragma unroll
            for (int ss = 0; ss < 2; ++ss)
#pragma unroll
                for (int d = 0; d < DV / 32; ++d) {
                    const int vrow = 32 * d + r, vkey = (vrow >> 1) & 7, c0 = 2 * ss;
                    const u32x2 lo = *(const u32x2*)(Vs + vrow * 128 + ((c0 ^ vkey) * 16) + 8 * h);
                    const u32x2 hi = *(const u32x2*)(Vs + vrow * 128 + (((c0 + 1) ^ vkey) * 16) + 8 * h);
                    vf0[ss][d] = (u32x4){lo.x, lo.y, hi.x, hi.y};
                }
            __builtin_amdgcn_sched_barrier(0);
            if (MODE != FM_RET) {
                if (need_mask) {
#pragma unroll
                    for (int t = 0; t < 2; ++t)
#pragma unroll
                        for (int i = 0; i < 16; ++i)
                            if (!fpred<MODE>(kt0 + 32 * t + crow(i, h), tq)) s[t][i] = -INFINITY;
                }
                float mx0 = mx2(mx2(mx2(s[0][0], s[0][1]), mx2(s[0][2], s[0][3])), mx2(mx2(s[0][4], s[0][5]), mx2(s[0][6], s[0][7])));
                float mx1 = mx2(mx2(mx2(s[0][8], s[0][9]), mx2(s[0][10], s[0][11])), mx2(mx2(s[0][12], s[0][13]), mx2(s[0][14], s[0][15])));
                float mx2_ = mx2(mx2(mx2(s[1][0], s[1][1]), mx2(s[1][2], s[1][3])), mx2(mx2(s[1][4], s[1][5]), mx2(s[1][6], s[1][7])));
                float mx3 = mx2(mx2(mx2(s[1][8], s[1][9]), mx2(s[1][10], s[1][11])), mx2(mx2(s[1][12], s[1][13]), mx2(s[1][14], s[1][15])));
                float mx = mx2(mx2(mx0, mx1), mx2(mx2_, mx3));
                if (MODE == FM_MOBA || MODE == FM_SLC) mx = lane_on ? mx : -INFINITY;
                mx = fmaxf(mx, shx(mx, 32));
                const float mxs = mx * sc;
                if (__any(mxs > m + 8.f)) {
                    const float mn = fmaxf(m, mxs);
                    const float alpha = ex2(m - mn);
                    m = mn;
                    l *= alpha;
#pragma unroll
                    for (int d = 0; d < DV / 32; ++d)
#pragma unroll
                        for (int i = 0; i < 16; ++i) o[d][i] *= alpha;
                }
                float negm = -m;
                if (MODE == FM_MOBA || MODE == FM_SLC) negm = lane_on ? negm : -1e30f;
                float ps0 = 0.f, ps1 = 0.f;
#pragma unroll
                for (int t = 0; t < 2; ++t)
#pragma unroll
                    for (int i = 0; i < 16; i += 2) {
                        const float p0 = ex2(__builtin_fmaf(s[t][i], sc, negm));
                        const float p1 = ex2(__builtin_fmaf(s[t][i + 1], sc, negm));
                        s[t][i] = p0; s[t][i + 1] = p1;
                        ps0 += p0; ps1 += p1;
                    }
                l += ps0 + ps1;
            } else {
                const float g1 = sc, g2 = g1 * g1, g3 = g2 * g1, g4 = g2 * g2, g8 = g4 * g4;
#pragma unroll
                for (int t = 0; t < 2; ++t) {
                    float Ac = ex2(lg * (float)(tq - (kt0 + 32 * t) - 4 * h));
#pragma unroll
                    for (int c = 0; c < 4; ++c) {
                        s[t][4 * c] *= Ac; s[t][4 * c + 1] *= Ac * g1; s[t][4 * c + 2] *= Ac * g2; s[t][4 * c + 3] *= Ac * g3;
                        Ac *= g8;
                    }
                }
                if (need_mask) {
#pragma unroll
                    for (int t = 0; t < 2; ++t)
#pragma unroll
                        for (int i = 0; i < 16; ++i)
                            if (kt0 + 32 * t + crow(i, h) > tq) s[t][i] = 0.f;
                }
            }
            __builtin_amdgcn_sched_barrier(0);
            u32x4 vf1[2][DV / 32];
#pragma unroll
            for (int ss = 0; ss < 2; ++ss)
#pragma unroll
                for (int d = 0; d < DV / 32; ++d) {
                    const int vrow = 32 * d + r, vkey = (vrow >> 1) & 7, c0 = 4 + 2 * ss;
                    const u32x2 lo = *(const u32x2*)(Vs + vrow * 128 + ((c0 ^ vkey) * 16) + 8 * h);
                    const u32x2 hi = *(const u32x2*)(Vs + vrow * 128 + (((c0 + 1) ^ vkey) * 16) + 8 * h);
                    vf1[ss][d] = (u32x4){lo.x, lo.y, hi.x, hi.y};
                }
#pragma unroll
            for (int ss = 0; ss < 2; ++ss) {
                u32x4 pk = {pack2(s[0][8 * ss], s[0][8 * ss + 1]), pack2(s[0][8 * ss + 2], s[0][8 * ss + 3]),
                            pack2(s[0][8 * ss + 4], s[0][8 * ss + 5]), pack2(s[0][8 * ss + 6], s[0][8 * ss + 7])};
                const bf16x8 pf = __builtin_bit_cast(bf16x8, pk);
#pragma unroll
                for (int d = 0; d < DV / 32; ++d) o[d] = MFMA(__builtin_bit_cast(bf16x8, vf0[ss][d]), pf, o[d]);
            }
#pragma unroll
            for (int ss = 0; ss < 2; ++ss) {
                u32x4 pk = {pack2(s[1][8 * ss], s[1][8 * ss + 1]), pack2(s[1][8 * ss + 2], s[1][8 * ss + 3]),
                            pack2(s[1][8 * ss + 4], s[1][8 * ss + 5]), pack2(s[1][8 * ss + 6], s[1][8 * ss + 7])};
                const bf16x8 pf = __builtin_bit_cast(bf16x8, pk);
#pragma unroll
                for (int d = 0; d < DV / 32; ++d) o[d] = MFMA(__builtin_bit_cast(bf16x8, vf1[ss][d]), pf, o[d]);
            }
        }
    }
    RAW_BARRIER();
}

template <int DK>
DI void load_q(bf16x8 (&qf)[DK / 16], const bf16_t* qrow, int h) {
#pragma unroll
    for (int kk = 0; kk < DK / 16; ++kk) qf[kk] = *(const bf16x8*)(qrow + 16 * kk + 8 * h);
}

template <int DV>
DI void write_gated(const f32x16 (&o)[DV / 32], float scale, bf16_t* zbase, size_t row, int col0, int h, bool wr = true) {
    if (!wr) {
        float chk = 0.f;
#pragma unroll
        for (int d = 0; d < DV / 32; ++d)
#pragma unroll
            for (int i = 0; i < 16; ++i) chk += o[d][i];
        if (chk * scale == 1.2345e-30f) zbase[0] = 0;
        return;
    }
#pragma unroll
    for (int d = 0; d < DV / 32; ++d)
#pragma unroll
        for (int c4 = 0; c4 < 4; ++c4) {
            bf16_t* zp = zbase + kbm((int)row, col0 + 32 * d + 8 * c4 + 4 * h, NTOK);
            const u32x2 z = *(const u32x2*)zp;
            u32x2 ov = {pack2(o[d][4 * c4] * scale * bflo(z.x), o[d][4 * c4 + 1] * scale * bfhi(z.x)),
                        pack2(o[d][4 * c4 + 2] * scale * bflo(z.y), o[d][4 * c4 + 3] * scale * bfhi(z.y))};
            *(u32x2*)zp = ov;
        }
}

DI u64 range_bits(int lo, int hi) {
    const u64 a = (hi >= 63) ? ~0ull : ((2ull << hi) - 1ull);
    return a & ~((1ull << lo) - 1ull);
}

constexpr int KM_OFF = 65536, MISC_OFF = 69888;
DI void moba_item(const Params& p, char* lds, int b, int hh, int qt, bool wr = true) {
    const int tid = my_tid(), lane = tid & 63, w = tid >> 6, r = lane & 31, h = lane >> 5;
    const bf16_t* bufA = (const bf16_t*)(p.ws + OFF_BUFA);
    const bf16_t* vT = (const bf16_t*)(p.ws + OFF_VT);
    bf16_t* bufZ = (bf16_t*)(p.ws + OFF_BUFZ);
    const float* kmean = (const float*)(p.ws + OFF_KMEAN);
    const int q0w = qt * 128 + w * 32, tq = q0w + r, own = qt >> 1;
    *(f32x4*)(lds + KM_OFF + tid * 16) = *(const f32x4*)(kmean + (size_t)(b * 8 + hh) * 1024 + tid * 4);
    const bf16_t* qrow = bufA + (size_t)(b * SEQ + tq) * NA + CA_MQ + hh * 64;
    bf16x8 qf[4];
    load_q<64>(qf, qrow, h);
    __syncthreads();
    float g[16];
#pragma unroll
    for (int n = 0; n < 16; ++n) g[n] = 0.f;
#pragma unroll
    for (int c = 0; c < 8; ++c) {
        const u32x4 qv = *(const u32x4*)(qrow + 8 * c);
        const float q0 = bflo(qv.x), q1 = bfhi(qv.x), q2 = bflo(qv.y), q3 = bfhi(qv.y), q4 = bflo(qv.z), q5 = bfhi(qv.z), q6 = bflo(qv.w), q7 = bfhi(qv.w);
#pragma unroll
        for (int n = 0; n < 15; ++n) {
            if (n < own) {
                const float* km = (const float*)(lds + KM_OFF) + n * 64 + c * 8;
                const f32x4 k0 = *(const f32x4*)km, k1 = *(const f32x4*)(km + 4);
                g[n] += q0 * k0.x + q1 * k0.y + q2 * k0.z + q3 * k0.w + q4 * k1.x + q5 * k1.y + q6 * k1.z + q7 * k1.w;
            }
        }
    }
    unsigned bm = 0;
#pragma unroll
    for (int pass = 0; pass < 3; ++pass) {
        float best = -INFINITY; int bi = -1;
#pragma unroll
        for (int n = 0; n < 15; ++n)
            if (n < own && !((bm >> n) & 1u) && g[n] > best) { best = g[n]; bi = n; }
        if (bi >= 0) bm |= 1u << bi;
    }
    bm |= 1u << own;
    unsigned um = bm;
    um |= __shfl_xor(um, 16, 64); um |= __shfl_xor(um, 8, 64); um |= __shfl_xor(um, 4, 64); um |= __shfl_xor(um, 2, 64); um |= __shfl_xor(um, 1, 64);
    um = __builtin_amdgcn_readfirstlane(um);
    u64 wt = 0;
#pragma unroll
    for (int n = 0; n < 16; ++n) if ((um >> n) & 1u) wt |= 0xFull << (4 * n);
    wt &= range_bits(0, (q0w + 31) >> 6);
    if (lane == 0) *(u64*)(lds + MISC_OFF + 8 * w) = wt;
    __syncthreads();
    const u64 tiles = *(const u64*)(lds + MISC_OFF) | *(const u64*)(lds + MISC_OFF + 8) | *(const u64*)(lds + MISC_OFF + 16) | *(const u64*)(lds + MISC_OFF + 24);
    f32x16 o[2]; o[0] = zero16(); o[1] = zero16();
    float m = -1e30f, l = 0.f;
    flash<64, 64, FM_MOBA>(lds, qf, bufA + (size_t)b * SEQ * NA + CA_MK + hh * 64, NA, vT + ((size_t)b * NVT + CV_MV + hh * 64) * SEQ, SEQ,
                           tiles, wt, tq, (u64)bm, 0.125f * LOG2E, 0.f, o, m, l);
    l += shx(l, 32);
    const float inv = l > 0.f ? 1.f / l : 0.f;
    write_gated<64>(o, inv, bufZ, (size_t)(b * SEQ + tq), 0 + hh * 64, h, wr);
}

constexpr int PART_OFF = 36864, SELM_OFF = 69632;
DI void nsa_item(const Params& p, char* lds, int b, int g, int qt32, bool wr = true) {
    const int tid = my_tid(), lane = tid & 63, w = tid >> 6, r = lane & 31, h = lane >> 5;
    const bf16_t* bufA = (const bf16_t*)(p.ws + OFF_BUFA);
    const bf16_t* vT = (const bf16_t*)(p.ws + OFF_VT);
    bf16_t* bufZ = (bf16_t*)(p.ws + OFF_BUFZ);
    const bf16_t* kc = (const bf16_t*)(p.ws + OFF_KC) + (size_t)(b * 2 + g) * 256 * 64;
    const bf16_t* vcT = (const bf16_t*)(p.ws + OFF_VCT) + (size_t)(b * 2 + g) * 64 * 256;
    const int q0 = qt32 * 32, tq = q0 + r, hq = g * 4 + w;
    const size_t tokrow = (size_t)(b * SEQ + tq);
    const bf16_t* qrow = bufA + tokrow * NA + CA_NQ + hq * 64;
    bf16x8 qf[4];
    load_q<64>(qf, qrow, h);
    const float sc = 0.125f * LOG2E;
    const bf16_t* gp = bufA + tokrow * NA + CA_GATE + hq * 3;
    const float g_cmp = bf2f(gp[0]), g_slc = bf2f(gp[1]), g_win = bf2f(gp[2]);
    f32x16 tot[2]; tot[0] = zero16(); tot[1] = zero16();
    const int ncmp_tiles = ((q0 >> 4) >> 6) + 1;
    const u64 ctiles = range_bits(0, ncmp_tiles - 1);
    float m = -1e30f, l = 0.f;
    {
        f32x16 o[2]; o[0] = zero16(); o[1] = zero16();
        flash<64, 64, FM_CMP>(lds, qf, kc, 64, vcT, 256, ctiles, ctiles, tq, 0ull, sc, 0.f, o, m, l);
        l += shx(l, 32);
        const float inv = l > 0.f ? 1.f / l : 0.f;
        l = inv;
#pragma unroll
        for (int d = 0; d < 2; ++d)
#pragma unroll
            for (int i = 0; i < 16; ++i) tot[d][i] = o[d][i] * (inv * g_cmp);
    }
#ifndef REP_IMP
#define REP_IMP 1
#endif
    for (int rimp = 0; rimp < REP_IMP; ++rimp) {
        float* part = (float*)(lds + w * 16384 + 8192) + r * 64;
#pragma unroll
        for (int j = 0; j < 32; ++j) part[2 * j + h] = 0.f;
        float prev = 0.f;
#pragma unroll 1
        for (int t4 = 0; t4 < ncmp_tiles; ++t4) {
#pragma unroll
            for (int t = 0; t < 2; ++t) {
                f32x16 s = zero16();
#pragma unroll
                for (int kk = 0; kk < 4; ++kk) {
                    const int krow = 32 * t + r;
                    const bf16x8 kf = *(const bf16x8*)(lds + t4 * 16384 + krow * 128 + (((2 * kk + h) ^ ((krow >> 1) & 7)) * 16));
                    s = MFMA(kf, qf[kk], s);
                }
                const int T = 2 * t4 + t;
#pragma unroll
                for (int c = 0; c < 4; ++c) {
                    float pv[4];
#pragma unroll
                    for (int e = 0; e < 4; ++e) {
                        const int key = 32 * T + 8 * c + 4 * h + e;
                        pv[e] = ((16 * key + 31) <= tq) ? ex2(s[4 * c + e] * sc - m) * l : 0.f;
                    }
                    const float A = 2.f * (pv[0] + pv[1] + pv[2]) + pv[3];
                    const float xch = shx(pv[3], 32);
                    const float add = h ? xch : prev;
                    prev = xch;
                    part[8 * T + 2 * c + h] = A + add;
                }
            }
        }
        __syncthreads();
        const float* pbase = (const float*)(lds + 8192);
#ifndef REP_TOPK
#define REP_TOPK 1
#endif
#pragma unroll 1
        for (int rtk = 0; rtk < REP_TOPK; ++rtk)
#pragma unroll 1
        for (int qq = 8 * w; qq < 8 * w + 8; ++qq) {
            float v = pbase[qq * 64 + lane] + pbase[4096 + qq * 64 + lane] + pbase[2 * 4096 + qq * 64 + lane] + pbase[3 * 4096 + qq * 64 + lane];
            const int own = (q0 + qq) >> 6;
            if (lane == 0 || lane == own || lane == own - 1) v = INFINITY;
            if (lane > own) v = -INFINITY;
            const unsigned key = (v > 0.f) ? __float_as_uint(v) : 0u;
            unsigned T = 0u;
#pragma unroll
            for (int bit = 30; bit >= 0; --bit) {
                const unsigned cand = T | (1u << bit);
                const int cnt = __builtin_popcountll(__ballot(key >= cand));
                T = (cnt >= 16) ? cand : T;
            }
            u64 selm = __ballot(key > T), E = __ballot(key == T);
            int need = 16 - __builtin_popcountll(selm);
            while (need > 0 && E != 0ull) { const u64 low = E & (0ull - E); selm |= low; E ^= low; --need; }
            if (lane == 0) *(u64*)(lds + SELM_OFF + qq * 8) = selm;
        }
        __syncthreads();
    }
    const u64 sel = *(const u64*)(lds + SELM_OFF + r * 8);
    {
        unsigned ulo = (unsigned)sel, uhi = (unsigned)(sel >> 32);
#pragma unroll
        for (int off = 16; off >= 1; off >>= 1) { ulo |= __shfl_xor(ulo, off, 64); uhi |= __shfl_xor(uhi, off, 64); }
        ulo = __builtin_amdgcn_readfirstlane(ulo); uhi = __builtin_amdgcn_readfirstlane(uhi);
        const u64 stiles = (((u64)uhi << 32) | ulo) & range_bits(0, (q0 + 31) >> 6);
        f32x16 o[2]; o[0] = zero16(); o[1] = zero16();
        float m2 = -1e30f, l2 = 0.f;
        flash<64, 64, FM_SLC>(lds, qf, bufA + (size_t)b * SEQ * NA + CA_NKS + g * 64, NA, vT + ((size_t)b * NVT + CV_NVS + g * 64) * SEQ, SEQ,
                              stiles, stiles, tq, sel, sc, 0.f, o, m2, l2);
        l2 += shx(l2, 32);
        const float inv = l2 > 0.f ? 1.f / l2 : 0.f;
#pragma unroll
        for (int d = 0; d < 2; ++d)
#pragma unroll
            for (int i = 0; i < 16; ++i) tot[d][i] += o[d][i] * (inv * g_slc);
    }
    {
        const int lo = (q0 >= 511 ? (q0 - 511) : 0) >> 6;
        const u64 wtl = range_bits(lo, (q0 + 31) >> 6);
        f32x16 o[2]; o[0] = zero16(); o[1] = zero16();
        float m3 = -1e30f, l3 = 0.f;
        flash<64, 64, FM_WIN>(lds, qf, bufA + (size_t)b * SEQ * NA + CA_NKW + g * 64, NA, vT + ((size_t)b * NVT + CV_NVW + g * 64) * SEQ, SEQ,
                              wtl, wtl, tq, 0ull, sc, 0.f, o, m3, l3);
        l3 += shx(l3, 32);
        const float inv = l3 > 0.f ? 1.f / l3 : 0.f;
#pragma unroll
        for (int d = 0; d < 2; ++d)
#pragma unroll
            for (int i = 0; i < 16; ++i) tot[d][i] += o[d][i] * (inv * g_win);
    }
    write_gated<64>(tot, 1.f, bufZ, tokrow, 512 + hq * 64, h, wr);
}

DI void ret_item(const Params& p, char* lds, int layer, int b, int hh, int qt, bool wr = true) {
    const int tid = my_tid(), lane = tid & 63, w = tid >> 6, r = lane & 31, h = lane >> 5;
    const bf16_t* bufA = (const bf16_t*)(p.ws + OFF_BUFA);
    const bf16_t* vT = (const bf16_t*)(p.ws + OFF_VT);
    bf16_t* bufZ = (bf16_t*)(p.ws + OFF_BUFZ);
    const int q0b = qt * 128, q0w = q0b + w * 32, tq = q0w + r;
    const size_t tokrow = (size_t)(b * SEQ + tq);
    bf16x8 qf[4];
    load_q<64>(qf, bufA + tokrow * NA + CA_RQ + hh * 64, h);
    const float lg = ret_lg(hh);
    const int c = qt;
    constexpr int ST_OFF = 49152;
    {
        const int nch = (hh == 0) ? 5 : (hh == 1 ? 9 : (hh == 2 ? 17 : 31));
        const int nprev = c < nch ? c : nch;
        const int dv = tid >> 1, d0 = (tid & 1) * 32;
        const bf16_t* up = (const bf16_t*)(p.ws + OFF_U) + ((size_t)(b * 4 + hh) * 32) * 8192 + tid * 32;
        const float dec = ex2(lg * 128.f);
        f32x4 a[8];
#pragma unroll
        for (int q = 0; q < 8; ++q) a[q] = (f32x4){0.f, 0.f, 0.f, 0.f};
        float f = 1.f;
#pragma unroll 1
        for (int k = 0; k < nprev; k += 4) {
            u32x4 raw[4][4];
#pragma unroll
            for (int kk = 0; kk < 4; ++kk) {
                const int cp = (k + kk < nprev) ? (c - 1 - k - kk) : 0;
                const bf16_t* src = up + (size_t)cp * 8192;
#pragma unroll
                for (int q = 0; q < 4; ++q) raw[kk][q] = *(const u32x4*)(src + 8 * q);
            }
#pragma unroll
            for (int kk = 0; kk < 4; ++kk) {
                const float fw = (k + kk < nprev) ? f : 0.f;
#pragma unroll
                for (int q = 0; q < 4; ++q) {
                    const u32x4 rv = raw[kk][q];
                    a[2 * q] += (f32x4){bflo(rv.x), bfhi(rv.x), bflo(rv.y), bfhi(rv.y)} * fw;
                    a[2 * q + 1] += (f32x4){bflo(rv.z), bfhi(rv.z), bflo(rv.w), bfhi(rv.w)} * fw;
                }
                f *= dec;
            }
        }
#pragma unroll
        for (int q = 0; q < 4; ++q) {
            u32x4 pk = {pack2(a[2 * q].x, a[2 * q].y), pack2(a[2 * q].z, a[2 * q].w), pack2(a[2 * q + 1].x, a[2 * q + 1].y), pack2(a[2 * q + 1].z, a[2 * q + 1].w)};
            const int cidx = (d0 >> 3) + q;
            *(u32x4*)(lds + ST_OFF + dv * 128 + ((cidx ^ ((dv >> 1) & 7)) * 16)) = pk;
        }
    }
    __syncthreads();
    f32x16 o[4];
#pragma unroll
    for (int d = 0; d < 4; ++d) o[d] = zero16();
    if (c > 0) {
        const float cross = ex2(lg * (float)((tq & 127) + 1));
        const bf16_t* qrow = bufA + tokrow * NA + CA_RQ + hh * 64;
#pragma unroll
        for (int t = 0; t < 2; ++t)
#pragma unroll
            for (int ss = 0; ss < 2; ++ss) {
                const int dq = 32 * t + 16 * ss + 4 * h;
                const u32x2 qa = *(const u32x2*)(qrow + dq), qb = *(const u32x2*)(qrow + dq + 8);
                u32x4 pk = {pack2(bflo(qa.x) * cross, bfhi(qa.x) * cross), pack2(bflo(qa.y) * cross, bfhi(qa.y) * cross),
                            pack2(bflo(qb.x) * cross, bfhi(qb.x) * cross), pack2(bflo(qb.y) * cross, bfhi(qb.y) * cross)};
                const bf16x8 pf = __builtin_bit_cast(bf16x8, pk);
#pragma unroll
                for (int d = 0; d < 4; ++d) {
                    const int vrow = 32 * d + r, vkey = (vrow >> 1) & 7, c0 = 4 * t + 2 * ss;
                    const u32x2 lo2 = *(const u32x2*)(lds + ST_OFF + vrow * 128 + ((c0 ^ vkey) * 16) + 8 * h);
                    const u32x2 hi2 = *(const u32x2*)(lds + ST_OFF + vrow * 128 + (((c0 + 1) ^ vkey) * 16) + 8 * h);
                    u32x4 vv = {lo2.x, lo2.y, hi2.x, hi2.y};
                    o[d] = MFMA(__builtin_bit_cast(bf16x8, vv), pf, o[d]);
                }
            }
    }
    const u64 tiles = range_bits(2 * c, 2 * c + 1);
    const u64 wt = range_bits(2 * c, (q0w + 31) >> 6);
    float m = 0.f, l = 0.f;
    flash<64, 128, FM_RET>(lds, qf, bufA + (size_t)b * SEQ * NA + CA_RK + hh * 64, NA, vT + ((size_t)b * NVT + CV_RV + hh * 128) * SEQ, SEQ,
                           tiles, wt, tq, 0ull, ex2(-lg), lg, o, m, l, 2);
    float sm = 0.f;
#pragma unroll
    for (int d = 0; d < 4; ++d)
#pragma unroll
        for (int i = 0; i < 16; ++i) sm += o[d][i];
    sm += shx(sm, 32);
    const float mu = sm * (1.f / 128.f);
    float sq = 0.f;
#pragma unroll
    for (int d = 0; d < 4; ++d)
#pragma unroll
        for (int i = 0; i < 16; ++i) { const float c = o[d][i] - mu; o[d][i] = c; sq += c * c; }
    sq += shx(sq, 32);
    const float rs = rsqrtf(sq * (1.f / 128.f) + EPS);
    const float* gn = p.gn_g + layer * 512 + hh * 128;
#pragma unroll
    for (int d = 0; d < 4; ++d)
#pragma unroll
        for (int c4 = 0; c4 < 4; ++c4) {
            const f32x4 gv = *(const f32x4*)(gn + 32 * d + 8 * c4 + 4 * h);
            o[d][4 * c4] *= gv.x; o[d][4 * c4 + 1] *= gv.y; o[d][4 * c4 + 2] *= gv.z; o[d][4 * c4 + 3] *= gv.w;
        }
    write_gated<128>(o, rs, bufZ, tokrow, 1024 + hh * 128, h, wr);
}

DI void mem_item(const Params& p, char* lds, int b, int hh, int qt, bool wr = true) {
    const int tid = my_tid(), lane = tid & 63, w = tid >> 6, r = lane & 31, h = lane >> 5;
    const bf16_t* bufA = (const bf16_t*)(p.ws + OFF_BUFA);
    bf16_t* bufZ = (bf16_t*)(p.ws + OFF_BUFZ);
    const bf16_t* memK = (const bf16_t*)(p.ws + OFF_MEMK);
    const bf16_t* memVT = (const bf16_t*)(p.ws + OFF_MEMV);
    const int tq = qt * 128 + w * 32 + r;
    const size_t tokrow = (size_t)(b * SEQ + tq);
    bf16x8 qf[8];
    load_q<128>(qf, bufA + tokrow * NA + CA_CQ + hh * 128, h);
    f32x16 o[4];
#pragma unroll
    for (int d = 0; d < 4; ++d) o[d] = zero16();
    float m = -1e30f, l = 0.f;
    flash<128, 128, FM_NONE>(lds, qf, memK + (size_t)b * 256 * 512 + hh * 128, 512, memVT + ((size_t)b * 512 + hh * 128) * 256, 256,
                             0xFull, 0xFull, tq, 0ull, 0.08838834764831845f * LOG2E, 0.f, o, m, l);
    l += shx(l, 32);
    const float inv = l > 0.f ? 1.f / l : 0.f;
    write_gated<128>(o, inv, bufZ, tokrow, 1536 + hh * 128, h, wr);
}

DI void conv_w(const float* __restrict__ W, int ldw, bf16_t* __restrict__ WT, int K, int Ndst, bool mapped, long gtid, long gthreads, bool blocked = false) {
    const long total = (long)Ndst * (K / 8);
    for (long idx = gtid; idx < total; idx += gthreads) {
        const int n = (int)(idx % Ndst), kc = (int)(idx / Ndst);
        const int src = mapped ? in_col_src(n) : n;
        u32x4 o = {0u, 0u, 0u, 0u};
        if (src >= 0) {
            float v[8];
#pragma unroll
            for (int j = 0; j < 8; ++j) v[j] = W[(size_t)(kc * 8 + j) * ldw + src];
            o.x = pack2(v[0], v[1]); o.y = pack2(v[2], v[3]); o.z = pack2(v[4], v[5]); o.w = pack2(v[6], v[7]);
        }
        *(u32x4*)(WT + (blocked ? kbm(n, kc * 8, Ndst) : (size_t)n * K + kc * 8)) = o;
    }
}
DI void conv_layer_weights(const Params& p, int layer, long gtid, long gthreads) {
    conv_w(p.w_in + (size_t)layer * 1024 * 6424, 6424, (bf16_t*)(p.ws + OFF_WIN), 1024, NIN, true, gtid, gthreads, true);
    conv_w(p.w_out + (size_t)layer * 2048 * 1024, 1024, (bf16_t*)(p.ws + OFF_WOUT), 2048, 1024, false, gtid, gthreads, true);
    conv_w(p.w_mem + (size_t)layer * 1024 * 1024, 1024, (bf16_t*)(p.ws + OFF_WMEM), 1024, 1024, false, gtid, gthreads);
    conv_w(p.w1_k + (size_t)layer * 2048 * 128, 128, (bf16_t*)(p.ws + OFF_W1K), 2048, 128, false, gtid, gthreads);
    conv_w(p.w1_v + (size_t)layer * 2048 * 128, 128, (bf16_t*)(p.ws + OFF_W1V), 2048, 128, false, gtid, gthreads);
}
DI void cmp_bias(const Params& p, int layer, char* lds) {
    const int bb = blockIdx.x;
    if (bb >= 32) return;
    const int which = bb >> 4, pt = bb & 15;
    const float* pe = (which ? p.pe_v : p.pe_k) + (size_t)layer * 2048;
    const float* w1 = (which ? p.w1_v : p.w1_k) + (size_t)layer * 2048 * 128;
    float* part = (float*)(p.ws + OFF_BIAS) + (which * 16 + pt) * 128;
    const int tid = my_tid(), j = tid & 127, half = tid >> 7;
    float s0 = 0.f, s1 = 0.f, s2 = 0.f, s3 = 0.f;
    const int kb = pt * 128 + half * 64;
#pragma unroll 4
    for (int k = kb; k < kb + 64; k += 4) {
        s0 += pe[k] * w1[(size_t)k * 128 + j];
        s1 += pe[k + 1] * w1[(size_t)(k + 1) * 128 + j];
        s2 += pe[k + 2] * w1[(size_t)(k + 2) * 128 + j];
        s3 += pe[k + 3] * w1[(size_t)(k + 3) * 128 + j];
    }
    float* red = (float*)lds;
    red[tid] = (s0 + s1) + (s2 + s3);
    __syncthreads();
    if (tid < 128) part[tid] = red[tid] + red[tid + 128];
    __syncthreads();
}
DI void rms_rows(const float* __restrict__ X, const float* __restrict__ g, bf16_t* __restrict__ H, int nrows, bool blocked) {
    const int lane = my_tid() & 63, w = my_tid() >> 6;
    for (int row = blockIdx.x * 4 + w; row < nrows; row += gridDim.x * 4) {
        const float* xr = X + (size_t)row * DM;
        f32x4 v[4];
        float ss = 0.f;
#pragma unroll
        for (int j = 0; j < 4; ++j) { v[j] = *(const f32x4*)(xr + lane * 4 + 256 * j); ss += v[j].x * v[j].x + v[j].y * v[j].y + v[j].z * v[j].z + v[j].w * v[j].w; }
        ss = wave_sum(ss);
        const float rs = rsqrtf(ss * (1.f / DM) + EPS);
#pragma unroll
        for (int j = 0; j < 4; ++j) {
            const f32x4 gv = *(const f32x4*)(g + lane * 4 + 256 * j);
            u32x2 o = {pack2(v[j].x * rs * gv.x, v[j].y * rs * gv.y), pack2(v[j].z * rs * gv.z, v[j].w * rs * gv.w)};
            *(u32x2*)(H + (blocked ? kbm(row, lane * 4 + 256 * j, nrows) : (size_t)row * DM + lane * 4 + 256 * j)) = o;
        }
    }
}
DI void resid_rows(const float* __restrict__ Xold, const bf16_t* __restrict__ Y, const float* __restrict__ pg, float* __restrict__ Out,
                   const float* __restrict__ g_next, bf16_t* __restrict__ H) {
    const int lane = my_tid() & 63, w = my_tid() >> 6;
    for (int row = blockIdx.x * 4 + w; row < NTOK; row += gridDim.x * 4) {
        const bf16_t* yr = Y + (size_t)row * DM;
        const float* xr = Xold + (size_t)row * DM;
        f32x4 v[4], xv[4];
        float ss = 0.f;
#pragma unroll
        for (int j = 0; j < 4; ++j) { const u32x2 yy = *(const u32x2*)(yr + lane * 4 + 256 * j); v[j] = (f32x4){bflo(yy.x), bfhi(yy.x), bflo(yy.y), bfhi(yy.y)}; xv[j] = *(const f32x4*)(xr + lane * 4 + 256 * j); ss += v[j].x * v[j].x + v[j].y * v[j].y + v[j].z * v[j].z + v[j].w * v[j].w; }
        ss = wave_sum(ss);
        const float rs = rsqrtf(ss * (1.f / DM) + EPS);
        float s2 = 0.f;
#pragma unroll
        for (int j = 0; j < 4; ++j) {
            const f32x4 gv = *(const f32x4*)(pg + lane * 4 + 256 * j);
            xv[j].x += v[j].x * rs * gv.x; xv[j].y += v[j].y * rs * gv.y; xv[j].z += v[j].z * rs * gv.z; xv[j].w += v[j].w * rs * gv.w;
            *(f32x4*)(Out + (size_t)row * DM + lane * 4 + 256 * j) = xv[j];
            s2 += xv[j].x * xv[j].x + xv[j].y * xv[j].y + xv[j].z * xv[j].z + xv[j].w * xv[j].w;
        }
        if (g_next) {
            s2 = wave_sum(s2);
            const float r2 = rsqrtf(s2 * (1.f / DM) + EPS);
#pragma unroll
            for (int j = 0; j < 4; ++j) {
                const f32x4 gv = *(const f32x4*)(g_next + lane * 4 + 256 * j);
                u32x2 o = {pack2(xv[j].x * r2 * gv.x, xv[j].y * r2 * gv.y), pack2(xv[j].z * r2 * gv.z, xv[j].w * r2 * gv.w)};
                *(u32x2*)(H + kbm(row, lane * 4 + 256 * j, NTOK)) = o;
            }
        }
    }
}
DI void rope_table(const Params& p, long gtid, long gthreads) {
    f32x2* tab = (f32x2*)(p.ws + OFF_ROPE);
    for (long idx = gtid; idx < (long)SEQ * 32; idx += gthreads) {
        const int s = (int)(idx >> 5), i = (int)(idx & 31);
        const float invf = (float)(1.0 / pow(10000.0, (double)i / 31.0));
        const float ang = (float)s * invf;
        const double a = (double)ang;
        const double k = rint(a * 0.15915494309189535);
        const float rr = (float)(a - k * 6.283185307179586);
        f32x2 cs = {cosf(rr), sinf(rr)};
        tab[idx] = cs;
    }
}

#define XB_TMO      128
#define XB_XCNT(j)  (256  + 64 * (j))
#define XB_XSUB(j)  (1280 + 64 * (j))
#define XB_XGEN(j)  (2304 + 64 * (j))
#define XB_TOP      3328
#define XB_TOPGEN   3392
#define XCD_BAR_WORDS 3456
#define XB_SPIN_CAP (1u << 18)
#define LAS __attribute__((address_space(3)))
DI unsigned xb_ld(unsigned* p) { return __hip_atomic_load(p, __ATOMIC_RELAXED, __HIP_MEMORY_SCOPE_AGENT); }
DI unsigned xb_add(unsigned* p, unsigned v) { return __hip_atomic_fetch_add(p, v, __ATOMIC_RELAXED, __HIP_MEMORY_SCOPE_AGENT); }
DI unsigned xb_xcc_id() { return (unsigned)__builtin_amdgcn_s_getreg((3 << 11) | 20) & 0xFu; }
#define XB_SPIN(cond, bar) do { unsigned _sp = 0; while (cond) { __builtin_amdgcn_s_sleep(1); \
    if ((++_sp & 255u) == 0u) { if (xb_ld(&(bar)[XB_TMO])) break; if (_sp > XB_SPIN_CAP) { atomicAdd(&(bar)[XB_TMO], 1u); break; } } } } while (0)
struct XcdBarrier { unsigned* bar; unsigned x; volatile LAS unsigned* st; };
DI XcdBarrier xcd_barrier_post(unsigned* bar, volatile LAS unsigned* st) {
    XcdBarrier b; b.bar = bar; b.x = xb_xcc_id(); b.st = st;
    if (threadIdx.x == 0) (void)xb_add(&bar[XB_XCNT(b.x)], 1u);
    return b;
}
DI void xcd_barrier_complete(unsigned* bar, unsigned x, unsigned& nloc, unsigned& nx) {
    const unsigned G = gridDim.x * gridDim.y * gridDim.z;
    unsigned sum, cnt, mine, sp = 0u;
    for (;;) {
        sum = 0u; cnt = 0u; mine = 0u;
#pragma unroll
        for (unsigned j = 0; j < 16; ++j) { const unsigned c = xb_ld(&bar[XB_XCNT(j)]); sum += c; cnt += (c > 0u) ? 1u : 0u; mine = (j == x) ? c : mine; }
        if (sum == G) break;
        __builtin_amdgcn_s_sleep(1);
        if ((++sp & 255u) == 0u) { if (xb_ld(&bar[XB_TMO])) break; if (sp > XB_SPIN_CAP) { atomicAdd(&bar[XB_TMO], 1u); break; } }
    }
    nloc = mine > 0u ? mine : 1u; nx = cnt > 0u ? cnt : 1u;
}
DI void xcd_barrier(const XcdBarrier& b) {
    asm volatile("s_waitcnt vmcnt(0)" ::: "memory");
    __syncthreads();
    if (threadIdx.x == 0) {
        unsigned* bar = b.bar;
        __builtin_amdgcn_s_waitcnt(0);
        unsigned nloc = b.st[0], nx = b.st[1];
        if (nloc == 0u) { xcd_barrier_complete(bar, b.x, nloc, nx); b.st[0] = nloc; b.st[1] = nx; }
        const unsigned old = xb_add(&bar[XB_XSUB(b.x)], 1u);
        const unsigned gen = old / nloc;
        if (old + 1u == (gen + 1u) * nloc) {
            __builtin_amdgcn_fence(__ATOMIC_RELEASE, "agent");
            asm volatile("s_waitcnt vmcnt(0)" ::: "memory");
            const unsigned og = xb_add(&bar[XB_TOP], 1u);
            const unsigned tg = og / nx;
            if (og + 1u == (tg + 1u) * nx) xb_add(&bar[XB_TOPGEN], 1u);
            else XB_SPIN(xb_ld(&bar[XB_TOPGEN]) == tg, bar);
            __builtin_amdgcn_fence(__ATOMIC_ACQUIRE, "agent");
            xb_add(&bar[XB_XGEN(b.x)], 1u);
            asm volatile("s_waitcnt vmcnt(0)" ::: "memory");
        } else {
            XB_SPIN(xb_ld(&bar[XB_XGEN(b.x)]) == gen, bar);
            __builtin_amdgcn_fence(__ATOMIC_ACQUIRE, "agent");
            asm volatile("s_waitcnt vmcnt(0)" ::: "memory");
        }
    }
    __syncthreads();
}

__global__ __launch_bounds__(256, 2) void mega(Params p) {
    __shared__ __attribute__((aligned(16))) char lds[LDS_BYTES];
    __shared__ int s_item;
    __shared__ float s_bias[128];
    cg::grid_group grid = cg::this_grid();
    __shared__ uint4 xb_words;
    if (threadIdx.x == 0) xb_words = make_uint4(0u, 0u, 0u, 0u);
    __syncthreads();
    const XcdBarrier xb = xcd_barrier_post((unsigned*)(p.ws + OFF_BAR), (volatile LAS unsigned*)&xb_words);
#define GTID ((long)blockIdx.x * 256 + my_tid())
#define GTHREADS ((long)gridDim.x * 256)
    bf16_t* hbuf = (bf16_t*)(p.ws + OFF_H);
    unsigned* ctr = (unsigned*)(p.ws + OFF_CTR);

    if (GTID < 256) ctr[GTID] = 0u;
    for (int r0 = 0; r0 < REP0; ++r0) {
#ifndef SKIP_CONV
    conv_layer_weights(p, 0, GTID, GTHREADS);
#endif
    rope_table(p, GTID, GTHREADS);
#ifndef SKIP_BIAS
    cmp_bias(p, 0, lds);
#endif
    rms_rows(p.x, p.pre_g, hbuf, NTOK, true);
    rms_rows(p.mem, p.mem_g, (bf16_t*)(p.ws + OFF_MEMN), 2048, false);
    if (p.ws == nullptr) grid.sync();
    xcd_barrier(xb);
    }

#ifdef EXTRA_SYNCS
    for (int es = 0; es < EXTRA_SYNCS; ++es) grid.sync();
#endif
#pragma unroll 1
    for (int layer = 0; layer < 2; ++layer) {
        for (int r123 = 0; r123 < REP123; ++r123) {
        for (int r1 = 0; r1 < REP1; ++r1) {
#ifndef SKIP_P1
        {
            const bf16_t* winT = (const bf16_t*)(p.ws + OFF_WIN);
            const f32x2* rope = (const f32x2*)(p.ws + OFF_ROPE);
            const int xcd = blockIdx.x & 7, li = blockIdx.x >> 3, nb = (gridDim.x + 7 - xcd) >> 3;
#pragma unroll 1
            for (int q = li; q < 832; q += nb) {
                const int q1 = q / 208, q2 = q - q1 * 208;
                int nt, ml;
                if (q2 < 192) { const int ng = q2 >> 6, in = q2 & 63; nt = 8 * ng + (in & 7); ml = in >> 3; }
                else { const int q3 = q2 - 192; nt = 24 + (q3 & 1); ml = q3 >> 1; }
                const int mt = 32 * xcd + 8 * q1 + ml;
                const bf16_t* A = hbuf + (size_t)mt * 128 * 32;
                const bf16_t* Bt = winT + (size_t)nt * 256 * 32;
                if (nt >= 12 && nt < 17) {
                    EpiVT e{(bf16_t*)(p.ws + OFF_VT), NVT, SEQ, mt * 128, nt * 256 - 3072};
                    gemm_wide<false>(lds, A, ARowLin{32}, Bt, 32, 16, e, (long)NTOK * 32, (long)NIN * 32);
                } else {
                    EpiRow e;
                    e.rope = rope; e.row0 = mt * 128;
                    if (nt < 12) { e.dst = (bf16_t*)(p.ws + OFF_BUFA); e.ld = NA; e.col0 = nt * 256; e.mode = (nt == 8) ? EM_ROPEQ : ((nt == 9) ? EM_ROPEK : EM_PLAIN); e.rkt = (nt == 9) ? (bf16_t*)(p.ws + OFF_RKT) : nullptr; }
                    else if (nt < 25) { e.dst = (bf16_t*)(p.ws + OFF_BUFZ); e.ld = NZ; e.col0 = (nt - 17) * 256; e.mode = EM_SILU; e.zblk = true; }
                    else { e.dst = (bf16_t*)(p.ws + OFF_BUFA); e.ld = NA; e.col0 = CA_GATE; e.mode = EM_GATE; }
                    gemm_wide<true>(lds, A, ARowLin{32}, Bt, 32, 16, e, (long)NTOK * 32, (long)NIN * 32);
                }
            }
        }
#endif
        xcd_barrier(xb);
        }
        for (int r2 = 0; r2 < REP2; ++r2) {
#ifndef SKIP_P2
        {
            const bf16_t* bufA = (const bf16_t*)(p.ws + OFF_BUFA);
            float* kmean = (float*)(p.ws + OFF_KMEAN);
            const int n_km = 8 * 16 * 4, n_cmp = 256, n_mem = 16 * 4, n_u = 8 * 4 * 32;
#pragma unroll 1
            for (int t = blockIdx.x; t < n_cmp + n_km + n_mem + n_u; t += gridDim.x) {
                if (t >= n_cmp + n_km + n_mem) {
                    const int u = t - (n_cmp + n_km + n_mem), c = u & 31, bh = u >> 5, b = bh >> 2, hh = bh & 3;
                    const int tid = my_tid(), lane = tid & 63, w = tid >> 6, r = lane & 31, h = lane >> 5;
                    const bf16_t* vtp = (const bf16_t*)(p.ws + OFF_VT) + ((size_t)b * NVT + CV_RV + hh * 128 + 32 * w + r) * SEQ + c * 128 + 8 * h;
                    const bf16_t* ktp = (const bf16_t*)(p.ws + OFF_RKT) + ((size_t)(b * 4 + hh) * 64 + r) * SEQ + c * 128 + 8 * h;
                    f32x16 u0 = zero16(), u1 = zero16();
#pragma unroll
                    for (int kk = 0; kk < 8; ++kk) {
                        const bf16x8 xf = *(const bf16x8*)(vtp + 16 * kk);
                        const bf16x8 y0 = *(const bf16x8*)(ktp + 16 * kk), y1 = *(const bf16x8*)(ktp + (size_t)32 * SEQ + 16 * kk);
                        u0 = MFMA(xf, y0, u0); u1 = MFMA(xf, y1, u1);
                    }
                    bf16_t* up = (bf16_t*)(p.ws + OFF_U) + (size_t)u * 8192;
#pragma unroll
                    for (int i = 0; i < 16; ++i) {
                        up[(32 * w + crow(i, h)) * 64 + r] = (bf16_t)(pack2(u0[i], 0.f) & 0xffffu);
                        up[(32 * w + crow(i, h)) * 64 + 32 + r] = (bf16_t)(pack2(u1[i], 0.f) & 0xffffu);
                    }
                } else if (t >= n_cmp + n_km) {
                    const int u = t - n_cmp - n_km, mt = u >> 2, nt = u & 3;
                    const bf16_t* A = (const bf16_t*)(p.ws + OFF_MEMN) + (size_t)mt * 128 * 1024;
                    const bf16_t* Bt = (const bf16_t*)(p.ws + OFF_WMEM) + (size_t)nt * 256 * 1024;
                    if (nt >= 2) {
                        EpiVT e{(bf16_t*)(p.ws + OFF_MEMV), 512, 256, mt * 128, nt * 256 - 512};
                        gemm_wide<false>(lds, A, ARowLin{1024}, Bt, 1024, 16, e);
                    } else {
                        EpiRow e; e.rope = nullptr; e.row0 = mt * 128; e.dst = (bf16_t*)(p.ws + OFF_MEMK); e.ld = 512; e.col0 = nt * 256; e.mode = EM_PLAIN;
                        gemm_wide<true>(lds, A, ARowLin{1024}, Bt, 1024, 16, e);
                    }
                } else if (t < n_cmp) {
                    const int tileid = t >> 2, split = t & 3, isv = tileid >> 5, mt = tileid & 31;
                    float* cpart = (float*)(p.ws + OFF_CPART) + (size_t)tileid * 4 * 64 * 256;
                    {
                        EpiPart ep{cpart + (size_t)split * 64 * 256};
                        gemm_tile<true>(lds, bufA + (size_t)split * 8 * NA, ARowCmp{mt * 128, isv ? CA_NVC : CA_NKC}, NA,
                                        (const bf16_t*)(p.ws + (isv ? OFF_W1V : OFF_W1K)) + split * 512, 2048, 8, ep);
                    }
                    __threadfence();
                    __syncthreads();
                    if (my_tid() == 0) s_item = (int)atomicAdd(ctr + 64 + layer * 64 + tileid, 1u);
                    __syncthreads();
                    const bool last = (s_item == 3);
                    __syncthreads();
                    if (!last) continue;
                    __threadfence();
                    float* lbias = s_bias;
                    if (my_tid() < 128) {
                        const float* part = (const float*)(p.ws + OFF_BIAS) + isv * 16 * 128 + my_tid();
                        float bsum = 0.f;
#pragma unroll
                        for (int q = 0; q < 16; ++q) bsum += part[q * 128];
                        lbias[my_tid()] = bsum;
                    }
                    __syncthreads();
                    {
                        const int tid2 = my_tid(), row = tid2 >> 1, c0 = (tid2 & 1) * 64;
                        const float* pp = cpart + row * 128 + c0;
#pragma unroll 4
                        for (int cg = 0; cg < 16; ++cg) {
                            const f32x4 a0 = *(const f32x4*)(pp + cg * 4), a1 = *(const f32x4*)(pp + 16384 + cg * 4);
                            const f32x4 a2 = *(const f32x4*)(pp + 2 * 16384 + cg * 4), a3 = *(const f32x4*)(pp + 3 * 16384 + cg * 4);
                            const f32x4 sm = ((a0 + a1) + a2) + a3;
                            const f32x4 bv = *(const f32x4*)(lbias + c0 + cg * 4);
                            u32x2 o = {pack2(silu_f(sm.x + bv.x), silu_f(sm.y + bv.y)), pack2(silu_f(sm.z + bv.z), silu_f(sm.w + bv.w))};
                            *(u32x2*)(lds + row * HSTR + (c0 + cg * 4) * 2) = o;
                        }
                    }
                    __syncthreads();
                    const float* w2 = (isv ? p.w2_v : p.w2_k) + (size_t)layer * 128 * 64;
                    const int tid = my_tid(); const int c = tid & 63, rg = tid >> 6;
                    float* w2s = (float*)(lds + 36864);
#pragma unroll
                    for (int q = 0; q < 8; ++q) *(f32x4*)(w2s + (q * 256 + tid) * 4) = *(const f32x4*)(w2 + (q * 256 + tid) * 4);
                    __syncthreads();
                    float a32[32];
#pragma unroll
                    for (int rr = 0; rr < 32; ++rr) a32[rr] = 0.f;
#pragma unroll 2
                    for (int k = 0; k < 128; k += 2) {
                        const float w0 = w2s[k * 64 + c], w1 = w2s[(k + 1) * 64 + c];
#pragma unroll
                        for (int rr = 0; rr < 32; ++rr) {
                            const unsigned u = *(const unsigned*)(lds + (rg * 32 + rr) * HSTR + k * 2);
                            a32[rr] += bflo(u) * w0 + bfhi(u) * w1;
                        }
                    }
                    bf16_t* kcb = (bf16_t*)(p.ws + OFF_KC);
                    bf16_t* vcb = (bf16_t*)(p.ws + OFF_VCT);
#pragma unroll
                    for (int rr = 0; rr < 32; ++rr) {
                        const int R = mt * 128 + rg * 32 + rr, bg = R >> 8, i = R & 255;
                        const bf16_t val = (bf16_t)(pack2(a32[rr], 0.f) & 0xffffu);
                        if (isv) vcb[((size_t)bg * 64 + c) * 256 + i] = val; else kcb[((size_t)bg * 256 + i) * 64 + c] = val;
                    }
                    __syncthreads();
                } else {
                    const int u = t - n_cmp, qd = u & 3, n = (u >> 2) & 15, b = u >> 6;
                    const int tid = my_tid(); const int cp = tid & 63, kg = tid >> 6;
                    const bf16_t* src = bufA + (size_t)(b * SEQ + n * 256 + kg * 64) * NA + CA_MK + qd * 128 + 2 * cp;
                    float s0 = 0.f, s1 = 0.f;
                    for (int k = 0; k < 64; ++k) { const unsigned uu = *(const unsigned*)(src + (size_t)k * NA); s0 += bflo(uu); s1 += bfhi(uu); }
                    float* red = (float*)lds;
                    red[kg * 128 + 2 * cp] = s0; red[kg * 128 + 2 * cp + 1] = s1;
                    __syncthreads();
                    if (tid < 128) {
                        const float sum = red[tid] + red[128 + tid] + red[256 + tid] + red[384 + tid];
                        const int hh = qd * 2 + (tid >> 6), d = tid & 63;
                        kmean[((size_t)(b * 8 + hh) * 16 + n) * 64 + d] = sum * (1.f / 256.f);
                    }
                    __syncthreads();
                }
            }
        }
#endif
        xcd_barrier(xb);
        }
#ifndef SKIP_P3
        {
            int qsel = blockIdx.x & 7, qtried = 0;
#pragma unroll 1
            while (true) {
                if (my_tid() == 0) s_item = (int)atomicAdd(ctr + layer * 32 + r123 * 16 + qsel, 1u);
                __syncthreads();
                const int id = s_item;
                __syncthreads();
                if (id >= 768) { if (++qtried >= 8) break; qsel = (qsel + 1) & 7; continue; }
                const int b = qsel;
                if (id < 256) {
#ifndef SKIP_NSA
                    for (int rp = 0; rp < REP_NSA; ++rp) nsa_item(p, lds, b, id >> 7, 127 - (id & 127), rp == REP_NSA - 1);
#endif
                } else if (id < 512) {
#ifndef SKIP_MOBA
                    const int u = id - 256; for (int rp = 0; rp < REP_MOBA; ++rp) moba_item(p, lds, b, u >> 5, 31 - (u & 31), rp == REP_MOBA - 1);
#endif
                } else if (id < 640) {
#ifndef SKIP_RET
                    const int u = id - 512; for (int rp = 0; rp < REP_RET; ++rp) ret_item(p, lds, layer, b, u >> 5, 31 - (u & 31), rp == REP_RET - 1);
#endif
                } else {
#ifndef SKIP_MEM
                    const int u = id - 640; for (int rp = 0; rp < REP_MEM; ++rp) mem_item(p, lds, b, u >> 5, u & 31, rp == REP_MEM - 1);
#endif
                }
            }
        }
#endif
        xcd_barrier(xb);
        }
        for (int r4 = 0; r4 < REP4; ++r4) {
#ifndef SKIP_P4
        {
            const bf16_t* bufZ = (const bf16_t*)(p.ws + OFF_BUFZ);
            const bf16_t* woT = (const bf16_t*)(p.ws + OFF_WOUT);
            const int xcd = blockIdx.x & 7, li = blockIdx.x >> 3, nb = (gridDim.x + 7 - xcd) >> 3;
#pragma unroll 1
            for (int q = li; q < 128; q += nb) {
                const int mt = 32 * xcd + (q >> 2), nt = q & 3;
                EpiY e{(bf16_t*)(p.ws + OFF_Y), mt * 128, nt * 256};
                gemm_wide<true>(lds, bufZ + (size_t)mt * 128 * 32, ARowLin{32}, woT + (size_t)nt * 256 * 32, 32, 32, e, (long)NTOK * 32, (long)1024 * 32);
            }
        }
#endif
        xcd_barrier(xb);
        }
        {
            const float* xold = layer == 0 ? p.x : p.out;
            resid_rows(xold, (const bf16_t*)(p.ws + OFF_Y), p.post_g + layer * DM, p.out, layer == 0 ? p.pre_g + DM : nullptr, hbuf);
            if (layer == 0) {
                conv_layer_weights(p, 1, GTID, GTHREADS);
                cmp_bias(p, 1, lds);
                rms_rows(p.mem, p.mem_g + DM, (bf16_t*)(p.ws + OFF_MEMN), 2048, false);
                xcd_barrier(xb);
            }
        }
    }
}

extern "C" void kernel_launch(void* const* d_in, const int* in_sizes, int n_in, void* d_out, int out_size, void* d_ws, size_t ws_size, hipStream_t stream) {
    static int grid_blocks = 0;
    if (!grid_blocks) {
        int dev = 0, cus = 0, per_cu = 0;
        hipGetDevice(&dev);
        hipDeviceGetAttribute(&cus, hipDeviceAttributeMultiprocessorCount, dev);
        hipOccupancyMaxActiveBlocksPerMultiprocessor(&per_cu, mega, 256, 0);
        if (per_cu < 1) per_cu = 1;
        if (per_cu > 2) per_cu = 2;
#ifdef FORCE_PER_CU
        per_cu = FORCE_PER_CU;
#endif
        grid_blocks = cus * per_cu;
    }
    if (ws_size < WS_NEED) fprintf(stderr, "workspace too small: %zu < %zu\n", ws_size, (size_t)WS_NEED);
    Params p{};
    p.x = (const float*)d_in[0]; p.mem = (const float*)d_in[1]; p.pre_g = (const float*)d_in[2]; p.post_g = (const float*)d_in[3];
    p.mem_g = (const float*)d_in[4]; p.w_in = (const float*)d_in[5]; p.w_mem = (const float*)d_in[6]; p.pe_k = (const float*)d_in[7];
    p.w1_k = (const float*)d_in[8]; p.w2_k = (const float*)d_in[9]; p.pe_v = (const float*)d_in[10]; p.w1_v = (const float*)d_in[11];
    p.w2_v = (const float*)d_in[12]; p.gn_g = (const float*)d_in[13]; p.w_out = (const float*)d_in[14];
    p.out = (float*)d_out; p.ws = (char*)d_ws;
    (void)hipMemsetAsync((char*)d_ws + OFF_BAR, 0, XCD_BAR_WORDS * 4, stream);
    void* args[] = {&p};
    hipError_t e = hipLaunchCooperativeKernel((void*)mega, dim3(grid_blocks), dim3(256), args, 0, stream);
    if (e != hipSuccess) fprintf(stderr, "cooperative launch failed: %s (grid %d)\n", hipGetErrorString(e), grid_blocks);
}
```

```cpp
#include <hip/hip_runtime.h>
#include <hip/hip_cooperative_groups.h>
#include <stdint.h>
#include <cstdio>
namespace cg = cooperative_groups;

typedef unsigned short bf16_t;
typedef short bf16x8 __attribute__((ext_vector_type(8)));
typedef float f32x16 __attribute__((ext_vector_type(16)));
typedef float f32x4 __attribute__((ext_vector_type(4)));
typedef float f32x2 __attribute__((ext_vector_type(2)));
typedef unsigned u32x4 __attribute__((ext_vector_type(4)));
typedef unsigned u32x2 __attribute__((ext_vector_type(2)));
typedef __bf16 bf16v2 __attribute__((ext_vector_type(2)));
typedef unsigned long long u64;
#define DI __device__ __forceinline__
#define MFMA(a, b, c) __builtin_amdgcn_mfma_f32_32x32x16_bf16((a), (b), (c), 0, 0, 0)

constexpr int SEQ = 4096, DM = 1024, NTOK = 32768;
constexpr int NA = 3096;
constexpr int NZ = 2048;
constexpr int NVT = 1280;
constexpr int NIN = 6656;
constexpr float EPS = 1e-6f;
DI size_t kbm(int row, int k, int nrows) { return ((size_t)(k >> 5) * nrows + row) * 32 + (k & 31); }
constexpr float LOG2E = 1.4426950408889634f;

constexpr int CA_MQ = 0, CA_MK = 512, CA_NQ = 1024, CA_NKC = 1536, CA_NVC = 1664, CA_NKS = 1792, CA_NKW = 1920,
              CA_RQ = 2048, CA_RK = 2304, CA_CQ = 2560, CA_GATE = 3072;
constexpr int CV_MV = 0, CV_NVS = 512, CV_NVW = 640, CV_RV = 768;

constexpr size_t OFF_BUFA = 0;
constexpr size_t OFF_VT   = OFF_BUFA + (size_t)NTOK * NA * 2;
constexpr size_t OFF_BUFZ = OFF_VT + (size_t)8 * NVT * SEQ * 2;
constexpr size_t OFF_H    = OFF_BUFZ + (size_t)NTOK * NZ * 2;
constexpr size_t OFF_WIN  = OFF_H + (size_t)NTOK * DM * 2;
constexpr size_t OFF_WOUT = OFF_WIN + (size_t)NIN * 1024 * 2;
constexpr size_t OFF_WMEM = OFF_WOUT + (size_t)1024 * 2048 * 2;
constexpr size_t OFF_W1K  = OFF_WMEM + (size_t)1024 * 1024 * 2;
constexpr size_t OFF_W1V  = OFF_W1K + (size_t)128 * 2048 * 2;
constexpr size_t OFF_ROPE = OFF_W1V + (size_t)128 * 2048 * 2;
constexpr size_t OFF_MEMN = OFF_ROPE + (size_t)SEQ * 32 * 8;
constexpr size_t OFF_MEMK = OFF_MEMN + (size_t)2048 * 1024 * 2;
constexpr size_t OFF_MEMV = OFF_MEMK + (size_t)2048 * 512 * 2;
constexpr size_t OFF_BIAS = OFF_MEMV + (size_t)8 * 512 * 256 * 2;
constexpr size_t OFF_CTR  = OFF_BIAS + 16384;
constexpr size_t OFF_BAR  = OFF_CTR + 1024;
constexpr size_t OFF_RKT  = OFF_BAR + 16384;
constexpr size_t WS_NEED  = OFF_RKT + (size_t)8 * 4 * 64 * SEQ * 2;
constexpr size_t OFF_KMEAN = OFF_H;
constexpr size_t OFF_KC    = OFF_KMEAN + (size_t)8 * 8 * 16 * 64 * 4;
constexpr size_t OFF_VCT   = OFF_KC + (size_t)16 * 256 * 64 * 2;
constexpr size_t OFF_U = OFF_H + ((size_t)24 << 20);
constexpr size_t OFF_CPART = OFF_H + ((size_t)4 << 20);
constexpr size_t OFF_Y = OFF_BUFA;

constexpr int LDS_BYTES = 73728;
#ifndef REP1
#define REP1 1
#endif
#ifndef REP_NSA
#define REP_NSA 1
#endif
#ifndef REP_MOBA
#define REP_MOBA 1
#endif
#ifndef REP_RET
#define REP_RET 1
#endif
#ifndef REP_MEM
#define REP_MEM 1
#endif
#ifndef REP0
#define REP0 1
#endif
#ifndef REP2
#define REP2 1
#endif
#ifndef REP4
#define REP4 1
#endif
#ifndef REP123
#define REP123 1
#endif

struct Params {
    const float *x, *mem, *pre_g, *post_g, *mem_g, *w_in, *w_mem, *pe_k, *w1_k, *w2_k, *pe_v, *w1_v, *w2_v, *gn_g, *w_out;
    float* out;
    char* ws;
};

DI int my_tid() { int t = threadIdx.x; asm volatile("" : "+v"(t)); return t; }
DI unsigned pack2(float a, float b) { f32x2 v = {a, b}; bf16v2 r = __builtin_convertvector(v, bf16v2); return __builtin_bit_cast(unsigned, r); }
DI float bflo(unsigned u) { return __uint_as_float(u << 16); }
DI float bfhi(unsigned u) { return __uint_as_float(u & 0xffff0000u); }
DI float bf2f(bf16_t v) { return __uint_as_float(((unsigned)v) << 16); }
DI int crow(int reg, int h) { return (reg & 3) + 8 * (reg >> 2) + 4 * h; }
DI float ex2(float x) { return __builtin_amdgcn_exp2f(x); }
DI float ret_lg(int hh) { return (hh == 0) ? -0.045803688f : (hh == 1 ? -0.022720077f : (hh == 2 ? -0.011315314f : -0.0056465633f)); }
DI float mx2(float a, float b) { return __builtin_amdgcn_fmed3f(a, b, INFINITY); }
DI float shx(float v, int m) { return __shfl_xor(v, m, 64); }
DI float wave_sum(float v) { v += shx(v, 32); v += shx(v, 16); v += shx(v, 8); v += shx(v, 4); v += shx(v, 2); v += shx(v, 1); return v; }
DI float silu_f(float v) { return v * __builtin_amdgcn_rcpf(1.f + __expf(-v)); }
DI float sigm_f(float v) { return __builtin_amdgcn_rcpf(1.f + __expf(-v)); }
DI f32x16 zero16() { f32x16 z; for (int i = 0; i < 16; ++i) z[i] = 0.f; return z; }

DI int in_col_src(int n) {
    if (n < 1024) return n;
    if (n < 1920) return n + 512;
    if (n < 2048) return n + 640;
    if (n < 2560) return n + 792;
    if (n < 3072) return n + 1304;
    if (n < 3584) return n - 2048;
    if (n < 3712) return n - 1152;
    if (n < 3840) return n - 1024;
    if (n < 4352) return n - 488;
    if (n < 6400) return n + 24;
    if (n < 6424) return n - 3584;
    return -1;
}

constexpr int GSTR = 144;
constexpr int GBUF = 36864;
constexpr int GBOFF = 18432;

DI void glds16(const void* g, unsigned lds_addr);
template <int N> DI void wait_vm();
#define RAW_BARRIER() do { asm volatile("s_waitcnt lgkmcnt(0)" ::: "memory"); __builtin_amdgcn_s_barrier(); asm volatile("" ::: "memory"); } while (0)
template <bool SWAP, class AOff, class Epi>
DI void gemm_tile(char* lds, const bf16_t* __restrict__ A, AOff aoff, long a_kstride, const bf16_t* __restrict__ Bt, long ldb, int nk64, Epi epi) {
    constexpr int TB = 16384, NI = 4;
    const int tid = my_tid(), lane = tid & 63, w = __builtin_amdgcn_readfirstlane(tid >> 6), r = lane & 31, h = lane >> 5;
    const int wm = w >> 1, wn = w & 1;
    const int nk = nk64 * 2;
    const int lr = lane >> 2, ls = lane & 3;
    const bf16_t* ap[2];
    const bf16_t* bp[2];
#pragma unroll
    for (int i = 0; i < 2; ++i) {
        const int row = 16 * (w + 4 * i) + lr, c = ls ^ ((row >> 2) & 3);
        ap[i] = A + aoff(row) + c * 8;
        bp[i] = Bt + (long)row * ldb + c * 8;
    }
    const unsigned sbase = (unsigned)(size_t)lds;
    f32x16 acc[2][2];
#pragma unroll
    for (int i = 0; i < 2; ++i)
#pragma unroll
        for (int j = 0; j < 2; ++j) acc[i][j] = zero16();
    int issued = 0;
#pragma unroll 1
    for (int a = 0; a < 3; ++a) {
        if (issued < nk) {
            const long ko_a = (long)(issued >> 1) * a_kstride + (issued & 1) * 32, ko_b = (long)issued * 32;
            const unsigned st = sbase + (issued & 3) * TB + w * 1024;
            glds16(ap[0] + ko_a, st); glds16(bp[0] + ko_b, st + 8192);
            glds16(ap[1] + ko_a, st + 4096); glds16(bp[1] + ko_b, st + 8192 + 4096);
            ++issued;
        }
    }
    const int fa = (wm * 64 + r) * 64, fb = 8192 + (wn * 64 + r) * 64, sw = (r >> 2) & 3;
#pragma unroll 1
    for (int kb = 0; kb < nk; ++kb) {
        const int ahead = issued - 1 - kb;
        if (ahead >= 2) wait_vm<2 * NI>(); else if (ahead == 1) wait_vm<NI>(); else wait_vm<0>();
        RAW_BARRIER();
        if (issued < nk) {
            const long ko_a = (long)(issued >> 1) * a_kstride + (issued & 1) * 32, ko_b = (long)issued * 32;
            const unsigned st = sbase + (issued & 3) * TB + w * 1024;
            glds16(ap[0] + ko_a, st); glds16(bp[0] + ko_b, st + 8192);
            glds16(ap[1] + ko_a, st + 4096); glds16(bp[1] + ko_b, st + 8192 + 4096);
            ++issued;
        }
        const char* cur = lds + (kb & 3) * TB;
        bf16x8 af[2][2], bfr[2][2];
#pragma unroll
        for (int kk = 0; kk < 2; ++kk) {
            const int so = ((2 * kk + h) ^ sw) * 16;
#pragma unroll
            for (int i = 0; i < 2; ++i) af[kk][i] = *(const bf16x8*)(cur + fa + i * 2048 + so);
#pragma unroll
            for (int j = 0; j < 2; ++j) bfr[kk][j] = *(const bf16x8*)(cur + fb + j * 2048 + so);
        }
#pragma unroll
        for (int kk = 0; kk < 2; ++kk)
#pragma unroll
            for (int i = 0; i < 2; ++i)
#pragma unroll
                for (int j = 0; j < 2; ++j) acc[i][j] = SWAP ? MFMA(bfr[kk][j], af[kk][i], acc[i][j]) : MFMA(af[kk][i], bfr[kk][j], acc[i][j]);
    }
    RAW_BARRIER();
    epi(acc, wm, wn, r, h);
}

template <bool SWAP, class AOff, class Epi>
DI void gemm_wide(char* lds, const bf16_t* __restrict__ A, AOff aoff, const bf16_t* __restrict__ Bt, long ldb, int nk64, Epi epi, long a_ks = 32, long b_ks = 32) {
    constexpr int TB = 24576, NI = 6;
    const int tid = my_tid(), lane = tid & 63, w = __builtin_amdgcn_readfirstlane(tid >> 6), r = lane & 31, h = lane >> 5;
    const int wm = w >> 1, wn = w & 1;
    const int nk = nk64 * 2;
    const int lr = lane >> 2, ls = lane & 3;
    const bf16_t* ap[2];
    const bf16_t* bp[4];
#pragma unroll
    for (int i = 0; i < 2; ++i) { const int row = 16 * (w + 4 * i) + lr, c = ls ^ ((row >> 2) & 3); ap[i] = A + aoff(row) + c * 8; }
#pragma unroll
    for (int i = 0; i < 4; ++i) { const int row = 16 * (w + 4 * i) + lr, c = ls ^ ((row >> 2) & 3); bp[i] = Bt + (long)row * ldb + c * 8; }
    const unsigned sbase = (unsigned)(size_t)lds;
    f32x16 acc[2][4];
#pragma unroll
    for (int i = 0; i < 2; ++i)
#pragma unroll
        for (int j = 0; j < 4; ++j) acc[i][j] = zero16();
    int issued = 0, si = 0;
#pragma unroll 1
    for (int a = 0; a < 2; ++a) {
        if (issued < nk) {
            const long ko = (long)issued * a_ks, kob = (long)issued * b_ks;
            const unsigned st = sbase + si * TB + w * 1024;
            glds16(ap[0] + ko, st); glds16(ap[1] + ko, st + 4096);
            glds16(bp[0] + kob, st + 8192); glds16(bp[1] + kob, st + 8192 + 4096); glds16(bp[2] + kob, st + 8192 + 8192); glds16(bp[3] + kob, st + 8192 + 12288);
            ++issued; si = (si == 2) ? 0 : si + 1;
        }
    }
    const int fa = (wm * 64 + r) * 64, fb = 8192 + (wn * 128 + r) * 64, sw = (r >> 2) & 3;
    int sc_ = 0;
#pragma unroll 1
    for (int kb = 0; kb < nk; ++kb) {
        if (issued - 1 - kb >= 1) wait_vm<NI>(); else wait_vm<0>();
        RAW_BARRIER();
        if (issued < nk) {
            const long ko = (long)issued * a_ks, kob = (long)issued * b_ks;
            const unsigned st = sbase + si * TB + w * 1024;
            glds16(ap[0] + ko, st); glds16(ap[1] + ko, st + 4096);
            glds16(bp[0] + kob, st + 8192); glds16(bp[1] + kob, st + 8192 + 4096); glds16(bp[2] + kob, st + 8192 + 8192); glds16(bp[3] + kob, st + 8192 + 12288);
            ++issued; si = (si == 2) ? 0 : si + 1;
        }
        const char* cur = lds + sc_ * TB;
        sc_ = (sc_ == 2) ? 0 : sc_ + 1;
#pragma unroll
        for (int kk = 0; kk < 2; ++kk) {
            const int so = ((2 * kk + h) ^ sw) * 16;
            bf16x8 af[2], bfr[4];
#pragma unroll
            for (int i = 0; i < 2; ++i) af[i] = *(const bf16x8*)(cur + fa + i * 2048 + so);
#pragma unroll
            for (int j = 0; j < 4; ++j) bfr[j] = *(const bf16x8*)(cur + fb + j * 2048 + so);
#pragma unroll
            for (int i = 0; i < 2; ++i)
#pragma unroll
                for (int j = 0; j < 4; ++j) acc[i][j] = SWAP ? MFMA(bfr[j], af[i], acc[i][j]) : MFMA(af[i], bfr[j], acc[i][j]);
        }
    }
    RAW_BARRIER();
    epi(acc, wm, wn, r, h);
}

struct ARowLin { long ld; DI long operator()(int r) const { return (long)r * ld; } };

enum { EM_PLAIN = 0, EM_ROPEQ = 1, EM_ROPEK = 2, EM_SILU = 3, EM_GATE = 4 };
struct EpiRow {
    bf16_t* dst; long ld; int row0; int col0; int mode; const f32x2* rope; bool zblk = false; bf16_t* rkt = nullptr;
    template <int NJ> DI void operator()(f32x16 (&acc)[2][NJ], int wm, int wn, int r, int h) const {
#pragma unroll
        for (int i = 0; i < 2; ++i) {
            const int row = row0 + wm * 64 + 32 * i + r;
            if (mode == EM_ROPEQ || mode == EM_ROPEK) {
                const int pos = row & (SEQ - 1);
                const float scl = (mode == EM_ROPEK) ? 0.125f : 1.f;
#pragma unroll
                for (int jp = 0; jp < NJ; jp += 2)
#pragma unroll
                for (int c4 = 0; c4 < 4; ++c4) {
                    float n1[4], n2[4];
#pragma unroll
                    for (int e = 0; e < 4; ++e) {
                        const int d = 8 * c4 + 4 * h + e;
                        const f32x2 cs = rope[pos * 32 + d];
                        const float t1 = acc[i][jp][4 * c4 + e], t2 = acc[i][jp + 1][4 * c4 + e];
                        n1[e] = (t1 * cs.x - t2 * cs.y) * scl;
                        n2[e] = (t1 * cs.y + t2 * cs.x) * scl;
                    }
                    bf16_t* d1 = dst + (long)row * ld + col0 + wn * (32 * NJ) + 32 * jp + 8 * c4 + 4 * h;
                    u32x2 o1 = {pack2(n1[0], n1[1]), pack2(n1[2], n1[3])};
                    u32x2 o2 = {pack2(n2[0], n2[1]), pack2(n2[2], n2[3])};
                    *(u32x2*)d1 = o1;
                    *(u32x2*)(d1 + 32) = o2;
                    if (mode == EM_ROPEK && rkt != nullptr) {
                        const int hh = (wn * (32 * NJ) + 32 * jp) >> 6;
                        const float wgt = ex2(ret_lg(hh) * (float)(127 - (pos & 127)));
                        bf16_t* tp = rkt + ((size_t)((row >> 12) * 4 + hh) * 64 + 8 * c4 + 4 * h) * SEQ + pos;
#pragma unroll
                        for (int e = 0; e < 4; ++e) {
                            tp[(size_t)e * SEQ] = (bf16_t)(pack2(n1[e] * wgt, 0.f) & 0xffffu);
                            tp[(size_t)(e + 32) * SEQ] = (bf16_t)(pack2(n2[e] * wgt, 0.f) & 0xffffu);
                        }
                    }
                }
            } else {
#pragma unroll
                for (int j = 0; j < NJ; ++j)
#pragma unroll
                    for (int c4 = 0; c4 < 4; ++c4) {
                        const int cl = wn * (32 * NJ) + 32 * j + 8 * c4 + 4 * h;
                        float v[4];
#pragma unroll
                        for (int e = 0; e < 4; ++e) v[e] = acc[i][j][4 * c4 + e];
                        if (mode == EM_SILU) {
#pragma unroll
                            for (int e = 0; e < 4; ++e) v[e] = silu_f(v[e]);
                        }
                        if (mode == EM_GATE) {
                            if (cl >= 24) continue;
#pragma unroll
                            for (int e = 0; e < 4; ++e) v[e] = sigm_f(v[e]);
                        }
                        u32x2 o = {pack2(v[0], v[1]), pack2(v[2], v[3])};
                        *(u32x2*)(dst + (zblk ? kbm(row, col0 + cl, NTOK) : (size_t)((long)row * ld + col0 + cl))) = o;
                    }
            }
        }
    }
};
struct EpiVT {
    bf16_t* dst; int ncols; int seq; int row0; int col0;
    template <int NJ> DI void operator()(f32x16 (&acc)[2][NJ], int wm, int wn, int r, int h) const {
#pragma unroll
        for (int i = 0; i < 2; ++i)
#pragma unroll
            for (int j = 0; j < NJ; ++j) {
                const int col = col0 + wn * (32 * NJ) + 32 * j + r;
#pragma unroll
                for (int c4 = 0; c4 < 4; ++c4) {
                    const int row = row0 + wm * 64 + 32 * i + 8 * c4 + 4 * h;
                    const int b = row / seq, s = row - b * seq;
                    u32x2 o = {pack2(acc[i][j][4 * c4], acc[i][j][4 * c4 + 1]), pack2(acc[i][j][4 * c4 + 2], acc[i][j][4 * c4 + 3])};
                    *(u32x2*)(dst + ((long)b * ncols + col) * seq + s) = o;
                }
            }
    }
};
struct EpiY {
    bf16_t* dst; int row0; int col0;
    template <int NJ> DI void operator()(f32x16 (&acc)[2][NJ], int wm, int wn, int r, int h) const {
#pragma unroll
        for (int i = 0; i < 2; ++i) {
            const int row = row0 + wm * 64 + 32 * i + r;
#pragma unroll
            for (int j = 0; j < NJ; ++j)
#pragma unroll
                for (int c4 = 0; c4 < 4; ++c4) {
                    u32x2 o = {pack2(acc[i][j][4 * c4], acc[i][j][4 * c4 + 1]), pack2(acc[i][j][4 * c4 + 2], acc[i][j][4 * c4 + 3])};
                    *(u32x2*)(dst + (long)row * DM + col0 + wn * (32 * NJ) + 32 * j + 8 * c4 + 4 * h) = o;
                }
        }
    }
};
constexpr int HSTR = 272;
struct EpiCmp {
    char* lds; const float* bias;
    DI void operator()(f32x16 (&acc)[2][2], int wm, int wn, int r, int h) const {
#pragma unroll
        for (int i = 0; i < 2; ++i) {
            const int row = wm * 64 + 32 * i + r;
#pragma unroll
            for (int j = 0; j < 2; ++j)
#pragma unroll
                for (int c4 = 0; c4 < 4; ++c4) {
                    const int cl = wn * 64 + 32 * j + 8 * c4 + 4 * h;
                    float v[4];
#pragma unroll
                    for (int e = 0; e < 4; ++e) v[e] = silu_f(acc[i][j][4 * c4 + e] + bias[cl + e]);
                    u32x2 o = {pack2(v[0], v[1]), pack2(v[2], v[3])};
                    *(u32x2*)(lds + row * HSTR + cl * 2) = o;
                }
        }
    }
};
struct EpiPart {
    float* dst;
    DI void operator()(f32x16 (&acc)[2][2], int wm, int wn, int r, int h) const {
#pragma unroll
        for (int i = 0; i < 2; ++i) {
            const int row = wm * 64 + 32 * i + r;
#pragma unroll
            for (int j = 0; j < 2; ++j)
#pragma unroll
                for (int c4 = 0; c4 < 4; ++c4) {
                    f32x4 o = {acc[i][j][4 * c4], acc[i][j][4 * c4 + 1], acc[i][j][4 * c4 + 2], acc[i][j][4 * c4 + 3]};
                    *(f32x4*)(dst + row * 128 + wn * 64 + 32 * j + 8 * c4 + 4 * h) = o;
                }
        }
    }
};
struct ARowCmp {
    int row0; int colbase;
    DI long operator()(int r) const {
        const int R = row0 + r, bg = R >> 8; int i = R & 255; if (i > 254) i = 254;
        const int b = bg >> 1, g = bg & 1;
        return ((long)(b * SEQ + 16 * i)) * NA + colbase + g * 64;
    }
};

enum { FM_NONE = 0, FM_MOBA = 1, FM_CMP = 2, FM_SLC = 3, FM_WIN = 4, FM_RET = 5 };
constexpr int VSTR = 144;

template <int DK, int DV>
struct TileRegs { u32x4 k[DK / 32]; u32x4 v[DV / 32]; };

template <int DK, int DV>
DI void tile_load(TileRegs<DK, DV>& t, const bf16_t* __restrict__ Kp, long kstride, const bf16_t* __restrict__ Vt, long vstride, int key0, bool loadv) {
    const int tid = my_tid();
#pragma unroll
    for (int j = 0; j < DK / 32; ++j) {
        const int c = tid + 256 * j, row = c / (DK / 8), kc = c % (DK / 8);
        t.k[j] = *(const u32x4*)(Kp + (long)(key0 + row) * kstride + kc * 8);
    }
    if (loadv) {
#pragma unroll
        for (int j = 0; j < DV / 32; ++j) {
            const int c = tid + 256 * j, row = c >> 3, kc = c & 7;
            t.v[j] = *(const u32x4*)(Vt + (long)row * vstride + key0 + kc * 8);
        }
    }
}
template <int DK, int DV>
DI void tile_store(const TileRegs<DK, DV>& t, char* buf, bool storev) {
    constexpr int KSTR = (DK + 8) * 2;
    const int tid = my_tid();
#pragma unroll
    for (int j = 0; j < DK / 32; ++j) {
        const int c = tid + 256 * j, row = c / (DK / 8), kc = c % (DK / 8);
        *(u32x4*)(buf + row * KSTR + kc * 16) = t.k[j];
    }
    if (storev) {
#pragma unroll
        for (int j = 0; j < DV / 32; ++j) {
            const int c = tid + 256 * j, row = c >> 3, kc = c & 7;
            *(u32x4*)(buf + 64 * KSTR + row * VSTR + kc * 16) = t.v[j];
        }
    }
}

template <int MODE>
DI bool fpred(int key, int tq) {
    if (MODE == FM_NONE) return true;
    if (MODE == FM_CMP) return (16 * key + 31) <= tq;
    if (MODE == FM_WIN) return (key <= tq) && (key > tq - 512);
    return key <= tq;
}

DI void glds16(const void* g, unsigned lds_addr) {
    lds_addr = __builtin_amdgcn_readfirstlane(lds_addr);
    asm volatile("s_mov_b32 m0, %0\n\ts_nop 0\n\tglobal_load_lds_dwordx4 %1, off" ::"s"(lds_addr), "v"(g) : "memory", "m0");
}
template <int DK, int DV>
struct TileSrc { const bf16_t* k[DK / 32]; const bf16_t* v[DV / 32]; unsigned woff; };
template <int DK, int DV>
DI void tile_src_init(TileSrc<DK, DV>& ts, const bf16_t* __restrict__ Kp, long kstride, const bf16_t* __restrict__ Vt, long vstride) {
    constexpr int NK = DK / 8, NV = DV / 8;
    const int tid = my_tid(), lane = tid & 63, w = __builtin_amdgcn_readfirstlane(tid >> 6);
    ts.woff = (unsigned)w * 1024u;
#pragma unroll
    for (int i = 0; i < NK / 4; ++i) {
        const int g = w + 4 * i;
        int row, c;
        if (DK == 64) { row = 8 * g + (lane >> 3); c = (lane & 7) ^ ((row >> 1) & 7); }
        else { row = 4 * g + (lane >> 4); c = (lane & 15) ^ (row & 15); }
        ts.k[i] = Kp + (long)row * kstride + c * 8;
    }
#pragma unroll
    for (int i = 0; i < NV / 4; ++i) {
        const int g = w + 4 * i;
        const int row = 8 * g + (lane >> 3), c = (lane & 7) ^ ((row >> 1) & 7);
        ts.v[i] = Vt + (long)row * vstride + c * 8;
    }
}
template <int DK, int DV>
DI void tile_issue(char* stage, const TileSrc<DK, DV>& ts, long kstride, int key0) {
    constexpr int NK = DK / 8, NV = DV / 8;
    const unsigned sbase = (unsigned)(size_t)stage + ts.woff;
    const long koff = (long)key0 * kstride;
#pragma unroll
    for (int i = 0; i < NK / 4; ++i) glds16(ts.k[i] + koff, sbase + i * 4096);
#pragma unroll
    for (int i = 0; i < NV / 4; ++i) glds16(ts.v[i] + key0, sbase + NK * 1024 + i * 4096);
}
template <int N> DI void wait_vm() { asm volatile("s_waitcnt vmcnt(%0)" ::"n"(N) : "memory"); }

template <int DK, int DV, int MODE>
DI void flash(char* lds, const bf16x8 (&qf)[DK / 16], const bf16_t* __restrict__ Kp, long kstride, const bf16_t* __restrict__ Vt, long vstride,
              u64 tiles, u64 wtiles, int tq, u64 aux, float sc, float lg, f32x16 (&o)[DV / 32], float& m, float& l, int nst_cap = 4) {
    constexpr int NK = DK / 8, NV = DV / 8, NI = (NK + NV) / 4;
    constexpr int TB = (NK + NV) * 1024;
    constexpr int NSTMAX = (LDS_BYTES / TB) > 4 ? 4 : (LDS_BYTES / TB);
    const int NST = NSTMAX < nst_cap ? NSTMAX : nst_cap;
    const int lane = my_tid() & 63, r = lane & 31, h = lane >> 5;
    tiles = ((u64)(unsigned)__builtin_amdgcn_readfirstlane((unsigned)(tiles >> 32)) << 32) | (unsigned)__builtin_amdgcn_readfirstlane((unsigned)tiles);
    wtiles = ((u64)(unsigned)__builtin_amdgcn_readfirstlane((unsigned)(wtiles >> 32)) << 32) | (unsigned)__builtin_amdgcn_readfirstlane((unsigned)wtiles);
    u64 rem_i = tiles, rem_c = tiles;
    const int n = __builtin_popcountll(tiles);
    if (n == 0) return;
    TileSrc<DK, DV> ts;
    tile_src_init<DK, DV>(ts, Kp, kstride, Vt, vstride);
    int issued = 0, slot_i = 0, slot_c = 0;
#pragma unroll 1
    for (int a = 0; a < NST - 1; ++a) {
        if (rem_i) {
            const int t = __builtin_ctzll(rem_i); rem_i &= rem_i - 1;
            tile_issue<DK, DV>(lds + slot_i * TB, ts, kstride, t * 64);
            ++issued; slot_i = (slot_i + 1 == NST) ? 0 : slot_i + 1;
        }
    }
#pragma unroll 1
    for (int j = 0; j < n; ++j) {
        const int cur = __builtin_ctzll(rem_c); rem_c &= rem_c - 1;
        const int ahead = issued - 1 - j;
        if (ahead >= 2) wait_vm<2 * NI>(); else if (ahead == 1) wait_vm<NI>(); else wait_vm<0>();
        RAW_BARRIER();
        if (rem_i) {
            const int t = __builtin_ctzll(rem_i); rem_i &= rem_i - 1;
            tile_issue<DK, DV>(lds + slot_i * TB, ts, kstride, t * 64);
            ++issued; slot_i = (slot_i + 1 == NST) ? 0 : slot_i + 1;
        }
        const char* Ks = lds + slot_c * TB;
        const char* Vs = Ks + NK * 1024;
        slot_c = (slot_c + 1 == NST) ? 0 : slot_c + 1;
        if ((wtiles >> cur) & 1ull) {
            const int q0w = __builtin_amdgcn_readfirstlane(tq);
            const int kt0 = cur * 64;
            bool need_mask = false;
            if (MODE == FM_MOBA || MODE == FM_SLC || MODE == FM_RET) need_mask = (kt0 + 63 > q0w);
            if (MODE == FM_CMP) need_mask = (16 * (kt0 + 63) + 31 > q0w);
            if (MODE == FM_WIN) need_mask = (kt0 + 63 > q0w) || (kt0 <= q0w + 31 - 512);
            bool lane_on = true;
            if (MODE == FM_MOBA) lane_on = (((unsigned)aux >> (cur >> 2)) & 1u) != 0u;
            if (MODE == FM_SLC) lane_on = ((aux >> cur) & 1ull) != 0ull;
            f32x16 s[2];
            if (DK == 64) {
                bf16x8 kf[2][DK / 16];
#pragma unroll
                for (int t = 0; t < 2; ++t)
#pragma unroll
                    for (int kk = 0; kk < DK / 16; ++kk) {
                        const int krow = 32 * t + r;
                        kf[t][kk] = *(const bf16x8*)(Ks + krow * (DK * 2) + (((2 * kk + h) ^ ((krow >> 1) & 7)) * 16));
                    }
                __builtin_amdgcn_sched_barrier(0);
#pragma unroll
                for (int t = 0; t < 2; ++t) {
                    s[t] = zero16();
#pragma unroll
                    for (int kk = 0; kk < DK / 16; ++kk) s[t] = MFMA(kf[t][kk], qf[kk], s[t]);
                }
            } else {
#pragma unroll
                for (int t = 0; t < 2; ++t) {
                    bf16x8 kf[DK / 16];
#pragma unroll
                    for (int kk = 0; kk < DK / 16; ++kk) {
                        const int krow = 32 * t + r;
                        kf[kk] = *(const bf16x8*)(Ks + krow * (DK * 2) + (((2 * kk + h) ^ (krow & 15)) * 16));
                    }
                    s[t] = zero16();
#pragma unroll
                    for (int kk = 0; kk < DK / 16; ++kk) s[t] = MFMA(kf[kk], qf[kk], s[t]);
                    __builtin_amdgcn_sched_barrier(0);
                }
            }
            u32x4 vf0[2][DV / 32];
#pragma unroll
            for (int ss = 0; ss < 2; ++ss)
#pragma unroll
                for (int d = 0; d < DV / 32; ++d) {
                    const int vrow = 32 * d + r, vkey = (vrow >> 1) & 7, c0 = 2 * ss;
                    const u32x2 lo = *(const u32x2*)(Vs + vrow * 128 + ((c0 ^ vkey) * 16) + 8 * h);
                    const u32x2 hi = *(const u32x2*)(Vs + vrow * 128 + (((c0 + 1) ^ vkey) * 16) + 8 * h);
                    vf0[ss][d] = (u32x4){lo.x, lo.y, hi.x, hi.y};
                }
            __builtin_amdgcn_sched_barrier(0);
            if (MODE != FM_RET) {
                if (need_mask) {
#pragma unroll
                    for (int t = 0; t < 2; ++t)
#pragma unroll
                        for (int i = 0; i < 16; ++i)
                            if (!fpred<MODE>(kt0 + 32 * t + crow(i, h), tq)) s[t][i] = -INFINITY;
                }
                float mx0 = mx2(mx2(mx2(s[0][0], s[0][1]), mx2(s[0][2], s[0][3])), mx2(mx2(s[0][4], s[0][5]), mx2(s[0][6], s[0][7])));
                float mx1 = mx2(mx2(mx2(s[0][8], s[0][9]), mx2(s[0][10], s[0][11])), mx2(mx2(s[0][12], s[0][13]), mx2(s[0][14], s[0][15])));
                float mx2_ = mx2(mx2(mx2(s[1][0], s[1][1]), mx2(s[1][2], s[1][3])), mx2(mx2(s[1][4], s[1][5]), mx2(s[1][6], s[1][7])));
                float mx3 = mx2(mx2(mx2(s[1][8], s[1][9]), mx2(s[1][10], s[1][11])), mx2(mx2(s[1][12], s[1][13]), mx2(s[1][14], s[1][15])));
                float mx = mx2(mx2(mx0, mx1), mx2(mx2_, mx3));
                if (MODE == FM_MOBA || MODE == FM_SLC) mx = lane_on ? mx : -INFINITY;
                mx = fmaxf(mx, shx(mx, 32));
                const float mxs = mx * sc;
                if (__any(mxs > m + 8.f)) {
                    const float mn = fmaxf(m, mxs);
                    const float alpha = ex2(m - mn);
                    m = mn;
                    l *= alpha;
#pragma unroll
                    for (int d = 0; d < DV / 32; ++d)
#pragma unroll
                        for (int i = 0; i < 16; ++i) o[d][i] *= alpha;
                }
                float negm = -m;
                if (MODE == FM_MOBA || MODE == FM_SLC) negm = lane_on ? negm : -1e30f;
                float ps0 = 0.f, ps1 = 0.f;
#pragma unroll
                for (int t = 0; t < 2; ++t)
#pragma unroll
                    for (int i = 0; i < 16; i += 2) {
                        const float p0 = ex2(__builtin_fmaf(s[t][i], sc, negm));
                        const float p1 = ex2(__builtin_fmaf(s[t][i + 1], sc, negm));
                        s[t][i] = p0; s[t][i + 1] = p1;
                        ps0 += p0; ps1 += p1;
                    }
                l += ps0 + ps1;
            } else {
                const float g1 = sc, g2 = g1 * g1, g3 = g2 * g1, g4 = g2 * g2, g8 = g4 * g4;
#pragma unroll
                for (int t = 0; t < 2; ++t) {
                    float Ac = ex2(lg * (float)(tq - (kt0 + 32 * t) - 4 * h));
#pragma unroll
                    for (int c = 0; c < 4; ++c) {
                        s[t][4 * c] *= Ac; s[t][4 * c + 1] *= Ac * g1; s[t][4 * c + 2] *= Ac * g2; s[t][4 * c + 3] *= Ac * g3;
                        Ac *= g8;
                    }
                }
                if (need_mask) {
#pragma unroll
                    for (int t = 0; t < 2; ++t)
#pragma unroll
                        for (int i = 0; i < 16; ++i)
                            if (kt0 + 32 * t + crow(i, h) > tq) s[t][i] = 0.f;
                }
            }
            __builtin_amdgcn_sched_barrier(0);
            u32x4 vf1[2][DV / 32];
#pragma unroll
            for (int ss = 0; ss < 2; ++ss)
#pragma unroll
                for (int d = 0; d < DV / 32; ++d) {
                    const int vrow = 32 * d + r, vkey = (vrow >> 1) & 7, c0 = 4 + 2 * ss;
                    const u32x2 lo = *(const u32x2*)(Vs + vrow * 128 + ((c0 ^ vkey) * 16) + 8 * h);
                    const u32x2 hi = *(const u32x2*)(Vs + vrow * 128 + (((c0 + 1) ^ vkey) * 16) + 8 * h);
                    vf1[ss][d] = (u32x4){lo.x, lo.y, hi.x, hi.y};
                }
#pragma unroll
            for (int ss = 0; ss < 2; ++ss) {
                u32x4 pk = {pack2(s[0][8 * ss], s[0][8 * ss + 1]), pack2(s[0][8 * ss + 2], s[0][8 * ss + 3]),
                            pack2(s[0][8 * ss + 4], s[0][8 * ss + 5]), pack2(s[0][8 * ss + 6], s[0][8 * ss + 7])};
                const bf16x8 pf = __builtin_bit_cast(bf16x8, pk);
#pragma unroll
                for (int d = 0; d < DV / 32; ++d) o[d] = MFMA(__builtin_bit_cast(bf16x8, vf0[ss][d]), pf, o[d]);
            }
#pragma unroll
            for (int ss = 0; ss < 2; ++ss) {
                u32x4 pk = {pack2(s[1][8 * ss], s[1][8 * ss + 1]), pack2(s[1][8 * ss + 2], s[1][8 * ss + 3]),
                            pack2(s[1][8 * ss + 4], s[1][8 * ss + 5]), pack2(s[1][8 * ss + 6], s[1][8 * ss + 7])};
                const bf16x8 pf = __builtin_bit_cast(bf16x8, pk);
#pragma unroll
                for (int d = 0; d < DV / 32; ++d) o[d] = MFMA(__builtin_bit_cast(bf16x8, vf1[ss][d]), pf, o[d]);
            }
        }
    }
    RAW_BARRIER();
}

template <int DK>
DI void load_q(bf16x8 (&qf)[DK / 16], const bf16_t* qrow, int h) {
#pragma unroll
    for (int kk = 0; kk < DK / 16; ++kk) qf[kk] = *(const bf16x8*)(qrow + 16 * kk + 8 * h);
}

template <int DV>
DI void write_gated(const f32x16 (&o)[DV / 32], float scale, bf16_t* zbase, size_t row, int col0, int h, bool wr = true) {
    if (!wr) {
        float chk = 0.f;
#pragma unroll
        for (int d = 0; d < DV / 32; ++d)
#pragma unroll
            for (int i = 0; i < 16; ++i) chk += o[d][i];
        if (chk * scale == 1.2345e-30f) zbase[0] = 0;
        return;
    }
#pragma unroll
    for (int d = 0; d < DV / 32; ++d)
#pragma unroll
        for (int c4 = 0; c4 < 4; ++c4) {
            bf16_t* zp = zbase + kbm((int)row, col0 + 32 * d + 8 * c4 + 4 * h, NTOK);
            const u32x2 z = *(const u32x2*)zp;
            u32x2 ov = {pack2(o[d][4 * c4] * scale * bflo(z.x), o[d][4 * c4 + 1] * scale * bfhi(z.x)),
                        pack2(o[d][4 * c4 + 2] * scale * bflo(z.y), o[d][4 * c4 + 3] * scale * bfhi(z.y))};
            *(u32x2*)zp = ov;
        }
}

DI u64 range_bits(int lo, int hi) {
    const u64 a = (hi >= 63) ? ~0ull : ((2ull << hi) - 1ull);
    return a & ~((1ull << lo) - 1ull);
}

constexpr int KM_OFF = 65536, MISC_OFF = 69888;
DI void moba_item(const Params& p, char* lds, int b, int hh, int qt, bool wr = true) {
    const int tid = my_tid(), lane = tid & 63, w = tid >> 6, r = lane & 31, h = lane >> 5;
    const bf16_t* bufA = (const bf16_t*)(p.ws + OFF_BUFA);
    const bf16_t* vT = (const bf16_t*)(p.ws + OFF_VT);
    bf16_t* bufZ = (bf16_t*)(p.ws + OFF_BUFZ);
    const float* kmean = (const float*)(p.ws + OFF_KMEAN);
    const int q0w = qt * 128 + w * 32, tq = q0w + r, own = qt >> 1;
    *(f32x4*)(lds + KM_OFF + tid * 16) = *(const f32x4*)(kmean + (size_t)(b * 8 + hh) * 1024 + tid * 4);
    const bf16_t* qrow = bufA + (size_t)(b * SEQ + tq) * NA + CA_MQ + hh * 64;
    bf16x8 qf[4];
    load_q<64>(qf, qrow, h);
    __syncthreads();
    float gh[8];
#pragma unroll
    for (int mI = 0; mI < 8; ++mI) gh[mI] = 0.f;
#pragma unroll
    for (int c = 0; c < 8; ++c) {
        const u32x4 qv = *(const u32x4*)(qrow + 8 * c);
        const float q0 = bflo(qv.x), q1 = bfhi(qv.x), q2 = bflo(qv.y), q3 = bfhi(qv.y), q4 = bflo(qv.z), q5 = bfhi(qv.z), q6 = bflo(qv.w), q7 = bfhi(qv.w);
#pragma unroll
        for (int mI = 0; mI < 8; ++mI) {
            if (2 * mI < own) {
                const float* km = (const float*)(lds + KM_OFF) + (2 * mI + h) * 64 + c * 8;
                const f32x4 k0 = *(const f32x4*)km, k1 = *(const f32x4*)(km + 4);
                gh[mI] += q0 * k0.x + q1 * k0.y + q2 * k0.z + q3 * k0.w + q4 * k1.x + q5 * k1.y + q6 * k1.z + q7 * k1.w;
            }
        }
    }
    float g[16];
#pragma unroll
    for (int mI = 0; mI < 8; ++mI) {
        const float other = shx(gh[mI], 32);
        g[2 * mI] = h ? other : gh[mI];
        g[2 * mI + 1] = h ? gh[mI] : other;
    }
    unsigned bm = 0;
#pragma unroll
    for (int pass = 0; pass < 3; ++pass) {
        float best = -INFINITY; int bi = -1;
#pragma unroll
        for (int n = 0; n < 15; ++n)
            if (n < own && !((bm >> n) & 1u) && g[n] > best) { best = g[n]; bi = n; }
        if (bi >= 0) bm |= 1u << bi;
    }
    bm |= 1u << own;
    unsigned um = bm;
    um |= __shfl_xor(um, 16, 64); um |= __shfl_xor(um, 8, 64); um |= __shfl_xor(um, 4, 64); um |= __shfl_xor(um, 2, 64); um |= __shfl_xor(um, 1, 64);
    um = __builtin_amdgcn_readfirstlane(um);
    u64 wt = 0;
#pragma unroll
    for (int n = 0; n < 16; ++n) if ((um >> n) & 1u) wt |= 0xFull << (4 * n);
    wt &= range_bits(0, (q0w + 31) >> 6);
    if (lane == 0) *(u64*)(lds + MISC_OFF + 8 * w) = wt;
    __syncthreads();
    const u64 tiles = *(const u64*)(lds + MISC_OFF) | *(const u64*)(lds + MISC_OFF + 8) | *(const u64*)(lds + MISC_OFF + 16) | *(const u64*)(lds + MISC_OFF + 24);
    f32x16 o[2]; o[0] = zero16(); o[1] = zero16();
    float m = -1e30f, l = 0.f;
    flash<64, 64, FM_MOBA>(lds, qf, bufA + (size_t)b * SEQ * NA + CA_MK + hh * 64, NA, vT + ((size_t)b * NVT + CV_MV + hh * 64) * SEQ, SEQ,
                           tiles, wt, tq, (u64)bm, 0.125f * LOG2E, 0.f, o, m, l);
    l += shx(l, 32);
    const float inv = l > 0.f ? 1.f / l : 0.f;
    write_gated<64>(o, inv, bufZ, (size_t)(b * SEQ + tq), 0 + hh * 64, h, wr);
}

constexpr int PART_OFF = 36864, SELM_OFF = 69632;
DI void nsa_item(const Params& p, char* lds, int b, int g, int qt32, bool wr = true) {
    const int tid = my_tid(), lane = tid & 63, w = tid >> 6, r = lane & 31, h = lane >> 5;
    const bf16_t* bufA = (const bf16_t*)(p.ws + OFF_BUFA);
    const bf16_t* vT = (const bf16_t*)(p.ws + OFF_VT);
    bf16_t* bufZ = (bf16_t*)(p.ws + OFF_BUFZ);
    const bf16_t* kc = (const bf16_t*)(p.ws + OFF_KC) + (size_t)(b * 2 + g) * 256 * 64;
    const bf16_t* vcT = (const bf16_t*)(p.ws + OFF_VCT) + (size_t)(b * 2 + g) * 64 * 256;
    const int q0 = qt32 * 32, tq = q0 + r, hq = g * 4 + w;
    const size_t tokrow = (size_t)(b * SEQ + tq);
    const bf16_t* qrow = bufA + tokrow * NA + CA_NQ + hq * 64;
    bf16x8 qf[4];
    load_q<64>(qf, qrow, h);
    const float sc = 0.125f * LOG2E;
    const bf16_t* gp = bufA + tokrow * NA + CA_GATE + hq * 3;
    const float g_cmp = bf2f(gp[0]), g_slc = bf2f(gp[1]), g_win = bf2f(gp[2]);
    f32x16 tot[2]; tot[0] = zero16(); tot[1] = zero16();
    const int ncmp_tiles = ((q0 >> 4) >> 6) + 1;
    const u64 ctiles = range_bits(0, ncmp_tiles - 1);
    float m = -1e30f, l = 0.f;
    {
        f32x16 o[2]; o[0] = zero16(); o[1] = zero16();
        flash<64, 64, FM_CMP>(lds, qf, kc, 64, vcT, 256, ctiles, ctiles, tq, 0ull, sc, 0.f, o, m, l);
        l += shx(l, 32);
        const float inv = l > 0.f ? 1.f / l : 0.f;
        l = inv;
#pragma unroll
        for (int d = 0; d < 2; ++d)
#pragma unroll
            for (int i = 0; i < 16; ++i) tot[d][i] = o[d][i] * (inv * g_cmp);
    }
#ifndef REP_IMP
#define REP_IMP 1
#endif
    for (int rimp = 0; rimp < REP_IMP; ++rimp) {
        float* part = (float*)(lds + w * 16384 + 8192) + r * 64;
#pragma unroll
        for (int j = 0; j < 32; ++j) part[2 * j + h] = 0.f;
        float prev = 0.f;
#pragma unroll 1
        for (int t4 = 0; t4 < ncmp_tiles; ++t4) {
#pragma unroll
            for (int t = 0; t < 2; ++t) {
                f32x16 s = zero16();
#pragma unroll
                for (int kk = 0; kk < 4; ++kk) {
                    const int krow = 32 * t + r;
                    const bf16x8 kf = *(const bf16x8*)(lds + t4 * 16384 + krow * 128 + (((2 * kk + h) ^ ((krow >> 1) & 7)) * 16));
                    s = MFMA(kf, qf[kk], s);
                }
                const int T = 2 * t4 + t;
#pragma unroll
                for (int c = 0; c < 4; ++c) {
                    float pv[4];
#pragma unroll
                    for (int e = 0; e < 4; ++e) {
                        const int key = 32 * T + 8 * c + 4 * h + e;
                        pv[e] = ((16 * key + 31) <= tq) ? ex2(s[4 * c + e] * sc - m) * l : 0.f;
                    }
                    const float A = 2.f * (pv[0] + pv[1] + pv[2]) + pv[3];
                    const float xch = shx(pv[3], 32);
                    const float add = h ? xch : prev;
                    prev = xch;
                    part[8 * T + 2 * c + h] = A + add;
                }
            }
        }
        __syncthreads();
        const float* pbase = (const float*)(lds + 8192);
#ifndef REP_TOPK
#define REP_TOPK 1
#endif
#pragma unroll 1
        for (int rtk = 0; rtk < REP_TOPK; ++rtk)
#pragma unroll 1
        for (int qq = 8 * w; qq < 8 * w + 8; ++qq) {
            float v = pbase[qq * 64 + lane] + pbase[4096 + qq * 64 + lane] + pbase[2 * 4096 + qq * 64 + lane] + pbase[3 * 4096 + qq * 64 + lane];
            const int own = (q0 + qq) >> 6;
            if (lane == 0 || lane == own || lane == own - 1) v = INFINITY;
            if (lane > own) v = -INFINITY;
            const unsigned key = (v > 0.f) ? __float_as_uint(v) : 0u;
            unsigned T = 0u;
#pragma unroll
            for (int bit = 30; bit >= 0; --bit) {
                const unsigned cand = T | (1u << bit);
                const int cnt = __builtin_popcountll(__ballot(key >= cand));
                T = (cnt >= 16) ? cand : T;
            }
            u64 selm = __ballot(key > T), E = __ballot(key == T);
            int need = 16 - __builtin_popcountll(selm);
            while (need > 0 && E != 0ull) { const u64 low = E & (0ull - E); selm |= low; E ^= low; --need; }
            if (lane == 0) *(u64*)(lds + SELM_OFF + qq * 8) = selm;
        }
        __syncthreads();
    }
    const u64 sel = *(const u64*)(lds + SELM_OFF + r * 8);
    {
        unsigned ulo = (unsigned)sel, uhi = (unsigned)(sel >> 32);
#pragma unroll
        for (int off = 16; off >= 1; off >>= 1) { ulo |= __shfl_xor(ulo, off, 64); uhi |= __shfl_xor(uhi, off, 64); }
        ulo = __builtin_amdgcn_readfirstlane(ulo); uhi = __builtin_amdgcn_readfirstlane(uhi);
        const u64 stiles = (((u64)uhi << 32) | ulo) & range_bits(0, (q0 + 31) >> 6);
        f32x16 o[2]; o[0] = zero16(); o[1] = zero16();
        float m2 = -1e30f, l2 = 0.f;
        flash<64, 64, FM_SLC>(lds, qf, bufA + (size_t)b * SEQ * NA + CA_NKS + g * 64, NA, vT + ((size_t)b * NVT + CV_NVS + g * 64) * SEQ, SEQ,
                              stiles, stiles, tq, sel, sc, 0.f, o, m2, l2);
        l2 += shx(l2, 32);
        const float inv = l2 > 0.f ? 1.f / l2 : 0.f;
#pragma unroll
        for (int d = 0; d < 2; ++d)
#pragma unroll
            for (int i = 0; i < 16; ++i) tot[d][i] += o[d][i] * (inv * g_slc);
    }
    {
        const int lo = (q0 >= 511 ? (q0 - 511) : 0) >> 6;
        const u64 wtl = range_bits(lo, (q0 + 31) >> 6);
        f32x16 o[2]; o[0] = zero16(); o[1] = zero16();
        float m3 = -1e30f, l3 = 0.f;
        flash<64, 64, FM_WIN>(lds, qf, bufA + (size_t)b * SEQ * NA + CA_NKW + g * 64, NA, vT + ((size_t)b * NVT + CV_NVW + g * 64) * SEQ, SEQ,
                              wtl, wtl, tq, 0ull, sc, 0.f, o, m3, l3);
        l3 += shx(l3, 32);
        const float inv = l3 > 0.f ? 1.f / l3 : 0.f;
#pragma unroll
        for (int d = 0; d < 2; ++d)
#pragma unroll
            for (int i = 0; i < 16; ++i) tot[d][i] += o[d][i] * (inv * g_win);
    }
    write_gated<64>(tot, 1.f, bufZ, tokrow, 512 + hq * 64, h, wr);
}

DI void ret_item(const Params& p, char* lds, int layer, int b, int hh, int qt, bool wr = true) {
    const int tid = my_tid(), lane = tid & 63, w = tid >> 6, r = lane & 31, h = lane >> 5;
    const bf16_t* bufA = (const bf16_t*)(p.ws + OFF_BUFA);
    const bf16_t* vT = (const bf16_t*)(p.ws + OFF_VT);
    bf16_t* bufZ = (bf16_t*)(p.ws + OFF_BUFZ);
    const int q0b = qt * 128, q0w = q0b + w * 32, tq = q0w + r;
    const size_t tokrow = (size_t)(b * SEQ + tq);
    bf16x8 qf[4];
    load_q<64>(qf, bufA + tokrow * NA + CA_RQ + hh * 64, h);
    const float lg = ret_lg(hh);
    const int c = qt;
    constexpr int ST_OFF = 49152;
    {
        const int nch = (hh == 0) ? 5 : (hh == 1 ? 9 : (hh == 2 ? 17 : 31));
        const int nprev = c < nch ? c : nch;
        const int dv = tid >> 1, d0 = (tid & 1) * 32;
        const bf16_t* up = (const bf16_t*)(p.ws + OFF_U) + ((size_t)(b * 4 + hh) * 32) * 8192 + tid * 32;
        const float dec = ex2(lg * 128.f);
        f32x4 a[8];
#pragma unroll
        for (int q = 0; q < 8; ++q) a[q] = (f32x4){0.f, 0.f, 0.f, 0.f};
        float f = 1.f;
#pragma unroll 1
        for (int k = 0; k < nprev; k += 4) {
            u32x4 raw[4][4];
#pragma unroll
            for (int kk = 0; kk < 4; ++kk) {
                const int cp = (k + kk < nprev) ? (c - 1 - k - kk) : 0;
                const bf16_t* src = up + (size_t)cp * 8192;
#pragma unroll
                for (int q = 0; q < 4; ++q) raw[kk][q] = *(const u32x4*)(src + 8 * q);
            }
#pragma unroll
            for (int kk = 0; kk < 4; ++kk) {
                const float fw = (k + kk < nprev) ? f : 0.f;
#pragma unroll
                for (int q = 0; q < 4; ++q) {
                    const u32x4 rv = raw[kk][q];
                    a[2 * q] += (f32x4){bflo(rv.x), bfhi(rv.x), bflo(rv.y), bfhi(rv.y)} * fw;
                    a[2 * q + 1] += (f32x4){bflo(rv.z), bfhi(rv.z), bflo(rv.w), bfhi(rv.w)} * fw;
                }
                f *= dec;
            }
        }
#pragma unroll
        for (int q = 0; q < 4; ++q) {
            u32x4 pk = {pack2(a[2 * q].x, a[2 * q].y), pack2(a[2 * q].z, a[2 * q].w), pack2(a[2 * q + 1].x, a[2 * q + 1].y), pack2(a[2 * q + 1].z, a[2 * q + 1].w)};
            const int cidx = (d0 >> 3) + q;
            *(u32x4*)(lds + ST_OFF + dv * 128 + ((cidx ^ ((dv >> 1) & 7)) * 16)) = pk;
        }
    }
    __syncthreads();
    f32x16 o[4];
#pragma unroll
    for (int d = 0; d < 4; ++d) o[d] = zero16();
    if (c > 0) {
        const float cross = ex2(lg * (float)((tq & 127) + 1));
        const bf16_t* qrow = bufA + tokrow * NA + CA_RQ + hh * 64;
#pragma unroll
        for (int t = 0; t < 2; ++t)
#pragma unroll
            for (int ss = 0; ss < 2; ++ss) {
                const int dq = 32 * t + 16 * ss + 4 * h;
                const u32x2 qa = *(const u32x2*)(qrow + dq), qb = *(const u32x2*)(qrow + dq + 8);
                u32x4 pk = {pack2(bflo(qa.x) * cross, bfhi(qa.x) * cross), pack2(bflo(qa.y) * cross, bfhi(qa.y) * cross),
                            pack2(bflo(qb.x) * cross, bfhi(qb.x) * cross), pack2(bflo(qb.y) * cross, bfhi(qb.y) * cross)};
                const bf16x8 pf = __builtin_bit_cast(bf16x8, pk);
#pragma unroll
                for (int d = 0; d < 4; ++d) {
                    const int vrow = 32 * d + r, vkey = (vrow >> 1) & 7, c0 = 4 * t + 2 * ss;
                    const u32x2 lo2 = *(const u32x2*)(lds + ST_OFF + vrow * 128 + ((c0 ^ vkey) * 16) + 8 * h);
                    const u32x2 hi2 = *(const u32x2*)(lds + ST_OFF + vrow * 128 + (((c0 + 1) ^ vkey) * 16) + 8 * h);
                    u32x4 vv = {lo2.x, lo2.y, hi2.x, hi2.y};
                    o[d] = MFMA(__builtin_bit_cast(bf16x8, vv), pf, o[d]);
                }
            }
    }
    const u64 tiles = range_bits(2 * c, 2 * c + 1);
    const u64 wt = range_bits(2 * c, (q0w + 31) >> 6);
    float m = 0.f, l = 0.f;
    flash<64, 128, FM_RET>(lds, qf, bufA + (size_t)b * SEQ * NA + CA_RK + hh * 64, NA, vT + ((size_t)b * NVT + CV_RV + hh * 128) * SEQ, SEQ,
                           tiles, wt, tq, 0ull, ex2(-lg), lg, o, m, l, 2);
    float sm = 0.f;
#pragma unroll
    for (int d = 0; d < 4; ++d)
#pragma unroll
        for (int i = 0; i < 16; ++i) sm += o[d][i];
    sm += shx(sm, 32);
    const float mu = sm * (1.f / 128.f);
    float sq = 0.f;
#pragma unroll
    for (int d = 0; d < 4; ++d)
#pragma unroll
        for (int i = 0; i < 16; ++i) { const float c = o[d][i] - mu; o[d][i] = c; sq += c * c; }
    sq += shx(sq, 32);
    const float rs = rsqrtf(sq * (1.f / 128.f) + EPS);
    const float* gn = p.gn_g + layer * 512 + hh * 128;
#pragma unroll
    for (int d = 0; d < 4; ++d)
#pragma unroll
        for (int c4 = 0; c4 < 4; ++c4) {
            const f32x4 gv = *(const f32x4*)(gn + 32 * d + 8 * c4 + 4 * h);
            o[d][4 * c4] *= gv.x; o[d][4 * c4 + 1] *= gv.y; o[d][4 * c4 + 2] *= gv.z; o[d][4 * c4 + 3] *= gv.w;
        }
    write_gated<128>(o, rs, bufZ, tokrow, 1024 + hh * 128, h, wr);
}

DI void mem_item(const Params& p, char* lds, int b, int hh, int qt, bool wr = true) {
    const int tid = my_tid(), lane = tid & 63, w = tid >> 6, r = lane & 31, h = lane >> 5;
    const bf16_t* bufA = (const bf16_t*)(p.ws + OFF_BUFA);
    bf16_t* bufZ = (bf16_t*)(p.ws + OFF_BUFZ);
    const bf16_t* memK = (const bf16_t*)(p.ws + OFF_MEMK);
    const bf16_t* memVT = (const bf16_t*)(p.ws + OFF_MEMV);
    const int tq = qt * 128 + w * 32 + r;
    const size_t tokrow = (size_t)(b * SEQ + tq);
    bf16x8 qf[8];
    load_q<128>(qf, bufA + tokrow * NA + CA_CQ + hh * 128, h);
    f32x16 o[4];
#pragma unroll
    for (int d = 0; d < 4; ++d) o[d] = zero16();
    float m = -1e30f, l = 0.f;
    flash<128, 128, FM_NONE>(lds, qf, memK + (size_t)b * 256 * 512 + hh * 128, 512, memVT + ((size_t)b * 512 + hh * 128) * 256, 256,
                             0xFull, 0xFull, tq, 0ull, 0.08838834764831845f * LOG2E, 0.f, o, m, l);
    l += shx(l, 32);
    const float inv = l > 0.f ? 1.f / l : 0.f;
    write_gated<128>(o, inv, bufZ, tokrow, 1536 + hh * 128, h, wr);
}

DI void conv_w(const float* __restrict__ W, int ldw, bf16_t* __restrict__ WT, int K, int Ndst, bool mapped, long gtid, long gthreads, bool blocked = false) {
    const long total = (long)Ndst * (K / 8);
    for (long idx = gtid; idx < total; idx += gthreads) {
        const int n = (int)(idx % Ndst), kc = (int)(idx / Ndst);
        const int src = mapped ? in_col_src(n) : n;
        u32x4 o = {0u, 0u, 0u, 0u};
        if (src >= 0) {
            float v[8];
#pragma unroll
            for (int j = 0; j < 8; ++j) v[j] = W[(size_t)(kc * 8 + j) * ldw + src];
            o.x = pack2(v[0], v[1]); o.y = pack2(v[2], v[3]); o.z = pack2(v[4], v[5]); o.w = pack2(v[6], v[7]);
        }
        *(u32x4*)(WT + (blocked ? kbm(n, kc * 8, Ndst) : (size_t)n * K + kc * 8)) = o;
    }
}
DI void conv_layer_weights(const Params& p, int layer, long gtid, long gthreads) {
    conv_w(p.w_in + (size_t)layer * 1024 * 6424, 6424, (bf16_t*)(p.ws + OFF_WIN), 1024, NIN, true, gtid, gthreads, true);
    conv_w(p.w_out + (size_t)layer * 2048 * 1024, 1024, (bf16_t*)(p.ws + OFF_WOUT), 2048, 1024, false, gtid, gthreads, true);
    conv_w(p.w_mem + (size_t)layer * 1024 * 1024, 1024, (bf16_t*)(p.ws + OFF_WMEM), 1024, 1024, false, gtid, gthreads);
    conv_w(p.w1_k + (size_t)layer * 2048 * 128, 128, (bf16_t*)(p.ws + OFF_W1K), 2048, 128, false, gtid, gthreads);
    conv_w(p.w1_v + (size_t)layer * 2048 * 128, 128, (bf16_t*)(p.ws + OFF_W1V), 2048, 128, false, gtid, gthreads);
}
DI void cmp_bias(const Params& p, int layer, char* lds) {
    const int bb = blockIdx.x;
    if (bb >= 32) return;
    const int which = bb >> 4, pt = bb & 15;
    const float* pe = (which ? p.pe_v : p.pe_k) + (size_t)layer * 2048;
    const float* w1 = (which ? p.w1_v : p.w1_k) + (size_t)layer * 2048 * 128;
    float* part = (float*)(p.ws + OFF_BIAS) + (which * 16 + pt) * 128;
    const int tid = my_tid(), j = tid & 127, half = tid >> 7;
    float s0 = 0.f, s1 = 0.f, s2 = 0.f, s3 = 0.f;
    const int kb = pt * 128 + half * 64;
#pragma unroll 4
    for (int k = kb; k < kb + 64; k += 4) {
        s0 += pe[k] * w1[(size_t)k * 128 + j];
        s1 += pe[k + 1] * w1[(size_t)(k + 1) * 128 + j];
        s2 += pe[k + 2] * w1[(size_t)(k + 2) * 128 + j];
        s3 += pe[k + 3] * w1[(size_t)(k + 3) * 128 + j];
    }
    float* red = (float*)lds;
    red[tid] = (s0 + s1) + (s2 + s3);
    __syncthreads();
    if (tid < 128) part[tid] = red[tid] + red[tid + 128];
    __syncthreads();
}
DI void rms_rows(const float* __restrict__ X, const float* __restrict__ g, bf16_t* __restrict__ H, int nrows, bool blocked) {
    const int lane = my_tid() & 63, w = my_tid() >> 6;
    for (int row = blockIdx.x * 4 + w; row < nrows; row += gridDim.x * 4) {
        const float* xr = X + (size_t)row * DM;
        f32x4 v[4];
        float ss = 0.f;
#pragma unroll
        for (int j = 0; j < 4; ++j) { v[j] = *(const f32x4*)(xr + lane * 4 + 256 * j); ss += v[j].x * v[j].x + v[j].y * v[j].y + v[j].z * v[j].z + v[j].w * v[j].w; }
        ss = wave_sum(ss);
        const float rs = rsqrtf(ss * (1.f / DM) + EPS);
#pragma unroll
        for (int j = 0; j < 4; ++j) {
            const f32x4 gv = *(const f32x4*)(g + lane * 4 + 256 * j);
            u32x2 o = {pack2(v[j].x * rs * gv.x, v[j].y * rs * gv.y), pack2(v[j].z * rs * gv.z, v[j].w * rs * gv.w)};
            *(u32x2*)(H + (blocked ? kbm(row, lane * 4 + 256 * j, nrows) : (size_t)row * DM + lane * 4 + 256 * j)) = o;
        }
    }
}
DI void resid_rows(const float* __restrict__ Xold, const bf16_t* __restrict__ Y, const float* __restrict__ pg, float* __restrict__ Out,
                   const float* __restrict__ g_next, bf16_t* __restrict__ H) {
    const int lane = my_tid() & 63, w = my_tid() >> 6;
    for (int row = blockIdx.x * 4 + w; row < NTOK; row += gridDim.x * 4) {
        const bf16_t* yr = Y + (size_t)row * DM;
        const float* xr = Xold + (size_t)row * DM;
        f32x4 v[4], xv[4];
        float ss = 0.f;
#pragma unroll
        for (int j = 0; j < 4; ++j) { const u32x2 yy = *(const u32x2*)(yr + lane * 4 + 256 * j); v[j] = (f32x4){bflo(yy.x), bfhi(yy.x), bflo(yy.y), bfhi(yy.y)}; xv[j] = *(const f32x4*)(xr + lane * 4 + 256 * j); ss += v[j].x * v[j].x + v[j].y * v[j].y + v[j].z * v[j].z + v[j].w * v[j].w; }
        ss = wave_sum(ss);
        const float rs = rsqrtf(ss * (1.f / DM) + EPS);
        float s2 = 0.f;
#pragma unroll
        for (int j = 0; j < 4; ++j) {
            const f32x4 gv = *(const f32x4*)(pg + lane * 4 + 256 * j);
            xv[j].x += v[j].x * rs * gv.x; xv[j].y += v[j].y * rs * gv.y; xv[j].z += v[j].z * rs * gv.z; xv[j].w += v[j].w * rs * gv.w;
            *(f32x4*)(Out + (size_t)row * DM + lane * 4 + 256 * j) = xv[j];
            s2 += xv[j].x * xv[j].x + xv[j].y * xv[j].y + xv[j].z * xv[j].z + xv[j].w * xv[j].w;
        }
        if (g_next) {
            s2 = wave_sum(s2);
            const float r2 = rsqrtf(s2 * (1.f / DM) + EPS);
#pragma unroll
            for (int j = 0; j < 4; ++j) {
                const f32x4 gv = *(const f32x4*)(g_next + lane * 4 + 256 * j);
                u32x2 o = {pack2(xv[j].x * r2 * gv.x, xv[j].y * r2 * gv.y), pack2(xv[j].z * r2 * gv.z, xv[j].w * r2 * gv.w)};
                *(u32x2*)(H + kbm(row, lane * 4 + 256 * j, NTOK)) = o;
            }
        }
    }
}
DI void rope_table(const Params& p, long gtid, long gthreads) {
    f32x2* tab = (f32x2*)(p.ws + OFF_ROPE);
    for (long idx = gtid; idx < (long)SEQ * 32; idx += gthreads) {
        const int s = (int)(idx >> 5), i = (int)(idx & 31);
        const float invf = (float)(1.0 / pow(10000.0, (double)i / 31.0));
        const float ang = (float)s * invf;
        const double a = (double)ang;
        const double k = rint(a * 0.15915494309189535);
        const float rr = (float)(a - k * 6.283185307179586);
        f32x2 cs = {cosf(rr), sinf(rr)};
        tab[idx] = cs;
    }
}

#define XB_TMO      128
#define XB_XCNT(j)  (256  + 64 * (j))
#define XB_XSUB(j)  (1280 + 64 * (j))
#define XB_XGEN(j)  (2304 + 64 * (j))
#define XB_TOP      3328
#define XB_TOPGEN   3392
#define XCD_BAR_WORDS 3456
#define XB_SPIN_CAP (1u << 18)
#define LAS __attribute__((address_space(3)))
DI unsigned xb_ld(unsigned* p) { return __hip_atomic_load(p, __ATOMIC_RELAXED, __HIP_MEMORY_SCOPE_AGENT); }
DI unsigned xb_add(unsigned* p, unsigned v) { return __hip_atomic_fetch_add(p, v, __ATOMIC_RELAXED, __HIP_MEMORY_SCOPE_AGENT); }
DI unsigned xb_xcc_id() { return (unsigned)__builtin_amdgcn_s_getreg((3 << 11) | 20) & 0xFu; }
#define XB_SPIN(cond, bar) do { unsigned _sp = 0; while (cond) { __builtin_amdgcn_s_sleep(1); \
    if ((++_sp & 255u) == 0u) { if (xb_ld(&(bar)[XB_TMO])) break; if (_sp > XB_SPIN_CAP) { atomicAdd(&(bar)[XB_TMO], 1u); break; } } } } while (0)
struct XcdBarrier { unsigned* bar; unsigned x; volatile LAS unsigned* st; };
DI XcdBarrier xcd_barrier_post(unsigned* bar, volatile LAS unsigned* st) {
    XcdBarrier b; b.bar = bar; b.x = xb_xcc_id(); b.st = st;
    if (threadIdx.x == 0) (void)xb_add(&bar[XB_XCNT(b.x)], 1u);
    return b;
}
DI void xcd_barrier_complete(unsigned* bar, unsigned x, unsigned& nloc, unsigned& nx) {
    const unsigned G = gridDim.x * gridDim.y * gridDim.z;
    unsigned sum, cnt, mine, sp = 0u;
    for (;;) {
        sum = 0u; cnt = 0u; mine = 0u;
#pragma unroll
        for (unsigned j = 0; j < 16; ++j) { const unsigned c = xb_ld(&bar[XB_XCNT(j)]); sum += c; cnt += (c > 0u) ? 1u : 0u; mine = (j == x) ? c : mine; }
        if (sum == G) break;
        __builtin_amdgcn_s_sleep(1);
        if ((++sp & 255u) == 0u) { if (xb_ld(&bar[XB_TMO])) break; if (sp > XB_SPIN_CAP) { atomicAdd(&bar[XB_TMO], 1u); break; } }
    }
    nloc = mine > 0u ? mine : 1u; nx = cnt > 0u ? cnt : 1u;
}
DI void xcd_barrier(const XcdBarrier& b) {
    asm volatile("s_waitcnt vmcnt(0)" ::: "memory");
    __syncthreads();
    if (threadIdx.x == 0) {
        unsigned* bar = b.bar;
        __builtin_amdgcn_s_waitcnt(0);
        unsigned nloc = b.st[0], nx = b.st[1];
        if (nloc == 0u) { xcd_barrier_complete(bar, b.x, nloc, nx); b.st[0] = nloc; b.st[1] = nx; }
        const unsigned old = xb_add(&bar[XB_XSUB(b.x)], 1u);
        const unsigned gen = old / nloc;
        if (old + 1u == (gen + 1u) * nloc) {
            __builtin_amdgcn_fence(__ATOMIC_RELEASE, "agent");
            asm volatile("s_waitcnt vmcnt(0)" ::: "memory");
            const unsigned og = xb_add(&bar[XB_TOP], 1u);
            const unsigned tg = og / nx;
            if (og + 1u == (tg + 1u) * nx) xb_add(&bar[XB_TOPGEN], 1u);
            else XB_SPIN(xb_ld(&bar[XB_TOPGEN]) == tg, bar);
            __builtin_amdgcn_fence(__ATOMIC_ACQUIRE, "agent");
            xb_add(&bar[XB_XGEN(b.x)], 1u);
            asm volatile("s_waitcnt vmcnt(0)" ::: "memory");
        } else {
            XB_SPIN(xb_ld(&bar[XB_XGEN(b.x)]) == gen, bar);
            __builtin_amdgcn_fence(__ATOMIC_ACQUIRE, "agent");
            asm volatile("s_waitcnt vmcnt(0)" ::: "memory");
        }
    }
    __syncthreads();
}

__global__ __launch_bounds__(256, 2) void mega(Params p) {
    __shared__ __attribute__((aligned(16))) char lds[LDS_BYTES];
    __shared__ int s_item;
    __shared__ float s_bias[128];
    cg::grid_group grid = cg::this_grid();
    __shared__ uint4 xb_words;
    if (threadIdx.x == 0) xb_words = make_uint4(0u, 0u, 0u, 0u);
    __syncthreads();
    const XcdBarrier xb = xcd_barrier_post((unsigned*)(p.ws + OFF_BAR), (volatile LAS unsigned*)&xb_words);
#define GTID ((long)blockIdx.x * 256 + my_tid())
#define GTHREADS ((long)gridDim.x * 256)
    bf16_t* hbuf = (bf16_t*)(p.ws + OFF_H);
    unsigned* ctr = (unsigned*)(p.ws + OFF_CTR);

    if (GTID < 256) ctr[GTID] = 0u;
    for (int r0 = 0; r0 < REP0; ++r0) {
#ifndef SKIP_CONV
    conv_layer_weights(p, 0, GTID, GTHREADS);
#endif
    rope_table(p, GTID, GTHREADS);
#ifndef SKIP_BIAS
    cmp_bias(p, 0, lds);
#endif
    rms_rows(p.x, p.pre_g, hbuf, NTOK, true);
    rms_rows(p.mem, p.mem_g, (bf16_t*)(p.ws + OFF_MEMN), 2048, false);
    if (p.ws == nullptr) grid.sync();
    xcd_barrier(xb);
    }

#ifdef EXTRA_SYNCS
    for (int es = 0; es < EXTRA_SYNCS; ++es) grid.sync();
#endif
#pragma unroll 1
    for (int layer = 0; layer < 2; ++layer) {
        for (int r123 = 0; r123 < REP123; ++r123) {
        for (int r1 = 0; r1 < REP1; ++r1) {
#ifndef SKIP_P1
        {
            const bf16_t* winT = (const bf16_t*)(p.ws + OFF_WIN);
            const f32x2* rope = (const f32x2*)(p.ws + OFF_ROPE);
            const int xcd = blockIdx.x & 7, li = blockIdx.x >> 3, nb = (gridDim.x + 7 - xcd) >> 3;
#pragma unroll 1
            for (int q = li; q < 832; q += nb) {
                const int q1 = q / 208, q2 = q - q1 * 208;
                int nt, ml;
                if (q2 < 192) { const int ng = q2 >> 6, in = q2 & 63; nt = 8 * ng + (in & 7); ml = in >> 3; }
                else { const int q3 = q2 - 192; nt = 24 + (q3 & 1); ml = q3 >> 1; }
                const int mt = 32 * xcd + 8 * q1 + ml;
                const bf16_t* A = hbuf + (size_t)mt * 128 * 32;
                const bf16_t* Bt = winT + (size_t)nt * 256 * 32;
                if (nt >= 12 && nt < 17) {
                    EpiVT e{(bf16_t*)(p.ws + OFF_VT), NVT, SEQ, mt * 128, nt * 256 - 3072};
                    gemm_wide<false>(lds, A, ARowLin{32}, Bt, 32, 16, e, (long)NTOK * 32, (long)NIN * 32);
                } else {
                    EpiRow e;
                    e.rope = rope; e.row0 = mt * 128;
                    if (nt < 12) { e.dst = (bf16_t*)(p.ws + OFF_BUFA); e.ld = NA; e.col0 = nt * 256; e.mode = (nt == 8) ? EM_ROPEQ : ((nt == 9) ? EM_ROPEK : EM_PLAIN); e.rkt = (nt == 9) ? (bf16_t*)(p.ws + OFF_RKT) : nullptr; }
                    else if (nt < 25) { e.dst = (bf16_t*)(p.ws + OFF_BUFZ); e.ld = NZ; e.col0 = (nt - 17) * 256; e.mode = EM_SILU; e.zblk = true; }
                    else { e.dst = (bf16_t*)(p.ws + OFF_BUFA); e.ld = NA; e.col0 = CA_GATE; e.mode = EM_GATE; }
                    gemm_wide<true>(lds, A, ARowLin{32}, Bt, 32, 16, e, (long)NTOK * 32, (long)NIN * 32);
                }
            }
        }
#endif
        xcd_barrier(xb);
        }
        for (int r2 = 0; r2 < REP2; ++r2) {
#ifndef SKIP_P2
        {
            const bf16_t* bufA = (const bf16_t*)(p.ws + OFF_BUFA);
            float* kmean = (float*)(p.ws + OFF_KMEAN);
            const int n_km = 8 * 16 * 4, n_cmp = 256, n_mem = 16 * 4, n_u = 8 * 4 * 32;
#pragma unroll 1
            for (int t = blockIdx.x; t < n_cmp + n_km + n_mem + n_u; t += gridDim.x) {
                if (t >= n_cmp + n_km + n_mem) {
                    const int u = t - (n_cmp + n_km + n_mem), c = u & 31, bh = u >> 5, b = bh >> 2, hh = bh & 3;
                    const int tid = my_tid(), lane = tid & 63, w = tid >> 6, r = lane & 31, h = lane >> 5;
                    const bf16_t* vtp = (const bf16_t*)(p.ws + OFF_VT) + ((size_t)b * NVT + CV_RV + hh * 128 + 32 * w + r) * SEQ + c * 128 + 8 * h;
                    const bf16_t* ktp = (const bf16_t*)(p.ws + OFF_RKT) + ((size_t)(b * 4 + hh) * 64 + r) * SEQ + c * 128 + 8 * h;
                    f32x16 u0 = zero16(), u1 = zero16();
#pragma unroll
                    for (int kk = 0; kk < 8; ++kk) {
                        const bf16x8 xf = *(const bf16x8*)(vtp + 16 * kk);
                        const bf16x8 y0 = *(const bf16x8*)(ktp + 16 * kk), y1 = *(const bf16x8*)(ktp + (size_t)32 * SEQ + 16 * kk);
                        u0 = MFMA(xf, y0, u0); u1 = MFMA(xf, y1, u1);
                    }
                    bf16_t* up = (bf16_t*)(p.ws + OFF_U) + (size_t)u * 8192;
#pragma unroll
                    for (int i = 0; i < 16; ++i) {
                        up[(32 * w + crow(i, h)) * 64 + r] = (bf16_t)(pack2(u0[i], 0.f) & 0xffffu);
                        up[(32 * w + crow(i, h)) * 64 + 32 + r] = (bf16_t)(pack2(u1[i], 0.f) & 0xffffu);
                    }
                } else if (t >= n_cmp + n_km) {
                    const int u = t - n_cmp - n_km, mt = u >> 2, nt = u & 3;
                    const bf16_t* A = (const bf16_t*)(p.ws + OFF_MEMN) + (size_t)mt * 128 * 1024;
                    const bf16_t* Bt = (const bf16_t*)(p.ws + OFF_WMEM) + (size_t)nt * 256 * 1024;
                    if (nt >= 2) {
                        EpiVT e{(bf16_t*)(p.ws + OFF_MEMV), 512, 256, mt * 128, nt * 256 - 512};
                        gemm_wide<false>(lds, A, ARowLin{1024}, Bt, 1024, 16, e);
                    } else {
                        EpiRow e; e.rope = nullptr; e.row0 = mt * 128; e.dst = (bf16_t*)(p.ws + OFF_MEMK); e.ld = 512; e.col0 = nt * 256; e.mode = EM_PLAIN;
                        gemm_wide<true>(lds, A, ARowLin{1024}, Bt, 1024, 16, e);
                    }
                } else if (t < n_cmp) {
                    const int tileid = t >> 2, split = t & 3, isv = tileid >> 5, mt = tileid & 31;
                    float* cpart = (float*)(p.ws + OFF_CPART) + (size_t)tileid * 4 * 64 * 256;
                    {
                        EpiPart ep{cpart + (size_t)split * 64 * 256};
                        gemm_tile<true>(lds, bufA + (size_t)split * 8 * NA, ARowCmp{mt * 128, isv ? CA_NVC : CA_NKC}, NA,
                                        (const bf16_t*)(p.ws + (isv ? OFF_W1V : OFF_W1K)) + split * 512, 2048, 8, ep);
                    }
                    __threadfence();
                    __syncthreads();
                    if (my_tid() == 0) s_item = (int)atomicAdd(ctr + 64 + layer * 64 + tileid, 1u);
                    __syncthreads();
                    const bool last = (s_item == 3);
                    __syncthreads();
                    if (!last) continue;
                    __threadfence();
                    float* lbias = s_bias;
                    if (my_tid() < 128) {
                        const float* part = (const float*)(p.ws + OFF_BIAS) + isv * 16 * 128 + my_tid();
                        float bsum = 0.f;
#pragma unroll
                        for (int q = 0; q < 16; ++q) bsum += part[q * 128];
                        lbias[my_tid()] = bsum;
                    }
                    __syncthreads();
                    {
                        const int tid2 = my_tid(), row = tid2 >> 1, c0 = (tid2 & 1) * 64;
                        const float* pp = cpart + row * 128 + c0;
#pragma unroll 4
                        for (int cg = 0; cg < 16; ++cg) {
                            const f32x4 a0 = *(const f32x4*)(pp + cg * 4), a1 = *(const f32x4*)(pp + 16384 + cg * 4);
                            const f32x4 a2 = *(const f32x4*)(pp + 2 * 16384 + cg * 4), a3 = *(const f32x4*)(pp + 3 * 16384 + cg * 4);
                            const f32x4 sm = ((a0 + a1) + a2) + a3;
                            const f32x4 bv = *(const f32x4*)(lbias + c0 + cg * 4);
                            u32x2 o = {pack2(silu_f(sm.x + bv.x), silu_f(sm.y + bv.y)), pack2(silu_f(sm.z + bv.z), silu_f(sm.w + bv.w))};
                            *(u32x2*)(lds + row * HSTR + (c0 + cg * 4) * 2) = o;
                        }
                    }
                    __syncthreads();
                    const float* w2 = (isv ? p.w2_v : p.w2_k) + (size_t)layer * 128 * 64;
                    const int tid = my_tid(); const int c = tid & 63, rg = tid >> 6;
                    float* w2s = (float*)(lds + 36864);
#pragma unroll
                    for (int q = 0; q < 8; ++q) *(f32x4*)(w2s + (q * 256 + tid) * 4) = *(const f32x4*)(w2 + (q * 256 + tid) * 4);
                    __syncthreads();
                    float a32[32];
#pragma unroll
                    for (int rr = 0; rr < 32; ++rr) a32[rr] = 0.f;
#pragma unroll 2
                    for (int k = 0; k < 128; k += 2) {
                        const float w0 = w2s[k * 64 + c], w1 = w2s[(k + 1) * 64 + c];
#pragma unroll
                        for (int rr = 0; rr < 32; ++rr) {
                            const unsigned u = *(const unsigned*)(lds + (rg * 32 + rr) * HSTR + k * 2);
                            a32[rr] += bflo(u) * w0 + bfhi(u) * w1;
                        }
                    }
                    bf16_t* kcb = (bf16_t*)(p.ws + OFF_KC);
                    bf16_t* vcb = (bf16_t*)(p.ws + OFF_VCT);
#pragma unroll
                    for (int rr = 0; rr < 32; ++rr) {
                        const int R = mt * 128 + rg * 32 + rr, bg = R >> 8, i = R & 255;
                        const bf16_t val = (bf16_t)(pack2(a32[rr], 0.f) & 0xffffu);
                        if (isv) vcb[((size_t)bg * 64 + c) * 256 + i] = val; else kcb[((size_t)bg * 256 + i) * 64 + c] = val;
                    }
                    __syncthreads();
                } else {
                    const int u = t - n_cmp, qd = u & 3, n = (u >> 2) & 15, b = u >> 6;
                    const int tid = my_tid(); const int cp = tid & 63, kg = tid >> 6;
                    const bf16_t* src = bufA + (size_t)(b * SEQ + n * 256 + kg * 64) * NA + CA_MK + qd * 128 + 2 * cp;
                    float s0 = 0.f, s1 = 0.f;
                    for (int k = 0; k < 64; ++k) { const unsigned uu = *(const unsigned*)(src + (size_t)k * NA); s0 += bflo(uu); s1 += bfhi(uu); }
                    float* red = (float*)lds;
                    red[kg * 128 + 2 * cp] = s0; red[kg * 128 + 2 * cp + 1] = s1;
                    __syncthreads();
                    if (tid < 128) {
                        const float sum = red[tid] + red[128 + tid] + red[256 + tid] + red[384 + tid];
                        const int hh = qd * 2 + (tid >> 6), d = tid & 63;
                        kmean[((size_t)(b * 8 + hh) * 16 + n) * 64 + d] = sum * (1.f / 256.f);
                    }
                    __syncthreads();
                }
            }
        }
#endif
        xcd_barrier(xb);
        }
#ifndef SKIP_P3
        {
            int qsel = blockIdx.x & 7, qtried = 0;
#pragma unroll 1
            while (true) {
                if (my_tid() == 0) s_item = (int)atomicAdd(ctr + layer * 32 + r123 * 16 + qsel, 1u);
                __syncthreads();
                const int id = s_item;
                __syncthreads();
                if (id >= 768) { if (++qtried >= 8) break; qsel = (qsel + 1) & 7; continue; }
                const int b = qsel;
                if (id < 256) {
#ifndef SKIP_NSA
                    for (int rp = 0; rp < REP_NSA; ++rp) nsa_item(p, lds, b, id >> 7, 127 - (id & 127), rp == REP_NSA - 1);
#endif
                } else if (id < 512) {
#ifndef SKIP_MOBA
                    const int u = id - 256; for (int rp = 0; rp < REP_MOBA; ++rp) moba_item(p, lds, b, u >> 5, 31 - (u & 31), rp == REP_MOBA - 1);
#endif
                } else if (id < 640) {
#ifndef SKIP_RET
                    const int u = id - 512; for (int rp = 0; rp < REP_RET; ++rp) ret_item(p, lds, layer, b, u >> 5, 31 - (u & 31), rp == REP_RET - 1);
#endif
                } else {
#ifndef SKIP_MEM
                    const int u = id - 640; for (int rp = 0; rp < REP_MEM; ++rp) mem_item(p, lds, b, u >> 5, u & 31, rp == REP_MEM - 1);
#endif
                }
            }
        }
#endif
        xcd_barrier(xb);
        }
        for (int r4 = 0; r4 < REP4; ++r4) {
#ifndef SKIP_P4
        {
            const bf16_t* bufZ = (const bf16_t*)(p.ws + OFF_BUFZ);
            const bf16_t* woT = (const bf16_t*)(p.ws + OFF_WOUT);
            const int xcd = blockIdx.x & 7, li = blockIdx.x >> 3, nb = (gridDim.x + 7 - xcd) >> 3;
#pragma unroll 1
            for (int q = li; q < 128; q += nb) {
                const int mt = 32 * xcd + (q >> 2), nt = q & 3;
                EpiY e{(bf16_t*)(p.ws + OFF_Y), mt * 128, nt * 256};
                gemm_wide<true>(lds, bufZ + (size_t)mt * 128 * 32, ARowLin{32}, woT + (size_t)nt * 256 * 32, 32, 32, e, (long)NTOK * 32, (long)1024 * 32);
            }
        }
#endif
        xcd_barrier(xb);
        }
        {
            const float* xold = layer == 0 ? p.x : p.out;
            resid_rows(xold, (const bf16_t*)(p.ws + OFF_Y), p.post_g + layer * DM, p.out, layer == 0 ? p.pre_g + DM : nullptr, hbuf);
            if (layer == 0) {
                conv_layer_weights(p, 1, GTID, GTHREADS);
                cmp_bias(p, 1, lds);
                rms_rows(p.mem, p.mem_g + DM, (bf16_t*)(p.ws + OFF_MEMN), 2048, false);
                xcd_barrier(xb);
            }
        }
    }
}

extern "C" void kernel_launch(void* const* d_in, const int* in_sizes, int n_in, void* d_out, int out_size, void* d_ws, size_t ws_size, hipStream_t stream) {
    static int grid_blocks = 0;
    if (!grid_blocks) {
        int dev = 0, cus = 0, per_cu = 0;
        hipGetDevice(&dev);
        hipDeviceGetAttribute(&cus, hipDeviceAttributeMultiprocessorCount, dev);
        hipOccupancyMaxActiveBlocksPerMultiprocessor(&per_cu, mega, 256, 0);
        if (per_cu < 1) per_cu = 1;
        if (per_cu > 2) per_cu = 2;
#ifdef FORCE_PER_CU
        per_cu = FORCE_PER_CU;
#endif
        grid_blocks = cus * per_cu;
    }
    if (ws_size < WS_NEED) fprintf(stderr, "workspace too small: %zu < %zu\n", ws_size, (size_t)WS_NEED);
    Params p{};
    p.x = (const float*)d_in[0]; p.mem = (const float*)d_in[1]; p.pre_g = (const float*)d_in[2]; p.post_g = (const float*)d_in[3];
    p.mem_g = (const float*)d_in[4]; p.w_in = (const float*)d_in[5]; p.w_mem = (const float*)d_in[6]; p.pe_k = (const float*)d_in[7];
    p.w1_k = (const float*)d_in[8]; p.w2_k = (const float*)d_in[9]; p.pe_v = (const float*)d_in[10]; p.w1_v = (const float*)d_in[11];
    p.w2_v = (const float*)d_in[12]; p.gn_g = (const float*)d_in[13]; p.w_out = (const float*)d_in[14];
    p.out = (float*)d_out; p.ws = (char*)d_ws;
    (void)hipMemsetAsync((char*)d_ws + OFF_BAR, 0, XCD_BAR_WORDS * 4, stream);
    void* args[] = {&p};
    hipError_t e = hipLaunchCooperativeKernel((void*)mega, dim3(grid_blocks), dim3(256), args, 0, stream);
    if (e != hipSuccess) fprintf(stderr, "cooperative launch failed: %s (grid %d)\n", hipGetErrorString(e), grid_blocks);
}
```

```cpp
#include <hip/hip_runtime.h>
#include <hip/hip_cooperative_groups.h>
#include <stdint.h>
#include <cstdio>
namespace cg = cooperative_groups;

typedef unsigned short bf16_t;
typedef short bf16x8 __attribute__((ext_vector_type(8)));
typedef float f32x16 __attribute__((ext_vector_type(16)));
typedef float f32x4 __attribute__((ext_vector_type(4)));
typedef float f32x2 __attribute__((ext_vector_type(2)));
typedef unsigned u32x4 __attribute__((ext_vector_type(4)));
typedef unsigned u32x2 __attribute__((ext_vector_type(2)));
typedef __bf16 bf16v2 __attribute__((ext_vector_type(2)));
typedef unsigned long long u64;
#define DI __device__ __forceinline__
#define MFMA(a, b, c) __builtin_amdgcn_mfma_f32_32x32x16_bf16((a), (b), (c), 0, 0, 0)

constexpr int SEQ = 4096, DM = 1024, NTOK = 32768;
constexpr int NA = 3096;
constexpr int NZ = 2048;
constexpr int NVT = 1280;
constexpr int NIN = 6656;
constexpr float EPS = 1e-6f;
DI size_t kbm(int row, int k, int nrows) { return ((size_t)(k >> 5) * nrows + row) * 32 + (k & 31); }
constexpr float LOG2E = 1.4426950408889634f;

constexpr int CA_MQ = 0, CA_MK = 512, CA_NQ = 1024, CA_NKC = 1536, CA_NVC = 1664, CA_NKS = 1792, CA_NKW = 1920,
              CA_RQ = 2048, CA_RK = 2304, CA_CQ = 2560, CA_GATE = 3072;
constexpr int CV_MV = 0, CV_NVS = 512, CV_NVW = 640, CV_RV = 768;

constexpr size_t OFF_BUFA = 0;
constexpr size_t OFF_VT   = OFF_BUFA + (size_t)NTOK * NA * 2;
constexpr size_t OFF_BUFZ = OFF_VT + (size_t)8 * NVT * SEQ * 2;
constexpr size_t OFF_H    = OFF_BUFZ + (size_t)NTOK * NZ * 2;
constexpr size_t OFF_WIN  = OFF_H + (size_t)NTOK * DM * 2;
constexpr size_t OFF_WOUT = OFF_WIN + (size_t)NIN * 1024 * 2;
constexpr size_t OFF_WMEM = OFF_WOUT + (size_t)1024 * 2048 * 2;
constexpr size_t OFF_W1K  = OFF_WMEM + (size_t)1024 * 1024 * 2;
constexpr size_t OFF_W1V  = OFF_W1K + (size_t)128 * 2048 * 2;
constexpr size_t OFF_ROPE = OFF_W1V + (size_t)128 * 2048 * 2;
constexpr size_t OFF_MEMN = OFF_ROPE + (size_t)SEQ * 32 * 8;
constexpr size_t OFF_MEMK = OFF_MEMN + (size_t)2048 * 1024 * 2;
constexpr size_t OFF_MEMV = OFF_MEMK + (size_t)2048 * 512 * 2;
constexpr size_t OFF_BIAS = OFF_MEMV + (size_t)8 * 512 * 256 * 2;
constexpr size_t OFF_CTR  = OFF_BIAS + 16384;
constexpr size_t OFF_BAR  = OFF_CTR + 1024;
constexpr size_t OFF_RKT  = OFF_BAR + 16384;
constexpr size_t WS_NEED  = OFF_RKT + (size_t)8 * 4 * 64 * SEQ * 2;
constexpr size_t OFF_KMEAN = OFF_H;
constexpr size_t OFF_KC    = OFF_KMEAN + (size_t)8 * 8 * 16 * 64 * 4;
constexpr size_t OFF_VCT   = OFF_KC + (size_t)16 * 256 * 64 * 2;
constexpr size_t OFF_U = OFF_H + ((size_t)24 << 20);
constexpr size_t OFF_CPART = OFF_H + ((size_t)4 << 20);
constexpr size_t OFF_Y = OFF_BUFA;

constexpr int LDS_BYTES = 73728;
#ifndef REP1
#define REP1 1
#endif
#ifndef REP_NSA
#define REP_NSA 1
#endif
#ifndef REP_MOBA
#define REP_MOBA 1
#endif
#ifndef REP_RET
#define REP_RET 1
#endif
#ifndef REP_MEM
#define REP_MEM 1
#endif
#ifndef REP0
#define REP0 1
#endif
#ifndef REP2
#define REP2 1
#endif
#ifndef REP4
#define REP4 1
#endif
#ifndef REP123
#define REP123 1
#endif

struct Params {
    const float *x, *mem, *pre_g, *post_g, *mem_g, *w_in, *w_mem, *pe_k, *w1_k, *w2_k, *pe_v, *w1_v, *w2_v, *gn_g, *w_out;
    float* out;
    char* ws;
};

DI int my_tid() { int t = threadIdx.x; asm volatile("" : "+v"(t)); return t; }
DI unsigned pack2(float a, float b) { f32x2 v = {a, b}; bf16v2 r = __builtin_convertvector(v, bf16v2); return __builtin_bit_cast(unsigned, r); }
DI float bflo(unsigned u) { return __uint_as_float(u << 16); }
DI float bfhi(unsigned u) { return __uint_as_float(u & 0xffff0000u); }
DI float bf2f(bf16_t v) { return __uint_as_float(((unsigned)v) << 16); }
DI int crow(int reg, int h) { return (reg & 3) + 8 * (reg >> 2) + 4 * h; }
DI float ex2(float x) { return __builtin_amdgcn_exp2f(x); }
DI float ret_lg(int hh) { return (hh == 0) ? -0.045803688f : (hh == 1 ? -0.022720077f : (hh == 2 ? -0.011315314f : -0.0056465633f)); }
DI float mx2(float a, float b) { return __builtin_amdgcn_fmed3f(a, b, INFINITY); }
DI float shx(float v, int m) { return __shfl_xor(v, m, 64); }
DI float wave_sum(float v) { v += shx(v, 32); v += shx(v, 16); v += shx(v, 8); v += shx(v, 4); v += shx(v, 2); v += shx(v, 1); return v; }
DI float silu_f(float v) { return v * __builtin_amdgcn_rcpf(1.f + __expf(-v)); }
DI float sigm_f(float v) { return __builtin_amdgcn_rcpf(1.f + __expf(-v)); }
DI f32x16 zero16() { f32x16 z; for (int i = 0; i < 16; ++i) z[i] = 0.f; return z; }

DI int in_col_src(int n) {
    if (n < 1024) return n;
    if (n < 1920) return n + 512;
    if (n < 2048) return n + 640;
    if (n < 2560) return n + 792;
    if (n < 3072) return n + 1304;
    if (n < 3584) return n - 2048;
    if (n < 3712) return n - 1152;
    if (n < 3840) return n - 1024;
    if (n < 4352) return n - 488;
    if (n < 6400) return n + 24;
    if (n < 6424) return n - 3584;
    return -1;
}

constexpr int GSTR = 144;
constexpr int GBUF = 36864;
constexpr int GBOFF = 18432;

DI void glds16(const void* g, unsigned lds_addr);
template <int N> DI void wait_vm();
#define RAW_BARRIER() do { asm volatile("s_waitcnt lgkmcnt(0)" ::: "memory"); __builtin_amdgcn_s_barrier(); asm volatile("" ::: "memory"); } while (0)
template <bool SWAP, class AOff, class Epi>
DI void gemm_tile(char* lds, const bf16_t* __restrict__ A, AOff aoff, long a_kstride, const bf16_t* __restrict__ Bt, long ldb, int nk64, Epi epi) {
    constexpr int TB = 16384, NI = 4;
    const int tid = my_tid(), lane = tid & 63, w = __builtin_amdgcn_readfirstlane(tid >> 6), r = lane & 31, h = lane >> 5;
    const int wm = w >> 1, wn = w & 1;
    const int nk = nk64 * 2;
    const int lr = lane >> 2, ls = lane & 3;
    const bf16_t* ap[2];
    const bf16_t* bp[2];
#pragma unroll
    for (int i = 0; i < 2; ++i) {
        const int row = 16 * (w + 4 * i) + lr, c = ls ^ ((row >> 2) & 3);
        ap[i] = A + aoff(row) + c * 8;
        bp[i] = Bt + (long)row * ldb + c * 8;
    }
    const unsigned sbase = (unsigned)(size_t)lds;
    f32x16 acc[2][2];
#pragma unroll
    for (int i = 0; i < 2; ++i)
#pragma unroll
        for (int j = 0; j < 2; ++j) acc[i][j] = zero16();
    int issued = 0;
#pragma unroll 1
    for (int a = 0; a < 3; ++a) {
        if (issued < nk) {
            const long ko_a = (long)(issued >> 1) * a_kstride + (issued & 1) * 32, ko_b = (long)issued * 32;
            const unsigned st = sbase + (issued & 3) * TB + w * 1024;
            glds16(ap[0] + ko_a, st); glds16(bp[0] + ko_b, st + 8192);
            glds16(ap[1] + ko_a, st + 4096); glds16(bp[1] + ko_b, st + 8192 + 4096);
            ++issued;
        }
    }
    const int fa = (wm * 64 + r) * 64, fb = 8192 + (wn * 64 + r) * 64, sw = (r >> 2) & 3;
#pragma unroll 1
    for (int kb = 0; kb < nk; ++kb) {
        const int ahead = issued - 1 - kb;
        if (ahead >= 2) wait_vm<2 * NI>(); else if (ahead == 1) wait_vm<NI>(); else wait_vm<0>();
        RAW_BARRIER();
        if (issued < nk) {
            const long ko_a = (long)(issued >> 1) * a_kstride + (issued & 1) * 32, ko_b = (long)issued * 32;
            const unsigned st = sbase + (issued & 3) * TB + w * 1024;
            glds16(ap[0] + ko_a, st); glds16(bp[0] + ko_b, st + 8192);
            glds16(ap[1] + ko_a, st + 4096); glds16(bp[1] + ko_b, st + 8192 + 4096);
            ++issued;
        }
        const char* cur = lds + (kb & 3) * TB;
        bf16x8 af[2][2], bfr[2][2];
#pragma unroll
        for (int kk = 0; kk < 2; ++kk) {
            const int so = ((2 * kk + h) ^ sw) * 16;
#pragma unroll
            for (int i = 0; i < 2; ++i) af[kk][i] = *(const bf16x8*)(cur + fa + i * 2048 + so);
#pragma unroll
            for (int j = 0; j < 2; ++j) bfr[kk][j] = *(const bf16x8*)(cur + fb + j * 2048 + so);
        }
#pragma unroll
        for (int kk = 0; kk < 2; ++kk)
#pragma unroll
            for (int i = 0; i < 2; ++i)
#pragma unroll
                for (int j = 0; j < 2; ++j) acc[i][j] = SWAP ? MFMA(bfr[kk][j], af[kk][i], acc[i][j]) : MFMA(af[kk][i], bfr[kk][j], acc[i][j]);
    }
    RAW_BARRIER();
    epi(acc, wm, wn, r, h);
}

template <bool SWAP, class AOff, class Epi>
DI void gemm_wide(char* lds, const bf16_t* __restrict__ A, AOff aoff, const bf16_t* __restrict__ Bt, long ldb, int nk64, Epi epi, long a_ks = 32, long b_ks = 32) {
    constexpr int TB = 24576, NI = 6;
    const int tid = my_tid(), lane = tid & 63, w = __builtin_amdgcn_readfirstlane(tid >> 6), r = lane & 31, h = lane >> 5;
    const int wm = w >> 1, wn = w & 1;
    const int nk = nk64 * 2;
    const int lr = lane >> 2, ls = lane & 3;
    const bf16_t* ap[2];
    const bf16_t* bp[4];
#pragma unroll
    for (int i = 0; i < 2; ++i) { const int row = 16 * (w + 4 * i) + lr, c = ls ^ ((row >> 2) & 3); ap[i] = A + aoff(row) + c * 8; }
#pragma unroll
    for (int i = 0; i < 4; ++i) { const int row = 16 * (w + 4 * i) + lr, c = ls ^ ((row >> 2) & 3); bp[i] = Bt + (long)row * ldb + c * 8; }
    const unsigned sbase = (unsigned)(size_t)lds;
    f32x16 acc[2][4];
#pragma unroll
    for (int i = 0; i < 2; ++i)
#pragma unroll
        for (int j = 0; j < 4; ++j) acc[i][j] = zero16();
    int issued = 0, si = 0;
#pragma unroll 1
    for (int a = 0; a < 2; ++a) {
        if (issued < nk) {
            const long ko = (long)issued * a_ks, kob = (long)issued * b_ks;
            const unsigned st = sbase + si * TB + w * 1024;
            glds16(ap[0] + ko, st); glds16(ap[1] + ko, st + 4096);
            glds16(bp[0] + kob, st + 8192); glds16(bp[1] + kob, st + 8192 + 4096); glds16(bp[2] + kob, st + 8192 + 8192); glds16(bp[3] + kob, st + 8192 + 12288);
            ++issued; si = (si == 2) ? 0 : si + 1;
        }
    }
    const int fa = (wm * 64 + r) * 64, fb = 8192 + (wn * 128 + r) * 64, sw = (r >> 2) & 3;
    int sc_ = 0;
#pragma unroll 1
    for (int kb = 0; kb < nk; ++kb) {
        if (issued - 1 - kb >= 1) wait_vm<NI>(); else wait_vm<0>();
        RAW_BARRIER();
        const char* cur = lds + sc_ * TB;
        sc_ = (sc_ == 2) ? 0 : sc_ + 1;
        bf16x8 af[2][2], bfr[2][4];
#pragma unroll
        for (int kk = 0; kk < 2; ++kk) {
            const int so = ((2 * kk + h) ^ sw) * 16;
#pragma unroll
            for (int i = 0; i < 2; ++i) af[kk][i] = *(const bf16x8*)(cur + fa + i * 2048 + so);
#pragma unroll
            for (int j = 0; j < 4; ++j) bfr[kk][j] = *(const bf16x8*)(cur + fb + j * 2048 + so);
        }
        if (issued < nk) {
            const long ko = (long)issued * a_ks, kob = (long)issued * b_ks;
            const unsigned st = sbase + si * TB + w * 1024;
            glds16(ap[0] + ko, st); glds16(ap[1] + ko, st + 4096);
            glds16(bp[0] + kob, st + 8192); glds16(bp[1] + kob, st + 8192 + 4096); glds16(bp[2] + kob, st + 8192 + 8192); glds16(bp[3] + kob, st + 8192 + 12288);
            ++issued; si = (si == 2) ? 0 : si + 1;
        }
#pragma unroll
        for (int kk = 0; kk < 2; ++kk)
#pragma unroll
            for (int i = 0; i < 2; ++i)
#pragma unroll
                for (int j = 0; j < 4; ++j) acc[i][j] = SWAP ? MFMA(bfr[kk][j], af[kk][i], acc[i][j]) : MFMA(af[kk][i], bfr[kk][j], acc[i][j]);
    }
    RAW_BARRIER();
    epi(acc, wm, wn, r, h);
}

struct ARowLin { long ld; DI long operator()(int r) const { return (long)r * ld; } };

enum { EM_PLAIN = 0, EM_ROPEQ = 1, EM_ROPEK = 2, EM_SILU = 3, EM_GATE = 4 };
struct EpiRow {
    bf16_t* dst; long ld; int row0; int col0; int mode; const f32x2* rope; bool zblk = false; bf16_t* rkt = nullptr;
    template <int NJ> DI void operator()(f32x16 (&acc)[2][NJ], int wm, int wn, int r, int h) const {
#pragma unroll
        for (int i = 0; i < 2; ++i) {
            const int row = row0 + wm * 64 + 32 * i + r;
            if (mode == EM_ROPEQ || mode == EM_ROPEK) {
                const int pos = row & (SEQ - 1);
                const float scl = (mode == EM_ROPEK) ? 0.125f : 1.f;
#pragma unroll
                for (int jp = 0; jp < NJ; jp += 2)
#pragma unroll
                for (int c4 = 0; c4 < 4; ++c4) {
                    float n1[4], n2[4];
#pragma unroll
                    for (int e = 0; e < 4; ++e) {
                        const int d = 8 * c4 + 4 * h + e;
                        const f32x2 cs = rope[pos * 32 + d];
                        const float t1 = acc[i][jp][4 * c4 + e], t2 = acc[i][jp + 1][4 * c4 + e];
                        n1[e] = (t1 * cs.x - t2 * cs.y) * scl;
                        n2[e] = (t1 * cs.y + t2 * cs.x) * scl;
                    }
                    bf16_t* d1 = dst + (long)row * ld + col0 + wn * (32 * NJ) + 32 * jp + 8 * c4 + 4 * h;
                    u32x2 o1 = {pack2(n1[0], n1[1]), pack2(n1[2], n1[3])};
                    u32x2 o2 = {pack2(n2[0], n2[1]), pack2(n2[2], n2[3])};
                    *(u32x2*)d1 = o1;
                    *(u32x2*)(d1 + 32) = o2;
                    if (mode == EM_ROPEK && rkt != nullptr) {
                        const int hh = (wn * (32 * NJ) + 32 * jp) >> 6;
                        const float wgt = ex2(ret_lg(hh) * (float)(127 - (pos & 127)));
                        bf16_t* tp = rkt + ((size_t)((row >> 12) * 4 + hh) * 64 + 8 * c4 + 4 * h) * SEQ + pos;
#pragma unroll
                        for (int e = 0; e < 4; ++e) {
                            tp[(size_t)e * SEQ] = (bf16_t)(pack2(n1[e] * wgt, 0.f) & 0xffffu);
                            tp[(size_t)(e + 32) * SEQ] = (bf16_t)(pack2(n2[e] * wgt, 0.f) & 0xffffu);
                        }
                    }
                }
            } else {
#pragma unroll
                for (int j = 0; j < NJ; ++j)
#pragma unroll
                    for (int c4 = 0; c4 < 4; ++c4) {
                        const int cl = wn * (32 * NJ) + 32 * j + 8 * c4 + 4 * h;
                        float v[4];
#pragma unroll
                        for (int e = 0; e < 4; ++e) v[e] = acc[i][j][4 * c4 + e];
                        if (mode == EM_SILU) {
#pragma unroll
                            for (int e = 0; e < 4; ++e) v[e] = silu_f(v[e]);
                        }
                        if (mode == EM_GATE) {
                            if (cl >= 24) continue;
#pragma unroll
                            for (int e = 0; e < 4; ++e) v[e] = sigm_f(v[e]);
                        }
                        u32x2 o = {pack2(v[0], v[1]), pack2(v[2], v[3])};
                        *(u32x2*)(dst + (zblk ? kbm(row, col0 + cl, NTOK) : (size_t)((long)row * ld + col0 + cl))) = o;
                    }
            }
        }
    }
};
struct EpiVT {
    bf16_t* dst; int ncols; int seq; int row0; int col0;
    template <int NJ> DI void operator()(f32x16 (&acc)[2][NJ], int wm, int wn, int r, int h) const {
#pragma unroll
        for (int i = 0; i < 2; ++i)
#pragma unroll
            for (int j = 0; j < NJ; ++j) {
                const int col = col0 + wn * (32 * NJ) + 32 * j + r;
#pragma unroll
                for (int c4 = 0; c4 < 4; ++c4) {
                    const int row = row0 + wm * 64 + 32 * i + 8 * c4 + 4 * h;
                    const int b = row / seq, s = row - b * seq;
                    u32x2 o = {pack2(acc[i][j][4 * c4], acc[i][j][4 * c4 + 1]), pack2(acc[i][j][4 * c4 + 2], acc[i][j][4 * c4 + 3])};
                    *(u32x2*)(dst + ((long)b * ncols + col) * seq + s) = o;
                }
            }
    }
};
struct EpiY {
    bf16_t* dst; int row0; int col0;
    template <int NJ> DI void operator()(f32x16 (&acc)[2][NJ], int wm, int wn, int r, int h) const {
#pragma unroll
        for (int i = 0; i < 2; ++i) {
            const int row = row0 + wm * 64 + 32 * i + r;
#pragma unroll
            for (int j = 0; j < NJ; ++j)
#pragma unroll
                for (int c4 = 0; c4 < 4; ++c4) {
                    u32x2 o = {pack2(acc[i][j][4 * c4], acc[i][j][4 * c4 + 1]), pack2(acc[i][j][4 * c4 + 2], acc[i][j][4 * c4 + 3])};
                    *(u32x2*)(dst + (long)row * DM + col0 + wn * (32 * NJ) + 32 * j + 8 * c4 + 4 * h) = o;
                }
        }
    }
};
constexpr int HSTR = 272;
struct EpiCmp {
    char* lds; const float* bias;
    DI void operator()(f32x16 (&acc)[2][2], int wm, int wn, int r, int h) const {
#pragma unroll
        for (int i = 0; i < 2; ++i) {
            const int row = wm * 64 + 32 * i + r;
#pragma unroll
            for (int j = 0; j < 2; ++j)
#pragma unroll
                for (int c4 = 0; c4 < 4; ++c4) {
                    const int cl = wn * 64 + 32 * j + 8 * c4 + 4 * h;
                    float v[4];
#pragma unroll
                    for (int e = 0; e < 4; ++e) v[e] = silu_f(acc[i][j][4 * c4 + e] + bias[cl + e]);
                    u32x2 o = {pack2(v[0], v[1]), pack2(v[2], v[3])};
                    *(u32x2*)(lds + row * HSTR + cl * 2) = o;
                }
        }
    }
};
struct EpiPart {
    float* dst;
    DI void operator()(f32x16 (&acc)[2][2], int wm, int wn, int r, int h) const {
#pragma unroll
        for (int i = 0; i < 2; ++i) {
            const int row = wm * 64 + 32 * i + r;
#pragma unroll
            for (int j = 0; j < 2; ++j)
#pragma unroll
                for (int c4 = 0; c4 < 4; ++c4) {
                    f32x4 o = {acc[i][j][4 * c4], acc[i][j][4 * c4 + 1], acc[i][j][4 * c4 + 2], acc[i][j][4 * c4 + 3]};
                    *(f32x4*)(dst + row * 128 + wn * 64 + 32 * j + 8 * c4 + 4 * h) = o;
                }
        }
    }
};
struct ARowCmp {
    int row0; int colbase;
    DI long operator()(int r) const {
        const int R = row0 + r, bg = R >> 8; int i = R & 255; if (i > 254) i = 254;
        const int b = bg >> 1, g = bg & 1;
        return ((long)(b * SEQ + 16 * i)) * NA + colbase + g * 64;
    }
};

enum { FM_NONE = 0, FM_MOBA = 1, FM_CMP = 2, FM_SLC = 3, FM_WIN = 4, FM_RET = 5 };
constexpr int VSTR = 144;

template <int DK, int DV>
struct TileRegs { u32x4 k[DK / 32]; u32x4 v[DV / 32]; };

template <int DK, int DV>
DI void tile_load(TileRegs<DK, DV>& t, const bf16_t* __restrict__ Kp, long kstride, const bf16_t* __restrict__ Vt, long vstride, int key0, bool loadv) {
    const int tid = my_tid();
#pragma unroll
    for (int j = 0; j < DK / 32; ++j) {
        const int c = tid + 256 * j, row = c / (DK / 8), kc = c % (DK / 8);
        t.k[j] = *(const u32x4*)(Kp + (long)(key0 + row) * kstride + kc * 8);
    }
    if (loadv) {
#pragma unroll
        for (int j = 0; j < DV / 32; ++j) {
            const int c = tid + 256 * j, row = c >> 3, kc = c & 7;
            t.v[j] = *(const u32x4*)(Vt + (long)row * vstride + key0 + kc * 8);
        }
    }
}
template <int DK, int DV>
DI void tile_store(const TileRegs<DK, DV>& t, char* buf, bool storev) {
    constexpr int KSTR = (DK + 8) * 2;
    const int tid = my_tid();
#pragma unroll
    for (int j = 0; j < DK / 32; ++j) {
        const int c = tid + 256 * j, row = c / (DK / 8), kc = c % (DK / 8);
        *(u32x4*)(buf + row * KSTR + kc * 16) = t.k[j];
    }
    if (storev) {
#pragma unroll
        for (int j = 0; j < DV / 32; ++j) {
            const int c = tid + 256 * j, row = c >> 3, kc = c & 7;
            *(u32x4*)(buf + 64 * KSTR + row * VSTR + kc * 16) = t.v[j];
        }
    }
}

template <int MODE>
DI bool fpred(int key, int tq) {
    if (MODE == FM_NONE) return true;
    if (MODE == FM_CMP) return (16 * key + 31) <= tq;
    if (MODE == FM_WIN) return (key <= tq) && (key > tq - 512);
    return key <= tq;
}

DI void glds16(const void* g, unsigned lds_addr) {
    lds_addr = __builtin_amdgcn_readfirstlane(lds_addr);
    asm volatile("s_mov_b32 m0, %0\n\ts_nop 0\n\tglobal_load_lds_dwordx4 %1, off" ::"s"(lds_addr), "v"(g) : "memory", "m0");
}
template <int DK, int DV>
struct TileSrc { const bf16_t* k[DK / 32]; const bf16_t* v[DV / 32]; unsigned woff; };
template <int DK, int DV>
DI void tile_src_init(TileSrc<DK, DV>& ts, const bf16_t* __restrict__ Kp, long kstride, const bf16_t* __restrict__ Vt, long vstride) {
    constexpr int NK = DK / 8, NV = DV / 8;
    const int tid = my_tid(), lane = tid & 63, w = __builtin_amdgcn_readfirstlane(tid >> 6);
    ts.woff = (unsigned)w * 1024u;
#pragma unroll
    for (int i = 0; i < NK / 4; ++i) {
        const int g = w + 4 * i;
        int row, c;
        if (DK == 64) { row = 8 * g + (lane >> 3); c = (lane & 7) ^ ((row >> 1) & 7); }
        else { row = 4 * g + (lane >> 4); c = (lane & 15) ^ (row & 15); }
        ts.k[i] = Kp + (long)row * kstride + c * 8;
    }
#pragma unroll
    for (int i = 0; i < NV / 4; ++i) {
        const int g = w + 4 * i;
        const int row = 8 * g + (lane >> 3), c = (lane & 7) ^ ((row >> 1) & 7);
        ts.v[i] = Vt + (long)row * vstride + c * 8;
    }
}
template <int DK, int DV>
DI void tile_issue(char* stage, const TileSrc<DK, DV>& ts, long kstride, int key0) {
    constexpr int NK = DK / 8, NV = DV / 8;
    const unsigned sbase = (unsigned)(size_t)stage + ts.woff;
    const long koff = (long)key0 * kstride;
#pragma unroll
    for (int i = 0; i < NK / 4; ++i) glds16(ts.k[i] + koff, sbase + i * 4096);
#pragma unroll
    for (int i = 0; i < NV / 4; ++i) glds16(ts.v[i] + key0, sbase + NK * 1024 + i * 4096);
}
template <int N> DI void wait_vm() { asm volatile("s_waitcnt vmcnt(%0)" ::"n"(N) : "memory"); }

template <int DK, int DV, int MODE>
DI void flash(char* lds, const bf16x8 (&qf)[DK / 16], const bf16_t* __restrict__ Kp, long kstride, const bf16_t* __restrict__ Vt, long vstride,
              u64 tiles, u64 wtiles, int tq, u64 aux, float sc, float lg, f32x16 (&o)[DV / 32], float& m, float& l, int nst_cap = 4) {
    constexpr int NK = DK / 8, NV = DV / 8, NI = (NK + NV) / 4;
    constexpr int TB = (NK + NV) * 1024;
    constexpr int NSTMAX = (LDS_BYTES / TB) > 4 ? 4 : (LDS_BYTES / TB);
    const int NST = NSTMAX < nst_cap ? NSTMAX : nst_cap;
    const int lane = my_tid() & 63, r = lane & 31, h = lane >> 5;
    tiles = ((u64)(unsigned)__builtin_amdgcn_readfirstlane((unsigned)(tiles >> 32)) << 32) | (unsigned)__builtin_amdgcn_readfirstlane((unsigned)tiles);
    wtiles = ((u64)(unsigned)__builtin_amdgcn_readfirstlane((unsigned)(wtiles >> 32)) << 32) | (unsigned)__builtin_amdgcn_readfirstlane((unsigned)wtiles);
    u64 rem_i = tiles, rem_c = tiles;
    const int n = __builtin_popcountll(tiles);
    if (n == 0) return;
    TileSrc<DK, DV> ts;
    tile_src_init<DK, DV>(ts, Kp, kstride, Vt, vstride);
    int issued = 0, slot_i = 0, slot_c = 0;
#pragma unroll 1
    for (int a = 0; a < NST - 1; ++a) {
        if (rem_i) {
            const int t = __builtin_ctzll(rem_i); rem_i &= rem_i - 1;
            tile_issue<DK, DV>(lds + slot_i * TB, ts, kstride, t * 64);
            ++issued; slot_i = (slot_i + 1 == NST) ? 0 : slot_i + 1;
        }
    }
#pragma unroll 1
    for (int j = 0; j < n; ++j) {
        const int cur = __builtin_ctzll(rem_c); rem_c &= rem_c - 1;
        const int ahead = issued - 1 - j;
        if (ahead >= 2) wait_vm<2 * NI>(); else if (ahead == 1) wait_vm<NI>(); else wait_vm<0>();
        RAW_BARRIER();
        if (rem_i) {
            const int t = __builtin_ctzll(rem_i); rem_i &= rem_i - 1;
            tile_issue<DK, DV>(lds + slot_i * TB, ts, kstride, t * 64);
            ++issued; slot_i = (slot_i + 1 == NST) ? 0 : slot_i + 1;
        }
        const char* Ks = lds + slot_c * TB;
        const char* Vs = Ks + NK * 1024;
        slot_c = (slot_c + 1 == NST) ? 0 : slot_c + 1;
        if ((wtiles >> cur) & 1ull) {
            const int q0w = __builtin_amdgcn_readfirstlane(tq);
            const int kt0 = cur * 64;
            bool need_mask = false;
            if (MODE == FM_MOBA || MODE == FM_SLC || MODE == FM_RET) need_mask = (kt0 + 63 > q0w);
            if (MODE == FM_CMP) need_mask = (16 * (kt0 + 63) + 31 > q0w);
            if (MODE == FM_WIN) need_mask = (kt0 + 63 > q0w) || (kt0 <= q0w + 31 - 512);
            bool lane_on = true;
            if (MODE == FM_MOBA) lane_on = (((unsigned)aux >> (cur >> 2)) & 1u) != 0u;
            if (MODE == FM_SLC) lane_on = ((aux >> cur) & 1ull) != 0ull;
            f32x16 s[2];
            if (DK == 64) {
                bf16x8 kf[2][DK / 16];
#pragma unroll
                for (int t = 0; t < 2; ++t)
#pragma unroll
                    for (int kk = 0; kk < DK / 16; ++kk) {
                        const int krow = 32 * t + r;
                        kf[t][kk] = *(const bf16x8*)(Ks + krow * (DK * 2) + (((2 * kk + h) ^ ((krow >> 1) & 7)) * 16));
                    }
                __builtin_amdgcn_sched_barrier(0);
#pragma unroll
                for (int t = 0; t < 2; ++t) {
                    s[t] = zero16();
#pragma unroll
                    for (int kk = 0; kk < DK / 16; ++kk) s[t] = MFMA(kf[t][kk], qf[kk], s[t]);
                }
            } else {
#pragma unroll
                for (int t = 0; t < 2; ++t) {
                    bf16x8 kf[DK / 16];
#pragma unroll
                    for (int kk = 0; kk < DK / 16; ++kk) {
                        const int krow = 32 * t + r;
                        kf[kk] = *(const bf16x8*)(Ks + krow * (DK * 2) + (((2 * kk + h) ^ (krow & 15)) * 16));
                    }
                    s[t] = zero16();
#pragma unroll
                    for (int kk = 0; kk < DK / 16; ++kk) s[t] = MFMA(kf[kk], qf[kk], s[t]);
                    __builtin_amdgcn_sched_barrier(0);
                }
            }
            u32x4 vf0[2][DV / 32];
#pragma unroll
            for (int ss = 0; ss < 2; ++ss)
#pragma unroll
                for (int d = 0; d < DV / 32; ++d) {
                    const int vrow = 32 * d + r, vkey = (vrow >> 1) & 7, c0 = 2 * ss;
                    const u32x2 lo = *(const u32x2*)(Vs + vrow * 128 + ((c0 ^ vkey) * 16) + 8 * h);
                    const u32x2 hi = *(const u32x2*)(Vs + vrow * 128 + (((c0 + 1) ^ vkey) * 16) + 8 * h);
                    vf0[ss][d] = (u32x4){lo.x, lo.y, hi.x, hi.y};
                }
            __builtin_amdgcn_sched_barrier(0);
            if (MODE != FM_RET) {
                if (need_mask) {
#pragma unroll
                    for (int t = 0; t < 2; ++t)
#pragma unroll
                        for (int i = 0; i < 16; ++i)
                            if (!fpred<MODE>(kt0 + 32 * t + crow(i, h), tq)) s[t][i] = -INFINITY;
                }
                float mx0 = mx2(mx2(mx2(s[0][0], s[0][1]), mx2(s[0][2], s[0][3])), mx2(mx2(s[0][4], s[0][5]), mx2(s[0][6], s[0][7])));
                float mx1 = mx2(mx2(mx2(s[0][8], s[0][9]), mx2(s[0][10], s[0][11])), mx2(mx2(s[0][12], s[0][13]), mx2(s[0][14], s[0][15])));
                float mx2_ = mx2(mx2(mx2(s[1][0], s[1][1]), mx2(s[1][2], s[1][3])), mx2(mx2(s[1][4], s[1][5]), mx2(s[1][6], s[1][7])));
                float mx3 = mx2(mx2(mx2(s[1][8], s[1][9]), mx2(s[1][10], s[1][11])), mx2(mx2(s[1][12], s[1][13]), mx2(s[1][14], s[1][15])));
                float mx = mx2(mx2(mx0, mx1), mx2(mx2_, mx3));
                if (MODE == FM_MOBA || MODE == FM_SLC) mx = lane_on ? mx : -INFINITY;
                mx = fmaxf(mx, shx(mx, 32));
                const float mxs = mx * sc;
                if (__any(mxs > m + 8.f)) {
                    const float mn = fmaxf(m, mxs);
                    const float alpha = ex2(m - mn);
                    m = mn;
                    l *= alpha;
#pragma unroll
                    for (int d = 0; d < DV / 32; ++d)
#pragma unroll
                        for (int i = 0; i < 16; ++i) o[d][i] *= alpha;
                }
                float negm = -m;
                if (MODE == FM_MOBA || MODE == FM_SLC) negm = lane_on ? negm : -1e30f;
                float ps0 = 0.f, ps1 = 0.f;
#pragma unroll
                for (int t = 0; t < 2; ++t)
#pragma unroll
                    for (int i = 0; i < 16; i += 2) {
                        const float p0 = ex2(__builtin_fmaf(s[t][i], sc, negm));
                        const float p1 = ex2(__builtin_fmaf(s[t][i + 1], sc, negm));
                        s[t][i] = p0; s[t][i + 1] = p1;
                        ps0 += p0; ps1 += p1;
                    }
                l += ps0 + ps1;
            } else {
                const float g1 = sc, g2 = g1 * g1, g3 = g2 * g1, g4 = g2 * g2, g8 = g4 * g4;
#pragma unroll
                for (int t = 0; t < 2; ++t) {
                    float Ac = ex2(lg * (float)(tq - (kt0 + 32 * t) - 4 * h));
#pragma unroll
                    for (int c = 0; c < 4; ++c) {
                        s[t][4 * c] *= Ac; s[t][4 * c + 1] *= Ac * g1; s[t][4 * c + 2] *= Ac * g2; s[t][4 * c + 3] *= Ac * g3;
                        Ac *= g8;
                    }
                }
                if (need_mask) {
#pragma unroll
                    for (int t = 0; t < 2; ++t)
#pragma unroll
                        for (int i = 0; i < 16; ++i)
                            if (kt0 + 32 * t + crow(i, h) > tq) s[t][i] = 0.f;
                }
            }
            __builtin_amdgcn_sched_barrier(0);
            u32x4 vf1[2][DV / 32];
#pragma unroll
            for (int ss = 0; ss < 2; ++ss)
#pragma unroll
                for (int d = 0; d < DV / 32; ++d) {
                    const int vrow = 32 * d + r, vkey = (vrow >> 1) & 7, c0 = 4 + 2 * ss;
                    const u32x2 lo = *(const u32x2*)(Vs + vrow * 128 + ((c0 ^ vkey) * 16) + 8 * h);
                    const u32x2 hi = *(const u32x2*)(Vs + vrow * 128 + (((c0 + 1) ^ vkey) * 16) + 8 * h);
                    vf1[ss][d] = (u32x4){lo.x, lo.y, hi.x, hi.y};
                }
#pragma unroll
            for (int ss = 0; ss < 2; ++ss) {
                u32x4 pk = {pack2(s[0][8 * ss], s[0][8 * ss + 1]), pack2(s[0][8 * ss + 2], s[0][8 * ss + 3]),
                            pack2(s[0][8 * ss + 4], s[0][8 * ss + 5]), pack2(s[0][8 * ss + 6], s[0][8 * ss + 7])};
                const bf16x8 pf = __builtin_bit_cast(bf16x8, pk);
#pragma unroll
                for (int d = 0; d < DV / 32; ++d) o[d] = MFMA(__builtin_bit_cast(bf16x8, vf0[ss][d]), pf, o[d]);
            }
#pragma unroll
            for (int ss = 0; ss < 2; ++ss) {
                u32x4 pk = {pack2(s[1][8 * ss], s[1][8 * ss + 1]), pack2(s[1][8 * ss + 2], s[1][8 * ss + 3]),
                            pack2(s[1][8 * ss + 4], s[1][8 * ss + 5]), pack2(s[1][8 * ss + 6], s[1][8 * ss + 7])};
                const bf16x8 pf = __builtin_bit_cast(bf16x8, pk);
#pragma unroll
                for (int d = 0; d < DV / 32; ++d) o[d] = MFMA(__builtin_bit_cast(bf16x8, vf1[ss][d]), pf, o[d]);
            }
        }
    }
    RAW_BARRIER();
}

template <int DK>
DI void load_q(bf16x8 (&qf)[DK / 16], const bf16_t* qrow, int h) {
#pragma unroll
    for (int kk = 0; kk < DK / 16; ++kk) qf[kk] = *(const bf16x8*)(qrow + 16 * kk + 8 * h);
}

template <int DV>
DI void write_gated(const f32x16 (&o)[DV / 32], float scale, bf16_t* zbase, size_t row, int col0, int h, bool wr = true) {
    if (!wr) {
        float chk = 0.f;
#pragma unroll
        for (int d = 0; d < DV / 32; ++d)
#pragma unroll
            for (int i = 0; i < 16; ++i) chk += o[d][i];
        if (chk * scale == 1.2345e-30f) zbase[0] = 0;
        return;
    }
#pragma unroll
    for (int d = 0; d < DV / 32; ++d)
#pragma unroll
        for (int c4 = 0; c4 < 4; ++c4) {
            bf16_t* zp = zbase + kbm((int)row, col0 + 32 * d + 8 * c4 + 4 * h, NTOK);
            const u32x2 z = *(const u32x2*)zp;
            u32x2 ov = {pack2(o[d][4 * c4] * scale * bflo(z.x), o[d][4 * c4 + 1] * scale * bfhi(z.x)),
                        pack2(o[d][4 * c4 + 2] * scale * bflo(z.y), o[d][4 * c4 + 3] * scale * bfhi(z.y))};
            *(u32x2*)zp = ov;
        }
}

DI u64 range_bits(int lo, int hi) {
    const u64 a = (hi >= 63) ? ~0ull : ((2ull << hi) - 1ull);
    return a & ~((1ull << lo) - 1ull);
}

constexpr int KM_OFF = 65536, MISC_OFF = 69888;
DI void moba_item(const Params& p, char* lds, int b, int hh, int qt, bool wr = true) {
    const int tid = my_tid(), lane = tid & 63, w = tid >> 6, r = lane & 31, h = lane >> 5;
    const bf16_t* bufA = (const bf16_t*)(p.ws + OFF_BUFA);
    const bf16_t* vT = (const bf16_t*)(p.ws + OFF_VT);
    bf16_t* bufZ = (bf16_t*)(p.ws + OFF_BUFZ);
    const float* kmean = (const float*)(p.ws + OFF_KMEAN);
    const int q0w = qt * 128 + w * 32, tq = q0w + r, own = qt >> 1;
    *(f32x4*)(lds + KM_OFF + tid * 16) = *(const f32x4*)(kmean + (size_t)(b * 8 + hh) * 1024 + tid * 4);
    const bf16_t* qrow = bufA + (size_t)(b * SEQ + tq) * NA + CA_MQ + hh * 64;
    bf16x8 qf[4];
    load_q<64>(qf, qrow, h);
    __syncthreads();
    float gh[8];
#pragma unroll
    for (int mI = 0; mI < 8; ++mI) gh[mI] = 0.f;
#pragma unroll
    for (int c = 0; c < 8; ++c) {
        const u32x4 qv = *(const u32x4*)(qrow + 8 * c);
        const float q0 = bflo(qv.x), q1 = bfhi(qv.x), q2 = bflo(qv.y), q3 = bfhi(qv.y), q4 = bflo(qv.z), q5 = bfhi(qv.z), q6 = bflo(qv.w), q7 = bfhi(qv.w);
#pragma unroll
        for (int mI = 0; mI < 8; ++mI) {
            if (2 * mI < own) {
                const float* km = (const float*)(lds + KM_OFF) + (2 * mI + h) * 64 + c * 8;
                const f32x4 k0 = *(const f32x4*)km, k1 = *(const f32x4*)(km + 4);
                gh[mI] += q0 * k0.x + q1 * k0.y + q2 * k0.z + q3 * k0.w + q4 * k1.x + q5 * k1.y + q6 * k1.z + q7 * k1.w;
            }
        }
    }
    float g[16];
#pragma unroll
    for (int mI = 0; mI < 8; ++mI) {
        const float other = shx(gh[mI], 32);
        g[2 * mI] = h ? other : gh[mI];
        g[2 * mI + 1] = h ? gh[mI] : other;
    }
    unsigned bm = 0;
#pragma unroll
    for (int pass = 0; pass < 3; ++pass) {
        float best = -INFINITY; int bi = -1;
#pragma unroll
        for (int n = 0; n < 15; ++n)
            if (n < own && !((bm >> n) & 1u) && g[n] > best) { best = g[n]; bi = n; }
        if (bi >= 0) bm |= 1u << bi;
    }
    bm |= 1u << own;
    unsigned um = bm;
    um |= __shfl_xor(um, 16, 64); um |= __shfl_xor(um, 8, 64); um |= __shfl_xor(um, 4, 64); um |= __shfl_xor(um, 2, 64); um |= __shfl_xor(um, 1, 64);
    um = __builtin_amdgcn_readfirstlane(um);
    u64 wt = 0;
#pragma unroll
    for (int n = 0; n < 16; ++n) if ((um >> n) & 1u) wt |= 0xFull << (4 * n);
    wt &= range_bits(0, (q0w + 31) >> 6);
    if (lane == 0) *(u64*)(lds + MISC_OFF + 8 * w) = wt;
    __syncthreads();
    const u64 tiles = *(const u64*)(lds + MISC_OFF) | *(const u64*)(lds + MISC_OFF + 8) | *(const u64*)(lds + MISC_OFF + 16) | *(const u64*)(lds + MISC_OFF + 24);
    f32x16 o[2]; o[0] = zero16(); o[1] = zero16();
    float m = -1e30f, l = 0.f;
    flash<64, 64, FM_MOBA>(lds, qf, bufA + (size_t)b * SEQ * NA + CA_MK + hh * 64, NA, vT + ((size_t)b * NVT + CV_MV + hh * 64) * SEQ, SEQ,
                           tiles, wt, tq, (u64)bm, 0.125f * LOG2E, 0.f, o, m, l);
    l += shx(l, 32);
    const float inv = l > 0.f ? 1.f / l : 0.f;
    write_gated<64>(o, inv, bufZ, (size_t)(b * SEQ + tq), 0 + hh * 64, h, wr);
}

constexpr int PART_OFF = 36864, SELM_OFF = 69632;
DI void nsa_item(const Params& p, char* lds, int b, int g, int qt32, bool wr = true) {
    const int tid = my_tid(), lane = tid & 63, w = tid >> 6, r = lane & 31, h = lane >> 5;
    const bf16_t* bufA = (const bf16_t*)(p.ws + OFF_BUFA);
    const bf16_t* vT = (const bf16_t*)(p.ws + OFF_VT);
    bf16_t* bufZ = (bf16_t*)(p.ws + OFF_BUFZ);
    const bf16_t* kc = (const bf16_t*)(p.ws + OFF_KC) + (size_t)(b * 2 + g) * 256 * 64;
    const bf16_t* vcT = (const bf16_t*)(p.ws + OFF_VCT) + (size_t)(b * 2 + g) * 64 * 256;
    const int q0 = qt32 * 32, tq = q0 + r, hq = g * 4 + w;
    const size_t tokrow = (size_t)(b * SEQ + tq);
    const bf16_t* qrow = bufA + tokrow * NA + CA_NQ + hq * 64;
    bf16x8 qf[4];
    load_q<64>(qf, qrow, h);
    const float sc = 0.125f * LOG2E;
    const bf16_t* gp = bufA + tokrow * NA + CA_GATE + hq * 3;
    const float g_cmp = bf2f(gp[0]), g_slc = bf2f(gp[1]), g_win = bf2f(gp[2]);
    f32x16 tot[2]; tot[0] = zero16(); tot[1] = zero16();
    const int ncmp_tiles = ((q0 >> 4) >> 6) + 1;
    const u64 ctiles = range_bits(0, ncmp_tiles - 1);
    float m = -1e30f, l = 0.f;
    {
        f32x16 o[2]; o[0] = zero16(); o[1] = zero16();
        flash<64, 64, FM_CMP>(lds, qf, kc, 64, vcT, 256, ctiles, ctiles, tq, 0ull, sc, 0.f, o, m, l);
        l += shx(l, 32);
        const float inv = l > 0.f ? 1.f / l : 0.f;
        l = inv;
#pragma unroll
        for (int d = 0; d < 2; ++d)
#pragma unroll
            for (int i = 0; i < 16; ++i) tot[d][i] = o[d][i] * (inv * g_cmp);
    }
#ifndef REP_IMP
#define REP_IMP 1
#endif
    for (int rimp = 0; rimp < REP_IMP; ++rimp) {
        float* part = (float*)(lds + w * 16384 + 8192) + r * 64;
#pragma unroll
        for (int j = 0; j < 32; ++j) part[2 * j + h] = 0.f;
        float prev = 0.f;
#pragma unroll 1
        for (int t4 = 0; t4 < ncmp_tiles; ++t4) {
#pragma unroll
            for (int t = 0; t < 2; ++t) {
                f32x16 s = zero16();
#pragma unroll
                for (int kk = 0; kk < 4; ++kk) {
                    const int krow = 32 * t + r;
                    const bf16x8 kf = *(const bf16x8*)(lds + t4 * 16384 + krow * 128 + (((2 * kk + h) ^ ((krow >> 1) & 7)) * 16));
                    s = MFMA(kf, qf[kk], s);
                }
                const int T = 2 * t4 + t;
#pragma unroll
                for (int c = 0; c < 4; ++c) {
                    float pv[4];
#pragma unroll
                    for (int e = 0; e < 4; ++e) {
                        const int key = 32 * T + 8 * c + 4 * h + e;
                        pv[e] = ((16 * key + 31) <= tq) ? ex2(s[4 * c + e] * sc - m) * l : 0.f;
                    }
                    const float A = 2.f * (pv[0] + pv[1] + pv[2]) + pv[3];
                    const float xch = shx(pv[3], 32);
                    const float add = h ? xch : prev;
                    prev = xch;
                    part[8 * T + 2 * c + h] = A + add;
                }
            }
        }
        __syncthreads();
        const float* pbase = (const float*)(lds + 8192);
#ifndef REP_TOPK
#define REP_TOPK 1
#endif
#pragma unroll 1
        for (int rtk = 0; rtk < REP_TOPK; ++rtk)
#pragma unroll 1
        for (int qq = 8 * w; qq < 8 * w + 8; ++qq) {
            float v = pbase[qq * 64 + lane] + pbase[4096 + qq * 64 + lane] + pbase[2 * 4096 + qq * 64 + lane] + pbase[3 * 4096 + qq * 64 + lane];
            const int own = (q0 + qq) >> 6;
            if (lane == 0 || lane == own || lane == own - 1) v = INFINITY;
            if (lane > own) v = -INFINITY;
            const unsigned key = (v > 0.f) ? __float_as_uint(v) : 0u;
            unsigned T = 0u;
#pragma unroll
            for (int bit = 30; bit >= 0; --bit) {
                const unsigned cand = T | (1u << bit);
                const int cnt = __builtin_popcountll(__ballot(key >= cand));
                T = (cnt >= 16) ? cand : T;
            }
            u64 selm = __ballot(key > T), E = __ballot(key == T);
            int need = 16 - __builtin_popcountll(selm);
            while (need > 0 && E != 0ull) { const u64 low = E & (0ull - E); selm |= low; E ^= low; --need; }
            if (lane == 0) *(u64*)(lds + SELM_OFF + qq * 8) = selm;
        }
        __syncthreads();
    }
    const u64 sel = *(const u64*)(lds + SELM_OFF + r * 8);
    {
        unsigned ulo = (unsigned)sel, uhi = (unsigned)(sel >> 32);
#pragma unroll
        for (int off = 16; off >= 1; off >>= 1) { ulo |= __shfl_xor(ulo, off, 64); uhi |= __shfl_xor(uhi, off, 64); }
        ulo = __builtin_amdgcn_readfirstlane(ulo); uhi = __builtin_amdgcn_readfirstlane(uhi);
        const u64 stiles = (((u64)uhi << 32) | ulo) & range_bits(0, (q0 + 31) >> 6);
        f32x16 o[2]; o[0] = zero16(); o[1] = zero16();
        float m2 = -1e30f, l2 = 0.f;
        flash<64, 64, FM_SLC>(lds, qf, bufA + (size_t)b * SEQ * NA + CA_NKS + g * 64, NA, vT + ((size_t)b * NVT + CV_NVS + g * 64) * SEQ, SEQ,
                              stiles, stiles, tq, sel, sc, 0.f, o, m2, l2);
        l2 += shx(l2, 32);
        const float inv = l2 > 0.f ? 1.f / l2 : 0.f;
#pragma unroll
        for (int d = 0; d < 2; ++d)
#pragma unroll
            for (int i = 0; i < 16; ++i) tot[d][i] += o[d][i] * (inv * g_slc);
    }
    {
        const int lo = (q0 >= 511 ? (q0 - 511) : 0) >> 6;
        const u64 wtl = range_bits(lo, (q0 + 31) >> 6);
        f32x16 o[2]; o[0] = zero16(); o[1] = zero16();
        float m3 = -1e30f, l3 = 0.f;
        flash<64, 64, FM_WIN>(lds, qf, bufA + (size_t)b * SEQ * NA + CA_NKW + g * 64, NA, vT + ((size_t)b * NVT + CV_NVW + g * 64) * SEQ, SEQ,
                              wtl, wtl, tq, 0ull, sc, 0.f, o, m3, l3);
        l3 += shx(l3, 32);
        const float inv = l3 > 0.f ? 1.f / l3 : 0.f;
#pragma unroll
        for (int d = 0; d < 2; ++d)
#pragma unroll
            for (int i = 0; i < 16; ++i) tot[d][i] += o[d][i] * (inv * g_win);
    }
    write_gated<64>(tot, 1.f, bufZ, tokrow, 512 + hq * 64, h, wr);
}

DI void ret_item(const Params& p, char* lds, int layer, int b, int hh, int qt, bool wr = true) {
    const int tid = my_tid(), lane = tid & 63, w = tid >> 6, r = lane & 31, h = lane >> 5;
    const bf16_t* bufA = (const bf16_t*)(p.ws + OFF_BUFA);
    const bf16_t* vT = (const bf16_t*)(p.ws + OFF_VT);
    bf16_t* bufZ = (bf16_t*)(p.ws + OFF_BUFZ);
    const int q0b = qt * 128, q0w = q0b + w * 32, tq = q0w + r;
    const size_t tokrow = (size_t)(b * SEQ + tq);
    bf16x8 qf[4];
    load_q<64>(qf, bufA + tokrow * NA + CA_RQ + hh * 64, h);
    const float lg = ret_lg(hh);
    const int c = qt;
    constexpr int ST_OFF = 49152;
    {
        const int nch = (hh == 0) ? 5 : (hh == 1 ? 9 : (hh == 2 ? 17 : 31));
        const int nprev = c < nch ? c : nch;
        const int dv = tid >> 1, d0 = (tid & 1) * 32;
        const bf16_t* up = (const bf16_t*)(p.ws + OFF_U) + ((size_t)(b * 4 + hh) * 32) * 8192 + tid * 32;
        const float dec = ex2(lg * 128.f);
        f32x4 a[8];
#pragma unroll
        for (int q = 0; q < 8; ++q) a[q] = (f32x4){0.f, 0.f, 0.f, 0.f};
        float f = 1.f;
#pragma unroll 1
        for (int k = 0; k < nprev; k += 4) {
            u32x4 raw[4][4];
#pragma unroll
            for (int kk = 0; kk < 4; ++kk) {
                const int cp = (k + kk < nprev) ? (c - 1 - k - kk) : 0;
                const bf16_t* src = up + (size_t)cp * 8192;
#pragma unroll
                for (int q = 0; q < 4; ++q) raw[kk][q] = *(const u32x4*)(src + 8 * q);
            }
#pragma unroll
            for (int kk = 0; kk < 4; ++kk) {
                const float fw = (k + kk < nprev) ? f : 0.f;
#pragma unroll
                for (int q = 0; q < 4; ++q) {
                    const u32x4 rv = raw[kk][q];
                    a[2 * q] += (f32x4){bflo(rv.x), bfhi(rv.x), bflo(rv.y), bfhi(rv.y)} * fw;
                    a[2 * q + 1] += (f32x4){bflo(rv.z), bfhi(rv.z), bflo(rv.w), bfhi(rv.w)} * fw;
                }
                f *= dec;
            }
        }
#pragma unroll
        for (int q = 0; q < 4; ++q) {
            u32x4 pk = {pack2(a[2 * q].x, a[2 * q].y), pack2(a[2 * q].z, a[2 * q].w), pack2(a[2 * q + 1].x, a[2 * q + 1].y), pack2(a[2 * q + 1].z, a[2 * q + 1].w)};
            const int cidx = (d0 >> 3) + q;
            *(u32x4*)(lds + ST_OFF + dv * 128 + ((cidx ^ ((dv >> 1) & 7)) * 16)) = pk;
        }
    }
    __syncthreads();
    f32x16 o[4];
#pragma unroll
    for (int d = 0; d < 4; ++d) o[d] = zero16();
    if (c > 0) {
        const float cross = ex2(lg * (float)((tq & 127) + 1));
        const bf16_t* qrow = bufA + tokrow * NA + CA_RQ + hh * 64;
#pragma unroll
        for (int t = 0; t < 2; ++t)
#pragma unroll
            for (int ss = 0; ss < 2; ++ss) {
                const int dq = 32 * t + 16 * ss + 4 * h;
                const u32x2 qa = *(const u32x2*)(qrow + dq), qb = *(const u32x2*)(qrow + dq + 8);
                u32x4 pk = {pack2(bflo(qa.x) * cross, bfhi(qa.x) * cross), pack2(bflo(qa.y) * cross, bfhi(qa.y) * cross),
                            pack2(bflo(qb.x) * cross, bfhi(qb.x) * cross), pack2(bflo(qb.y) * cross, bfhi(qb.y) * cross)};
                const bf16x8 pf = __builtin_bit_cast(bf16x8, pk);
#pragma unroll
                for (int d = 0; d < 4; ++d) {
                    const int vrow = 32 * d + r, vkey = (vrow >> 1) & 7, c0 = 4 * t + 2 * ss;
                    const u32x2 lo2 = *(const u32x2*)(lds + ST_OFF + vrow * 128 + ((c0 ^ vkey) * 16) + 8 * h);
                    const u32x2 hi2 = *(const u32x2*)(lds + ST_OFF + vrow * 128 + (((c0 + 1) ^ vkey) * 16) + 8 * h);
                    u32x4 vv = {lo2.x, lo2.y, hi2.x, hi2.y};
                    o[d] = MFMA(__builtin_bit_cast(bf16x8, vv), pf, o[d]);
                }
            }
    }
    const u64 tiles = range_bits(2 * c, 2 * c + 1);
    const u64 wt = range_bits(2 * c, (q0w + 31) >> 6);
    float m = 0.f, l = 0.f;
    flash<64, 128, FM_RET>(lds, qf, bufA + (size_t)b * SEQ * NA + CA_RK + hh * 64, NA, vT + ((size_t)b * NVT + CV_RV + hh * 128) * SEQ, SEQ,
                           tiles, wt, tq, 0ull, ex2(-lg), lg, o, m, l, 2);
    float sm = 0.f;
#pragma unroll
    for (int d = 0; d < 4; ++d)
#pragma unroll
        for (int i = 0; i < 16; ++i) sm += o[d][i];
    sm += shx(sm, 32);
    const float mu = sm * (1.f / 128.f);
    float sq = 0.f;
#pragma unroll
    for (int d = 0; d < 4; ++d)
#pragma unroll
        for (int i = 0; i < 16; ++i) { const float c = o[d][i] - mu; o[d][i] = c; sq += c * c; }
    sq += shx(sq, 32);
    const float rs = rsqrtf(sq * (1.f / 128.f) + EPS);
    const float* gn = p.gn_g + layer * 512 + hh * 128;
#pragma unroll
    for (int d = 0; d < 4; ++d)
#pragma unroll
        for (int c4 = 0; c4 < 4; ++c4) {
            const f32x4 gv = *(const f32x4*)(gn + 32 * d + 8 * c4 + 4 * h);
            o[d][4 * c4] *= gv.x; o[d][4 * c4 + 1] *= gv.y; o[d][4 * c4 + 2] *= gv.z; o[d][4 * c4 + 3] *= gv.w;
        }
    write_gated<128>(o, rs, bufZ, tokrow, 1024 + hh * 128, h, wr);
}

DI void mem_item(const Params& p, char* lds, int b, int hh, int qt, bool wr = true) {
    const int tid = my_tid(), lane = tid & 63, w = tid >> 6, r = lane & 31, h = lane >> 5;
    const bf16_t* bufA = (const bf16_t*)(p.ws + OFF_BUFA);
    bf16_t* bufZ = (bf16_t*)(p.ws + OFF_BUFZ);
    const bf16_t* memK = (const bf16_t*)(p.ws + OFF_MEMK);
    const bf16_t* memVT = (const bf16_t*)(p.ws + OFF_MEMV);
    const int tq = qt * 128 + w * 32 + r;
    const size_t tokrow = (size_t)(b * SEQ + tq);
    bf16x8 qf[8];
    load_q<128>(qf, bufA + tokrow * NA + CA_CQ + hh * 128, h);
    f32x16 o[4];
#pragma unroll
    for (int d = 0; d < 4; ++d) o[d] = zero16();
    float m = -1e30f, l = 0.f;
    flash<128, 128, FM_NONE>(lds, qf, memK + (size_t)b * 256 * 512 + hh * 128, 512, memVT + ((size_t)b * 512 + hh * 128) * 256, 256,
                             0xFull, 0xFull, tq, 0ull, 0.08838834764831845f * LOG2E, 0.f, o, m, l);
    l += shx(l, 32);
    const float inv = l > 0.f ? 1.f / l : 0.f;
    write_gated<128>(o, inv, bufZ, tokrow, 1536 + hh * 128, h, wr);
}

DI void conv_w(const float* __restrict__ W, int ldw, bf16_t* __restrict__ WT, int K, int Ndst, bool mapped, long gtid, long gthreads, bool blocked = false) {
    const long total = (long)Ndst * (K / 8);
    for (long idx = gtid; idx < total; idx += gthreads) {
        const int n = (int)(idx % Ndst), kc = (int)(idx / Ndst);
        const int src = mapped ? in_col_src(n) : n;
        u32x4 o = {0u, 0u, 0u, 0u};
        if (src >= 0) {
            float v[8];
#pragma unroll
            for (int j = 0; j < 8; ++j) v[j] = W[(size_t)(kc * 8 + j) * ldw + src];
            o.x = pack2(v[0], v[1]); o.y = pack2(v[2], v[3]); o.z = pack2(v[4], v[5]); o.w = pack2(v[6], v[7]);
        }
        *(u32x4*)(WT + (blocked ? kbm(n, kc * 8, Ndst) : (size_t)n * K + kc * 8)) = o;
    }
}
DI void conv_layer_weights(const Params& p, int layer, long gtid, long gthreads) {
    conv_w(p.w_in + (size_t)layer * 1024 * 6424, 6424, (bf16_t*)(p.ws + OFF_WIN), 1024, NIN, true, gtid, gthreads, true);
    conv_w(p.w_out + (size_t)layer * 2048 * 1024, 1024, (bf16_t*)(p.ws + OFF_WOUT), 2048, 1024, false, gtid, gthreads, true);
    conv_w(p.w_mem + (size_t)layer * 1024 * 1024, 1024, (bf16_t*)(p.ws + OFF_WMEM), 1024, 1024, false, gtid, gthreads);
    conv_w(p.w1_k + (size_t)layer * 2048 * 128, 128, (bf16_t*)(p.ws + OFF_W1K), 2048, 128, false, gtid, gthreads);
    conv_w(p.w1_v + (size_t)layer * 2048 * 128, 128, (bf16_t*)(p.ws + OFF_W1V), 2048, 128, false, gtid, gthreads);
}
DI void cmp_bias(const Params& p, int layer, char* lds) {
    const int bb = blockIdx.x;
    if (bb >= 32) return;
    const int which = bb >> 4, pt = bb & 15;
    const float* pe = (which ? p.pe_v : p.pe_k) + (size_t)layer * 2048;
    const float* w1 = (which ? p.w1_v : p.w1_k) + (size_t)layer * 2048 * 128;
    float* part = (float*)(p.ws + OFF_BIAS) + (which * 16 + pt) * 128;
    const int tid = my_tid(), j = tid & 127, half = tid >> 7;
    float s0 = 0.f, s1 = 0.f, s2 = 0.f, s3 = 0.f;
    const int kb = pt * 128 + half * 64;
#pragma unroll 4
    for (int k = kb; k < kb + 64; k += 4) {
        s0 += pe[k] * w1[(size_t)k * 128 + j];
        s1 += pe[k + 1] * w1[(size_t)(k + 1) * 128 + j];
        s2 += pe[k + 2] * w1[(size_t)(k + 2) * 128 + j];
        s3 += pe[k + 3] * w1[(size_t)(k + 3) * 128 + j];
    }
    float* red = (float*)lds;
    red[tid] = (s0 + s1) + (s2 + s3);
    __syncthreads();
    if (tid < 128) part[tid] = red[tid] + red[tid + 128];
    __syncthreads();
}
DI void rms_rows(const float* __restrict__ X, const float* __restrict__ g, bf16_t* __restrict__ H, int nrows, bool blocked) {
    const int lane = my_tid() & 63, w = my_tid() >> 6;
    for (int row = blockIdx.x * 4 + w; row < nrows; row += gridDim.x * 4) {
        const float* xr = X + (size_t)row * DM;
        f32x4 v[4];
        float ss = 0.f;
#pragma unroll
        for (int j = 0; j < 4; ++j) { v[j] = *(const f32x4*)(xr + lane * 4 + 256 * j); ss += v[j].x * v[j].x + v[j].y * v[j].y + v[j].z * v[j].z + v[j].w * v[j].w; }
        ss = wave_sum(ss);
        const float rs = rsqrtf(ss * (1.f / DM) + EPS);
#pragma unroll
        for (int j = 0; j < 4; ++j) {
            const f32x4 gv = *(const f32x4*)(g + lane * 4 + 256 * j);
            u32x2 o = {pack2(v[j].x * rs * gv.x, v[j].y * rs * gv.y), pack2(v[j].z * rs * gv.z, v[j].w * rs * gv.w)};
            *(u32x2*)(H + (blocked ? kbm(row, lane * 4 + 256 * j, nrows) : (size_t)row * DM + lane * 4 + 256 * j)) = o;
        }
    }
}
DI void resid_rows(const float* __restrict__ Xold, const bf16_t* __restrict__ Y, const float* __restrict__ pg, float* __restrict__ Out,
                   const float* __restrict__ g_next, bf16_t* __restrict__ H) {
    const int lane = my_tid() & 63, w = my_tid() >> 6;
    for (int row = blockIdx.x * 4 + w; row < NTOK; row += gridDim.x * 4) {
        const bf16_t* yr = Y + (size_t)row * DM;
        const float* xr = Xold + (size_t)row * DM;
        f32x4 v[4], xv[4];
        float ss = 0.f;
#pragma unroll
        for (int j = 0; j < 4; ++j) { const u32x2 yy = *(const u32x2*)(yr + lane * 4 + 256 * j); v[j] = (f32x4){bflo(yy.x), bfhi(yy.x), bflo(yy.y), bfhi(yy.y)}; xv[j] = *(const f32x4*)(xr + lane * 4 + 256 * j); ss += v[j].x * v[j].x + v[j].y * v[j].y + v[j].z * v[j].z + v[j].w * v[j].w; }
        ss = wave_sum(ss);
        const float rs = rsqrtf(ss * (1.f / DM) + EPS);
        float s2 = 0.f;
#pragma unroll
        for (int j = 0; j < 4; ++j) {
            const f32x4 gv = *(const f32x4*)(pg + lane * 4 + 256 * j);
            xv[j].x += v[j].x * rs * gv.x; xv[j].y += v[j].y * rs * gv.y; xv[j].z += v[j].z * rs * gv.z; xv[j].w += v[j].w * rs * gv.w;
            *(f32x4*)(Out + (size_t)row * DM + lane * 4 + 256 * j) = xv[j];
            s2 += xv[j].x * xv[j].x + xv[j].y * xv[j].y + xv[j].z * xv[j].z + xv[j].w * xv[j].w;
        }
        if (g_next) {
            s2 = wave_sum(s2);
            const float r2 = rsqrtf(s2 * (1.f / DM) + EPS);
#pragma unroll
            for (int j = 0; j < 4; ++j) {
                const f32x4 gv = *(const f32x4*)(g_next + lane * 4 + 256 * j);
                u32x2 o = {pack2(xv[j].x * r2 * gv.x, xv[j].y * r2 * gv.y), pack2(xv[j].z * r2 * gv.z, xv[j].w * r2 * gv.w)};
                *(u32x2*)(H + kbm(row, lane * 4 + 256 * j, NTOK)) = o;
            }
        }
    }
}
DI void rope_table(const Params& p, long gtid, long gthreads) {
    f32x2* tab = (f32x2*)(p.ws + OFF_ROPE);
    for (long idx = gtid; idx < (long)SEQ * 32; idx += gthreads) {
        const int s = (int)(idx >> 5), i = (int)(idx & 31);
        const float invf = (float)(1.0 / pow(10000.0, (double)i / 31.0));
        const float ang = (float)s * invf;
        const double a = (double)ang;
        const double k = rint(a * 0.15915494309189535);
        const float rr = (float)(a - k * 6.283185307179586);
        f32x2 cs = {cosf(rr), sinf(rr)};
        tab[idx] = cs;
    }
}

#define XB_TMO      128
#define XB_XCNT(j)  (256  + 64 * (j))
#define XB_XSUB(j)  (1280 + 64 * (j))
#define XB_XGEN(j)  (2304 + 64 * (j))
#define XB_TOP      3328
#define XB_TOPGEN   3392
#define XCD_BAR_WORDS 3456
#define XB_SPIN_CAP (1u << 18)
#define LAS __attribute__((address_space(3)))
DI unsigned xb_ld(unsigned* p) { return __hip_atomic_load(p, __ATOMIC_RELAXED, __HIP_MEMORY_SCOPE_AGENT); }
DI unsigned xb_add(unsigned* p, unsigned v) { return __hip_atomic_fetch_add(p, v, __ATOMIC_RELAXED, __HIP_MEMORY_SCOPE_AGENT); }
DI unsigned xb_xcc_id() { return (unsigned)__builtin_amdgcn_s_getreg((3 << 11) | 20) & 0xFu; }
#define XB_SPIN(cond, bar) do { unsigned _sp = 0; while (cond) { __builtin_amdgcn_s_sleep(1); \
    if ((++_sp & 255u) == 0u) { if (xb_ld(&(bar)[XB_TMO])) break; if (_sp > XB_SPIN_CAP) { atomicAdd(&(bar)[XB_TMO], 1u); break; } } } } while (0)
struct XcdBarrier { unsigned* bar; unsigned x; volatile LAS unsigned* st; };
DI XcdBarrier xcd_barrier_post(unsigned* bar, volatile LAS unsigned* st) {
    XcdBarrier b; b.bar = bar; b.x = xb_xcc_id(); b.st = st;
    if (threadIdx.x == 0) (void)xb_add(&bar[XB_XCNT(b.x)], 1u);
    return b;
}
DI void xcd_barrier_complete(unsigned* bar, unsigned x, unsigned& nloc, unsigned& nx) {
    const unsigned G = gridDim.x * gridDim.y * gridDim.z;
    unsigned sum, cnt, mine, sp = 0u;
    for (;;) {
        sum = 0u; cnt = 0u; mine = 0u;
#pragma unroll
        for (unsigned j = 0; j < 16; ++j) { const unsigned c = xb_ld(&bar[XB_XCNT(j)]); sum += c; cnt += (c > 0u) ? 1u : 0u; mine = (j == x) ? c : mine; }
        if (sum == G) break;
        __builtin_amdgcn_s_sleep(1);
        if ((++sp & 255u) == 0u) { if (xb_ld(&bar[XB_TMO])) break; if (sp > XB_SPIN_CAP) { atomicAdd(&bar[XB_TMO], 1u); break; } }
    }
    nloc = mine > 0u ? mine : 1u; nx = cnt > 0u ? cnt : 1u;
}
DI void xcd_barrier(const XcdBarrier& b) {
    asm volatile("s_waitcnt vmcnt(0)" ::: "memory");
    __syncthreads();
    if (threadIdx.x == 0) {
        unsigned* bar = b.bar;
        __builtin_amdgcn_s_waitcnt(0);
        unsigned nloc = b.st[0], nx = b.st[1];
        if (nloc == 0u) { xcd_barrier_complete(bar, b.x, nloc, nx); b.st[0] = nloc; b.st[1] = nx; }
        const unsigned old = xb_add(&bar[XB_XSUB(b.x)], 1u);
        const unsigned gen = old / nloc;
        if (old + 1u == (gen + 1u) * nloc) {
            __builtin_amdgcn_fence(__ATOMIC_RELEASE, "agent");
            asm volatile("s_waitcnt vmcnt(0)" ::: "memory");
            const unsigned og = xb_add(&bar[XB_TOP], 1u);
            const unsigned tg = og / nx;
            if (og + 1u == (tg + 1u) * nx) xb_add(&bar[XB_TOPGEN], 1u);
            else XB_SPIN(xb_ld(&bar[XB_TOPGEN]) == tg, bar);
            __builtin_amdgcn_fence(__ATOMIC_ACQUIRE, "agent");
            xb_add(&bar[XB_XGEN(b.x)], 1u);
            asm volatile("s_waitcnt vmcnt(0)" ::: "memory");
        } else {
            XB_SPIN(xb_ld(&bar[XB_XGEN(b.x)]) == gen, bar);
            __builtin_amdgcn_fence(__ATOMIC_ACQUIRE, "agent");
            asm volatile("s_waitcnt vmcnt(0)" ::: "memory");
        }
    }
    __syncthreads();
}

__global__ __launch_bounds__(256, 2) void mega(Params p) {
    __shared__ __attribute__((aligned(16))) char lds[LDS_BYTES];
    __shared__ int s_item;
    __shared__ float s_bias[128];
    cg::grid_group grid = cg::this_grid();
    __shared__ uint4 xb_words;
    if (threadIdx.x == 0) xb_words = make_uint4(0u, 0u, 0u, 0u);
    __syncthreads();
    const XcdBarrier xb = xcd_barrier_post((unsigned*)(p.ws + OFF_BAR), (volatile LAS unsigned*)&xb_words);
#define GTID ((long)blockIdx.x * 256 + my_tid())
#define GTHREADS ((long)gridDim.x * 256)
    bf16_t* hbuf = (bf16_t*)(p.ws + OFF_H);
    unsigned* ctr = (unsigned*)(p.ws + OFF_CTR);

    if (GTID < 256) ctr[GTID] = 0u;
    for (int r0 = 0; r0 < REP0; ++r0) {
#ifndef SKIP_CONV
    conv_layer_weights(p, 0, GTID, GTHREADS);
#endif
    rope_table(p, GTID, GTHREADS);
#ifndef SKIP_BIAS
    cmp_bias(p, 0, lds);
#endif
    rms_rows(p.x, p.pre_g, hbuf, NTOK, true);
    rms_rows(p.mem, p.mem_g, (bf16_t*)(p.ws + OFF_MEMN), 2048, false);
    if (p.ws == nullptr) grid.sync();
    xcd_barrier(xb);
    }

#ifdef EXTRA_SYNCS
    for (int es = 0; es < EXTRA_SYNCS; ++es) grid.sync();
#endif
#pragma unroll 1
    for (int layer = 0; layer < 2; ++layer) {
        for (int r123 = 0; r123 < REP123; ++r123) {
        for (int r1 = 0; r1 < REP1; ++r1) {
#ifndef SKIP_P1
        {
            const bf16_t* winT = (const bf16_t*)(p.ws + OFF_WIN);
            const f32x2* rope = (const f32x2*)(p.ws + OFF_ROPE);
            const int xcd = blockIdx.x & 7, li = blockIdx.x >> 3, nb = (gridDim.x + 7 - xcd) >> 3;
#pragma unroll 1
            for (int q = li; q < 832; q += nb) {
                const int q1 = q / 208, q2 = q - q1 * 208;
                int nt, ml;
                if (q2 < 192) { const int ng = q2 >> 6, in = q2 & 63; nt = 8 * ng + (in & 7); ml = in >> 3; }
                else { const int q3 = q2 - 192; nt = 24 + (q3 & 1); ml = q3 >> 1; }
                const int mt = 32 * xcd + 8 * q1 + ml;
                const bf16_t* A = hbuf + (size_t)mt * 128 * 32;
                const bf16_t* Bt = winT + (size_t)nt * 256 * 32;
                if (nt >= 12 && nt < 17) {
                    EpiVT e{(bf16_t*)(p.ws + OFF_VT), NVT, SEQ, mt * 128, nt * 256 - 3072};
                    gemm_wide<false>(lds, A, ARowLin{32}, Bt, 32, 16, e, (long)NTOK * 32, (long)NIN * 32);
                } else {
                    EpiRow e;
                    e.rope = rope; e.row0 = mt * 128;
                    if (nt < 12) { e.dst = (bf16_t*)(p.ws + OFF_BUFA); e.ld = NA; e.col0 = nt * 256; e.mode = (nt == 8) ? EM_ROPEQ : ((nt == 9) ? EM_ROPEK : EM_PLAIN); e.rkt = (nt == 9) ? (bf16_t*)(p.ws + OFF_RKT) : nullptr; }
                    else if (nt < 25) { e.dst = (bf16_t*)(p.ws + OFF_BUFZ); e.ld = NZ; e.col0 = (nt - 17) * 256; e.mode = EM_SILU; e.zblk = true; }
                    else { e.dst = (bf16_t*)(p.ws + OFF_BUFA); e.ld = NA; e.col0 = CA_GATE; e.mode = EM_GATE; }
                    gemm_wide<true>(lds, A, ARowLin{32}, Bt, 32, 16, e, (long)NTOK * 32, (long)NIN * 32);
                }
            }
        }
#endif
        xcd_barrier(xb);
        }
        for (int r2 = 0; r2 < REP2; ++r2) {
#ifndef SKIP_P2
        {
            const bf16_t* bufA = (const bf16_t*)(p.ws + OFF_BUFA);
            float* kmean = (float*)(p.ws + OFF_KMEAN);
            const int n_km = 8 * 16 * 4, n_cmp = 256, n_mem = 16 * 4, n_u = 8 * 4 * 32;
#pragma unroll 1
            for (int t = blockIdx.x; t < n_cmp + n_km + n_mem + n_u; t += gridDim.x) {
                if (t >= n_cmp + n_km + n_mem) {
                    const int u = t - (n_cmp + n_km + n_mem), c = u & 31, bh = u >> 5, b = bh >> 2, hh = bh & 3;
                    const int tid = my_tid(), lane = tid & 63, w = tid >> 6, r = lane & 31, h = lane >> 5;
                    const bf16_t* vtp = (const bf16_t*)(p.ws + OFF_VT) + ((size_t)b * NVT + CV_RV + hh * 128 + 32 * w + r) * SEQ + c * 128 + 8 * h;
                    const bf16_t* ktp = (const bf16_t*)(p.ws + OFF_RKT) + ((size_t)(b * 4 + hh) * 64 + r) * SEQ + c * 128 + 8 * h;
                    f32x16 u0 = zero16(), u1 = zero16();
#pragma unroll
                    for (int kk = 0; kk < 8; ++kk) {
                        const bf16x8 xf = *(const bf16x8*)(vtp + 16 * kk);
                        const bf16x8 y0 = *(const bf16x8*)(ktp + 16 * kk), y1 = *(const bf16x8*)(ktp + (size_t)32 * SEQ + 16 * kk);
                        u0 = MFMA(xf, y0, u0); u1 = MFMA(xf, y1, u1);
                    }
                    bf16_t* up = (bf16_t*)(p.ws + OFF_U) + (size_t)u * 8192;
#pragma unroll
                    for (int i = 0; i < 16; ++i) {
                        up[(32 * w + crow(i, h)) * 64 + r] = (bf16_t)(pack2(u0[i], 0.f) & 0xffffu);
                        up[(32 * w + crow(i, h)) * 64 + 32 + r] = (bf16_t)(pack2(u1[i], 0.f) & 0xffffu);
                    }
                } else if (t >= n_cmp + n_km) {
                    const int u = t - n_cmp - n_km, mt = u >> 2, nt = u & 3;
                    const bf16_t* A = (const bf16_t*)(p.ws + OFF_MEMN) + (size_t)mt * 128 * 1024;
                    const bf16_t* Bt = (const bf16_t*)(p.ws + OFF_WMEM) + (size_t)nt * 256 * 1024;
                    if (nt >= 2) {
                        EpiVT e{(bf16_t*)(p.ws + OFF_MEMV), 512, 256, mt * 128, nt * 256 - 512};
                        gemm_wide<false>(lds, A, ARowLin{1024}, Bt, 1024, 16, e);
                    } else {
                        EpiRow e; e.rope = nullptr; e.row0 = mt * 128; e.dst = (bf16_t*)(p.ws + OFF_MEMK); e.ld = 512; e.col0 = nt * 256; e.mode = EM_PLAIN;
                        gemm_wide<true>(lds, A, ARowLin{1024}, Bt, 1024, 16, e);
                    }
                } else if (t < n_cmp) {
                    const int tileid = t >> 2, split = t & 3, isv = tileid >> 5, mt = tileid & 31;
                    float* cpart = (float*)(p.ws + OFF_CPART) + (size_t)tileid * 4 * 64 * 256;
                    {
                        EpiPart ep{cpart + (size_t)split * 64 * 256};
                        gemm_tile<true>(lds, bufA + (size_t)split * 8 * NA, ARowCmp{mt * 128, isv ? CA_NVC : CA_NKC}, NA,
                                        (const bf16_t*)(p.ws + (isv ? OFF_W1V : OFF_W1K)) + split * 512, 2048, 8, ep);
                    }
                    __threadfence();
                    __syncthreads();
                    if (my_tid() == 0) s_item = (int)atomicAdd(ctr + 64 + layer * 64 + tileid, 1u);
                    __syncthreads();
                    const bool last = (s_item == 3);
                    __syncthreads();
                    if (!last) continue;
                    __threadfence();
                    float* lbias = s_bias;
                    if (my_tid() < 128) {
                        const float* part = (const float*)(p.ws + OFF_BIAS) + isv * 16 * 128 + my_tid();
                        float bsum = 0.f;
#pragma unroll
                        for (int q = 0; q < 16; ++q) bsum += part[q * 128];
                        lbias[my_tid()] = bsum;
                    }
                    __syncthreads();
                    {
                        const int tid2 = my_tid(), row = tid2 >> 1, c0 = (tid2 & 1) * 64;
                        const float* pp = cpart + row * 128 + c0;
#pragma unroll 4
                        for (int cg = 0; cg < 16; ++cg) {
                            const f32x4 a0 = *(const f32x4*)(pp + cg * 4), a1 = *(const f32x4*)(pp + 16384 + cg * 4);
                            const f32x4 a2 = *(const f32x4*)(pp + 2 * 16384 + cg * 4), a3 = *(const f32x4*)(pp + 3 * 16384 + cg * 4);
                            const f32x4 sm = ((a0 + a1) + a2) + a3;
                            const f32x4 bv = *(const f32x4*)(lbias + c0 + cg * 4);
                            u32x2 o = {pack2(silu_f(sm.x + bv.x), silu_f(sm.y + bv.y)), pack2(silu_f(sm.z + bv.z), silu_f(sm.w + bv.w))};
                            *(u32x2*)(lds + row * HSTR + (c0 + cg * 4) * 2) = o;
                        }
                    }
                    __syncthreads();
                    const float* w2 = (isv ? p.w2_v : p.w2_k) + (size_t)layer * 128 * 64;
                    const int tid = my_tid(); const int c = tid & 63, rg = tid >> 6;
                    float* w2s = (float*)(lds + 36864);
#pragma unroll
                    for (int q = 0; q < 8; ++q) *(f32x4*)(w2s + (q * 256 + tid) * 4) = *(const f32x4*)(w2 + (q * 256 + tid) * 4);
                    __syncthreads();
                    float a32[32];
#pragma unroll
                    for (int rr = 0; rr < 32; ++rr) a32[rr] = 0.f;
#pragma unroll 2
                    for (int k = 0; k < 128; k += 2) {
                        const float w0 = w2s[k * 64 + c], w1 = w2s[(k + 1) * 64 + c];
#pragma unroll
                        for (int rr = 0; rr < 32; ++rr) {
                            const unsigned u = *(const unsigned*)(lds + (rg * 32 + rr) * HSTR + k * 2);
                            a32[rr] += bflo(u) * w0 + bfhi(u) * w1;
                        }
                    }
                    bf16_t* kcb = (bf16_t*)(p.ws + OFF_KC);
                    bf16_t* vcb = (bf16_t*)(p.ws + OFF_VCT);
#pragma unroll
                    for (int rr = 0; rr < 32; ++rr) {
                        const int R = mt * 128 + rg * 32 + rr, bg = R >> 8, i = R & 255;
                        const bf16_t val = (bf16_t)(pack2(a32[rr], 0.f) & 0xffffu);
                        if (isv) vcb[((size_t)bg * 64 + c) * 256 + i] = val; else kcb[((size_t)bg * 256 + i) * 64 + c] = val;
                    }
                    __syncthreads();
                } else {
                    const int u = t - n_cmp, qd = u & 3, n = (u >> 2) & 15, b = u >> 6;
                    const int tid = my_tid(); const int cp = tid & 63, kg = tid >> 6;
                    const bf16_t* src = bufA + (size_t)(b * SEQ + n * 256 + kg * 64) * NA + CA_MK + qd * 128 + 2 * cp;
                    float s0 = 0.f, s1 = 0.f;
                    for (int k = 0; k < 64; ++k) { const unsigned uu = *(const unsigned*)(src + (size_t)k * NA); s0 += bflo(uu); s1 += bfhi(uu); }
                    float* red = (float*)lds;
                    red[kg * 128 + 2 * cp] = s0; red[kg * 128 + 2 * cp + 1] = s1;
                    __syncthreads();
                    if (tid < 128) {
                        const float sum = red[tid] + red[128 + tid] + red[256 + tid] + red[384 + tid];
                        const int hh = qd * 2 + (tid >> 6), d = tid & 63;
                        kmean[((size_t)(b * 8 + hh) * 16 + n) * 64 + d] = sum * (1.f / 256.f);
                    }
                    __syncthreads();
                }
            }
        }
#endif
        xcd_barrier(xb);
        }
#ifndef SKIP_P3
        {
            int qsel = blockIdx.x & 7, qtried = 0;
#pragma unroll 1
            while (true) {
                if (my_tid() == 0) s_item = (int)atomicAdd(ctr + layer * 32 + r123 * 16 + qsel, 1u);
                __syncthreads();
                const int id = s_item;
                __syncthreads();
                if (id >= 768) { if (++qtried >= 8) break; qsel = (qsel + 1) & 7; continue; }
                const int b = qsel;
                if (id < 256) {
#ifndef SKIP_NSA
                    for (int rp = 0; rp < REP_NSA; ++rp) nsa_item(p, lds, b, id >> 7, 127 - (id & 127), rp == REP_NSA - 1);
#endif
                } else if (id < 512) {
#ifndef SKIP_MOBA
                    const int u = id - 256; for (int rp = 0; rp < REP_MOBA; ++rp) moba_item(p, lds, b, u >> 5, 31 - (u & 31), rp == REP_MOBA - 1);
#endif
                } else if (id < 640) {
#ifndef SKIP_RET
                    const int u = id - 512; for (int rp = 0; rp < REP_RET; ++rp) ret_item(p, lds, layer, b, u >> 5, 31 - (u & 31), rp == REP_RET - 1);
#endif
                } else {
#ifndef SKIP_MEM
                    const int u = id - 640; for (int rp = 0; rp < REP_MEM; ++rp) mem_item(p, lds, b, u >> 5, u & 31, rp == REP_MEM - 1);
#endif
                }
            }
        }
#endif
        xcd_barrier(xb);
        }
        for (int r4 = 0; r4 < REP4; ++r4) {
#ifndef SKIP_P4
        {
            const bf16_t* bufZ = (const bf16_t*)(p.ws + OFF_BUFZ);
            const bf16_t* woT = (const bf16_t*)(p.ws + OFF_WOUT);
            const int xcd = blockIdx.x & 7, li = blockIdx.x >> 3, nb = (gridDim.x + 7 - xcd) >> 3;
#pragma unroll 1
            for (int q = li; q < 128; q += nb) {
                const int mt = 32 * xcd + (q >> 2), nt = q & 3;
                EpiY e{(bf16_t*)(p.ws + OFF_Y), mt * 128, nt * 256};
                gemm_wide<true>(lds, bufZ + (size_t)mt * 128 * 32, ARowLin{32}, woT + (size_t)nt * 256 * 32, 32, 32, e, (long)NTOK * 32, (long)1024 * 32);
            }
        }
#endif
        xcd_barrier(xb);
        }
        {
            const float* xold = layer == 0 ? p.x : p.out;
            resid_rows(xold, (const bf16_t*)(p.ws + OFF_Y), p.post_g + layer * DM, p.out, layer == 0 ? p.pre_g + DM : nullptr, hbuf);
            if (layer == 0) {
                conv_layer_weights(p, 1, GTID, GTHREADS);
                cmp_bias(p, 1, lds);
                rms_rows(p.mem, p.mem_g + DM, (bf16_t*)(p.ws + OFF_MEMN), 2048, false);
                xcd_barrier(xb);
            }
        }
    }
}

extern "C" void kernel_launch(void* const* d_in, const int* in_sizes, int n_in, void* d_out, int out_size, void* d_ws, size_t ws_size, hipStream_t stream) {
    static int grid_blocks = 0;
    if (!grid_blocks) {
        int dev = 0, cus = 0, per_cu = 0;
        hipGetDevice(&dev);
        hipDeviceGetAttribute(&cus, hipDeviceAttributeMultiprocessorCount, dev);
        hipOccupancyMaxActiveBlocksPerMultiprocessor(&per_cu, mega, 256, 0);
        if (per_cu < 1) per_cu = 1;
        if (per_cu > 2) per_cu = 2;
#ifdef FORCE_PER_CU
        per_cu = FORCE_PER_CU;
#endif
        grid_blocks = cus * per_cu;
    }
    if (ws_size < WS_NEED) fprintf(stderr, "workspace too small: %zu < %zu\n", ws_size, (size_t)WS_NEED);
    Params p{};
    p.x = (const float*)d_in[0]; p.mem = (const float*)d_in[1]; p.pre_g = (const float*)d_in[2]; p.post_g = (const float*)d_in[3];
    p.mem_g = (const float*)d_in[4]; p.w_in = (const float*)d_in[5]; p.w_mem = (const float*)d_in[6]; p.pe_k = (const float*)d_in[7];
    p.w1_k = (const float*)d_in[8]; p.w2_k = (const float*)d_in[9]; p.pe_v = (const float*)d_in[10]; p.w1_v = (const float*)d_in[11];
    p.w2_v = (const float*)d_in[12]; p.gn_g = (const float*)d_in[13]; p.w_out = (const float*)d_in[14];
    p.out = (float*)d_out; p.ws = (char*)d_ws;
    (void)hipMemsetAsync((char*)d_ws + OFF_BAR, 0, XCD_BAR_WORDS * 4, stream);
    void* args[] = {&p};
    hipError_t e = hipLaunchCooperativeKernel((void*)mega, dim3(grid_blocks), dim3(256), args, 0, stream);
    if (e != hipSuccess) fprintf(stderr, "cooperative launch failed: %s (grid %d)\n", hipGetErrorString(e), grid_blocks);
}
```

```cpp
#include <hip/hip_runtime.h>
#include <hip/hip_cooperative_groups.h>
#include <stdint.h>
#include <cstdio>
namespace cg = cooperative_groups;

typedef unsigned short bf16_t;
typedef short bf16x8 __attribute__((ext_vector_type(8)));
typedef float f32x16 __attribute__((ext_vector_type(16)));
typedef float f32x4 __attribute__((ext_vector_type(4)));
typedef float f32x2 __attribute__((ext_vector_type(2)));
typedef unsigned u32x4 __attribute__((ext_vector_type(4)));
typedef unsigned u32x2 __attribute__((ext_vector_type(2)));
typedef __bf16 bf16v2 __attribute__((ext_vector_type(2)));
typedef unsigned long long u64;
#define DI __device__ __forceinline__
#define MFMA(a, b, c) __builtin_amdgcn_mfma_f32_32x32x16_bf16((a), (b), (c), 0, 0, 0)

constexpr int SEQ = 4096, DM = 1024, NTOK = 32768;
constexpr int NA = 3096;
constexpr int NZ = 2048;
constexpr int NVT = 1280;
constexpr int NIN = 6656;
constexpr float EPS = 1e-6f;
DI size_t kbm(int row, int k, int nrows) { return ((size_t)(k >> 5) * nrows + row) * 32 + (k & 31); }
constexpr float LOG2E = 1.4426950408889634f;

constexpr int CA_MQ = 0, CA_MK = 512, CA_NQ = 1024, CA_NKC = 1536, CA_NVC = 1664, CA_NKS = 1792, CA_NKW = 1920,
              CA_RQ = 2048, CA_RK = 2304, CA_CQ = 2560, CA_GATE = 3072;
constexpr int CV_MV = 0, CV_NVS = 512, CV_NVW = 640, CV_RV = 768;

constexpr size_t OFF_BUFA = 0;
constexpr size_t OFF_VT   = OFF_BUFA + (size_t)NTOK * NA * 2;
constexpr size_t OFF_BUFZ = OFF_VT + (size_t)8 * NVT * SEQ * 2;
constexpr size_t OFF_H    = OFF_BUFZ + (size_t)NTOK * NZ * 2;
constexpr size_t OFF_WIN  = OFF_H + (size_t)NTOK * DM * 2;
constexpr size_t OFF_WOUT = OFF_WIN + (size_t)NIN * 1024 * 2;
constexpr size_t OFF_WMEM = OFF_WOUT + (size_t)1024 * 2048 * 2;
constexpr size_t OFF_W1K  = OFF_WMEM + (size_t)1024 * 1024 * 2;
constexpr size_t OFF_W1V  = OFF_W1K + (size_t)128 * 2048 * 2;
constexpr size_t OFF_ROPE = OFF_W1V + (size_t)128 * 2048 * 2;
constexpr size_t OFF_MEMN = OFF_ROPE + (size_t)SEQ * 32 * 8;
constexpr size_t OFF_MEMK = OFF_MEMN + (size_t)2048 * 1024 * 2;
constexpr size_t OFF_MEMV = OFF_MEMK + (size_t)2048 * 512 * 2;
constexpr size_t OFF_BIAS = OFF_MEMV + (size_t)8 * 512 * 256 * 2;
constexpr size_t OFF_CTR  = OFF_BIAS + 16384;
constexpr size_t OFF_BAR  = OFF_CTR + 1024;
constexpr size_t OFF_RKT  = OFF_BAR + 16384;
constexpr size_t WS_NEED  = OFF_RKT + (size_t)8 * 4 * 64 * SEQ * 2;
constexpr size_t OFF_KMEAN = OFF_H;
constexpr size_t OFF_KC    = OFF_KMEAN + (size_t)8 * 8 * 16 * 64 * 4;
constexpr size_t OFF_VCT   = OFF_KC + (size_t)16 * 256 * 64 * 2;
constexpr size_t OFF_U = OFF_H + ((size_t)24 << 20);
constexpr size_t OFF_CPART = OFF_H + ((size_t)4 << 20);
constexpr size_t OFF_Y = OFF_BUFA;

constexpr int LDS_BYTES = 73728;
#ifndef REP1
#define REP1 1
#endif
#ifndef REP_NSA
#define REP_NSA 1
#endif
#ifndef REP_MOBA
#define REP_MOBA 1
#endif
#ifndef REP_RET
#define REP_RET 1
#endif
#ifndef REP_MEM
#define REP_MEM 1
#endif
#ifndef REP0
#define REP0 1
#endif
#ifndef REP2
#define REP2 1
#endif
#ifndef REP4
#define REP4 1
#endif
#ifndef REP123
#define REP123 1
#endif

struct Params {
    const float *x, *mem, *pre_g, *post_g, *mem_g, *w_in, *w_mem, *pe_k, *w1_k, *w2_k, *pe_v, *w1_v, *w2_v, *gn_g, *w_out;
    float* out;
    char* ws;
};

DI int my_tid() { int t = threadIdx.x; asm volatile("" : "+v"(t)); return t; }
DI unsigned pack2(float a, float b) { f32x2 v = {a, b}; bf16v2 r = __builtin_convertvector(v, bf16v2); return __builtin_bit_cast(unsigned, r); }
DI float bflo(unsigned u) { return __uint_as_float(u << 16); }
DI float bfhi(unsigned u) { return __uint_as_float(u & 0xffff0000u); }
DI float bf2f(bf16_t v) { return __uint_as_float(((unsigned)v) << 16); }
DI int crow(int reg, int h) { return (reg & 3) + 8 * (reg >> 2) + 4 * h; }
DI float ex2(float x) { return __builtin_amdgcn_exp2f(x); }
DI float ret_lg(int hh) { return (hh == 0) ? -0.045803688f : (hh == 1 ? -0.022720077f : (hh == 2 ? -0.011315314f : -0.0056465633f)); }
DI float mx2(float a, float b) { return __builtin_amdgcn_fmed3f(a, b, INFINITY); }
DI float shx(float v, int m) { return __shfl_xor(v, m, 64); }
DI float xh_max(float v) { auto rr = __builtin_amdgcn_permlane32_swap(__float_as_uint(v), __float_as_uint(v), false, false); return __builtin_amdgcn_fmed3f(__uint_as_float(rr[0]), __uint_as_float(rr[1]), INFINITY); }
DI float xh_sum(float v) { auto rr = __builtin_amdgcn_permlane32_swap(__float_as_uint(v), __float_as_uint(v), false, false); return __uint_as_float(rr[0]) + __uint_as_float(rr[1]); }
DI float xh_other(float v, int h) { auto rr = __builtin_amdgcn_permlane32_swap(__float_as_uint(v), __float_as_uint(v), false, false); return h ? __uint_as_float(rr[0]) : __uint_as_float(rr[1]); }
DI float wave_sum(float v) { v = xh_sum(v); v += shx(v, 16); v += shx(v, 8); v += shx(v, 4); v += shx(v, 2); v += shx(v, 1); return v; }
DI float silu_f(float v) { return v * __builtin_amdgcn_rcpf(1.f + __expf(-v)); }
DI float sigm_f(float v) { return __builtin_amdgcn_rcpf(1.f + __expf(-v)); }
DI f32x16 zero16() { f32x16 z; for (int i = 0; i < 16; ++i) z[i] = 0.f; return z; }

DI int in_col_src(int n) {
    if (n < 1024) return n;
    if (n < 1920) return n + 512;
    if (n < 2048) return n + 640;
    if (n < 2560) return n + 792;
    if (n < 3072) return n + 1304;
    if (n < 3584) return n - 2048;
    if (n < 3712) return n - 1152;
    if (n < 3840) return n - 1024;
    if (n < 4352) return n - 488;
    if (n < 6400) return n + 24;
    if (n < 6424) return n - 3584;
    return -1;
}

constexpr int GSTR = 144;
constexpr int GBUF = 36864;
constexpr int GBOFF = 18432;

DI void glds16(const void* g, unsigned lds_addr);
template <int N> DI void wait_vm();
#define RAW_BARRIER() do { asm volatile("s_waitcnt lgkmcnt(0)" ::: "memory"); __builtin_amdgcn_s_barrier(); asm volatile("" ::: "memory"); } while (0)
template <bool SWAP, class AOff, class Epi>
DI void gemm_tile(char* lds, const bf16_t* __restrict__ A, AOff aoff, long a_kstride, const bf16_t* __restrict__ Bt, long ldb, int nk64, Epi epi) {
    constexpr int TB = 16384, NI = 4;
    const int tid = my_tid(), lane = tid & 63, w = __builtin_amdgcn_readfirstlane(tid >> 6), r = lane & 31, h = lane >> 5;
    const int wm = w >> 1, wn = w & 1;
    const int nk = nk64 * 2;
    const int lr = lane >> 2, ls = lane & 3;
    const bf16_t* ap[2];
    const bf16_t* bp[2];
#pragma unroll
    for (int i = 0; i < 2; ++i) {
        const int row = 16 * (w + 4 * i) + lr, c = ls ^ ((row >> 2) & 3);
        ap[i] = A + aoff(row) + c * 8;
        bp[i] = Bt + (long)row * ldb + c * 8;
    }
    const unsigned sbase = (unsigned)(size_t)lds;
    f32x16 acc[2][2];
#pragma unroll
    for (int i = 0; i < 2; ++i)
#pragma unroll
        for (int j = 0; j < 2; ++j) acc[i][j] = zero16();
    int issued = 0;
#pragma unroll 1
    for (int a = 0; a < 3; ++a) {
        if (issued < nk) {
            const long ko_a = (long)(issued >> 1) * a_kstride + (issued & 1) * 32, ko_b = (long)issued * 32;
            const unsigned st = sbase + (issued & 3) * TB + w * 1024;
            glds16(ap[0] + ko_a, st); glds16(bp[0] + ko_b, st + 8192);
            glds16(ap[1] + ko_a, st + 4096); glds16(bp[1] + ko_b, st + 8192 + 4096);
            ++issued;
        }
    }
    const int fa = (wm * 64 + r) * 64, fb = 8192 + (wn * 64 + r) * 64, sw = (r >> 2) & 3;
#pragma unroll 1
    for (int kb = 0; kb < nk; ++kb) {
        const int ahead = issued - 1 - kb;
        if (ahead >= 2) wait_vm<2 * NI>(); else if (ahead == 1) wait_vm<NI>(); else wait_vm<0>();
        RAW_BARRIER();
        if (issued < nk) {
            const long ko_a = (long)(issued >> 1) * a_kstride + (issued & 1) * 32, ko_b = (long)issued * 32;
            const unsigned st = sbase + (issued & 3) * TB + w * 1024;
            glds16(ap[0] + ko_a, st); glds16(bp[0] + ko_b, st + 8192);
            glds16(ap[1] + ko_a, st + 4096); glds16(bp[1] + ko_b, st + 8192 + 4096);
            ++issued;
        }
        const char* cur = lds + (kb & 3) * TB;
        bf16x8 af[2][2], bfr[2][2];
#pragma unroll
        for (int kk = 0; kk < 2; ++kk) {
            const int so = ((2 * kk + h) ^ sw) * 16;
#pragma unroll
            for (int i = 0; i < 2; ++i) af[kk][i] = *(const bf16x8*)(cur + fa + i * 2048 + so);
#pragma unroll
            for (int j = 0; j < 2; ++j) bfr[kk][j] = *(const bf16x8*)(cur + fb + j * 2048 + so);
        }
#pragma unroll
        for (int kk = 0; kk < 2; ++kk)
#pragma unroll
            for (int i = 0; i < 2; ++i)
#pragma unroll
                for (int j = 0; j < 2; ++j) acc[i][j] = SWAP ? MFMA(bfr[kk][j], af[kk][i], acc[i][j]) : MFMA(af[kk][i], bfr[kk][j], acc[i][j]);
    }
    RAW_BARRIER();
    epi(acc, wm, wn, r, h);
}

template <bool SWAP, class AOff, class Epi>
DI void gemm_wide(char* lds, const bf16_t* __restrict__ A, AOff aoff, const bf16_t* __restrict__ Bt, long ldb, int nk64, Epi epi, long a_ks = 32, long b_ks = 32) {
    constexpr int TB = 24576, NI = 6;
    const int tid = my_tid(), lane = tid & 63, w = __builtin_amdgcn_readfirstlane(tid >> 6), r = lane & 31, h = lane >> 5;
    const int wm = w >> 1, wn = w & 1;
    const int nk = nk64 * 2;
    const int lr = lane >> 2, ls = lane & 3;
    const bf16_t* ap[2];
    const bf16_t* bp[4];
#pragma unroll
    for (int i = 0; i < 2; ++i) { const int row = 16 * (w + 4 * i) + lr, c = ls ^ ((row >> 2) & 3); ap[i] = A + aoff(row) + c * 8; }
#pragma unroll
    for (int i = 0; i < 4; ++i) { const int row = 16 * (w + 4 * i) + lr, c = ls ^ ((row >> 2) & 3); bp[i] = Bt + (long)row * ldb + c * 8; }
    const unsigned sbase = (unsigned)(size_t)lds;
    f32x16 acc[2][4];
#pragma unroll
    for (int i = 0; i < 2; ++i)
#pragma unroll
        for (int j = 0; j < 4; ++j) acc[i][j] = zero16();
    int issued = 0, si = 0;
#pragma unroll 1
    for (int a = 0; a < 2; ++a) {
        if (issued < nk) {
            const long ko = (long)issued * a_ks, kob = (long)issued * b_ks;
            const unsigned st = sbase + si * TB + w * 1024;
            glds16(ap[0] + ko, st); glds16(ap[1] + ko, st + 4096);
            glds16(bp[0] + kob, st + 8192); glds16(bp[1] + kob, st + 8192 + 4096); glds16(bp[2] + kob, st + 8192 + 8192); glds16(bp[3] + kob, st + 8192 + 12288);
            ++issued; si = (si == 2) ? 0 : si + 1;
        }
    }
    const int fa = (wm * 64 + r) * 64, fb = 8192 + (wn * 128 + r) * 64, sw = (r >> 2) & 3;
    int sc_ = 0;
#pragma unroll 1
    for (int kb = 0; kb < nk; ++kb) {
        if (issued - 1 - kb >= 1) wait_vm<NI>(); else wait_vm<0>();
        RAW_BARRIER();
        const char* cur = lds + sc_ * TB;
        sc_ = (sc_ == 2) ? 0 : sc_ + 1;
        bf16x8 af[2][2], bfr[2][4];
#pragma unroll
        for (int kk = 0; kk < 2; ++kk) {
            const int so = ((2 * kk + h) ^ sw) * 16;
#pragma unroll
            for (int i = 0; i < 2; ++i) af[kk][i] = *(const bf16x8*)(cur + fa + i * 2048 + so);
#pragma unroll
            for (int j = 0; j < 4; ++j) bfr[kk][j] = *(const bf16x8*)(cur + fb + j * 2048 + so);
        }
        if (issued < nk) {
            const long ko = (long)issued * a_ks, kob = (long)issued * b_ks;
            const unsigned st = sbase + si * TB + w * 1024;
            glds16(ap[0] + ko, st); glds16(ap[1] + ko, st + 4096);
            glds16(bp[0] + kob, st + 8192); glds16(bp[1] + kob, st + 8192 + 4096); glds16(bp[2] + kob, st + 8192 + 8192); glds16(bp[3] + kob, st + 8192 + 12288);
            ++issued; si = (si == 2) ? 0 : si + 1;
        }
#pragma unroll
        for (int kk = 0; kk < 2; ++kk)
#pragma unroll
            for (int i = 0; i < 2; ++i)
#pragma unroll
                for (int j = 0; j < 4; ++j) acc[i][j] = SWAP ? MFMA(bfr[kk][j], af[kk][i], acc[i][j]) : MFMA(af[kk][i], bfr[kk][j], acc[i][j]);
    }
    RAW_BARRIER();
    epi(acc, wm, wn, r, h);
}

struct ARowLin { long ld; DI long operator()(int r) const { return (long)r * ld; } };

enum { EM_PLAIN = 0, EM_ROPEQ = 1, EM_ROPEK = 2, EM_SILU = 3, EM_GATE = 4 };
struct EpiRow {
    bf16_t* dst; long ld; int row0; int col0; int mode; const f32x2* rope; bool zblk = false; bf16_t* rkt = nullptr;
    template <int NJ> DI void operator()(f32x16 (&acc)[2][NJ], int wm, int wn, int r, int h) const {
#pragma unroll
        for (int i = 0; i < 2; ++i) {
            const int row = row0 + wm * 64 + 32 * i + r;
            if (mode == EM_ROPEQ || mode == EM_ROPEK) {
                const int pos = row & (SEQ - 1);
                const float scl = (mode == EM_ROPEK) ? 0.125f : 1.f;
#pragma unroll
                for (int jp = 0; jp < NJ; jp += 2)
#pragma unroll
                for (int c4 = 0; c4 < 4; ++c4) {
                    float n1[4], n2[4];
#pragma unroll
                    for (int e = 0; e < 4; ++e) {
                        const int d = 8 * c4 + 4 * h + e;
                        const f32x2 cs = rope[pos * 32 + d];
                        const float t1 = acc[i][jp][4 * c4 + e], t2 = acc[i][jp + 1][4 * c4 + e];
                        n1[e] = (t1 * cs.x - t2 * cs.y) * scl;
                        n2[e] = (t1 * cs.y + t2 * cs.x) * scl;
                    }
                    bf16_t* d1 = dst + (long)row * ld + col0 + wn * (32 * NJ) + 32 * jp + 8 * c4 + 4 * h;
                    u32x2 o1 = {pack2(n1[0], n1[1]), pack2(n1[2], n1[3])};
                    u32x2 o2 = {pack2(n2[0], n2[1]), pack2(n2[2], n2[3])};
                    *(u32x2*)d1 = o1;
                    *(u32x2*)(d1 + 32) = o2;
                    if (mode == EM_ROPEK && rkt != nullptr) {
                        const int hh = (wn * (32 * NJ) + 32 * jp) >> 6;
                        const float wgt = ex2(ret_lg(hh) * (float)(127 - (pos & 127)));
                        bf16_t* tp = rkt + ((size_t)((row >> 12) * 4 + hh) * 64 + 8 * c4 + 4 * h) * SEQ + pos;
#pragma unroll
                        for (int e = 0; e < 4; ++e) {
                            tp[(size_t)e * SEQ] = (bf16_t)(pack2(n1[e] * wgt, 0.f) & 0xffffu);
                            tp[(size_t)(e + 32) * SEQ] = (bf16_t)(pack2(n2[e] * wgt, 0.f) & 0xffffu);
                        }
                    }
                }
            } else {
#pragma unroll
                for (int j = 0; j < NJ; ++j)
#pragma unroll
                    for (int c4 = 0; c4 < 4; ++c4) {
                        const int cl = wn * (32 * NJ) + 32 * j + 8 * c4 + 4 * h;
                        float v[4];
#pragma unroll
                        for (int e = 0; e < 4; ++e) v[e] = acc[i][j][4 * c4 + e];
                        if (mode == EM_SILU) {
#pragma unroll
                            for (int e = 0; e < 4; ++e) v[e] = silu_f(v[e]);
                        }
                        if (mode == EM_GATE) {
                            if (cl >= 24) continue;
#pragma unroll
                            for (int e = 0; e < 4; ++e) v[e] = sigm_f(v[e]);
                        }
                        u32x2 o = {pack2(v[0], v[1]), pack2(v[2], v[3])};
                        *(u32x2*)(dst + (zblk ? kbm(row, col0 + cl, NTOK) : (size_t)((long)row * ld + col0 + cl))) = o;
                    }
            }
        }
    }
};
struct EpiVT {
    bf16_t* dst; int ncols; int seq; int row0; int col0;
    template <int NJ> DI void operator()(f32x16 (&acc)[2][NJ], int wm, int wn, int r, int h) const {
#pragma unroll
        for (int i = 0; i < 2; ++i)
#pragma unroll
            for (int j = 0; j < NJ; ++j) {
                const int col = col0 + wn * (32 * NJ) + 32 * j + r;
#pragma unroll
                for (int c4 = 0; c4 < 4; ++c4) {
                    const int row = row0 + wm * 64 + 32 * i + 8 * c4 + 4 * h;
                    const int b = row / seq, s = row - b * seq;
                    u32x2 o = {pack2(acc[i][j][4 * c4], acc[i][j][4 * c4 + 1]), pack2(acc[i][j][4 * c4 + 2], acc[i][j][4 * c4 + 3])};
                    *(u32x2*)(dst + ((long)b * ncols + col) * seq + s) = o;
                }
            }
    }
};
struct EpiY {
    bf16_t* dst; int row0; int col0;
    template <int NJ> DI void operator()(f32x16 (&acc)[2][NJ], int wm, int wn, int r, int h) const {
#pragma unroll
        for (int i = 0; i < 2; ++i) {
            const int row = row0 + wm * 64 + 32 * i + r;
#pragma unroll
            for (int j = 0; j < NJ; ++j)
#pragma unroll
                for (int c4 = 0; c4 < 4; ++c4) {
                    u32x2 o = {pack2(acc[i][j][4 * c4], acc[i][j][4 * c4 + 1]), pack2(acc[i][j][4 * c4 + 2], acc[i][j][4 * c4 + 3])};
                    *(u32x2*)(dst + (long)row * DM + col0 + wn * (32 * NJ) + 32 * j + 8 * c4 + 4 * h) = o;
                }
        }
    }
};
constexpr int HSTR = 272;
struct EpiCmp {
    char* lds; const float* bias;
    DI void operator()(f32x16 (&acc)[2][2], int wm, int wn, int r, int h) const {
#pragma unroll
        for (int i = 0; i < 2; ++i) {
            const int row = wm * 64 + 32 * i + r;
#pragma unroll
            for (int j = 0; j < 2; ++j)
#pragma unroll
                for (int c4 = 0; c4 < 4; ++c4) {
                    const int cl = wn * 64 + 32 * j + 8 * c4 + 4 * h;
                    float v[4];
#pragma unroll
                    for (int e = 0; e < 4; ++e) v[e] = silu_f(acc[i][j][4 * c4 + e] + bias[cl + e]);
                    u32x2 o = {pack2(v[0], v[1]), pack2(v[2], v[3])};
                    *(u32x2*)(lds + row * HSTR + cl * 2) = o;
                }
        }
    }
};
struct EpiPart {
    float* dst;
    DI void operator()(f32x16 (&acc)[2][2], int wm, int wn, int r, int h) const {
#pragma unroll
        for (int i = 0; i < 2; ++i) {
            const int row = wm * 64 + 32 * i + r;
#pragma unroll
            for (int j = 0; j < 2; ++j)
#pragma unroll
                for (int c4 = 0; c4 < 4; ++c4) {
                    f32x4 o = {acc[i][j][4 * c4], acc[i][j][4 * c4 + 1], acc[i][j][4 * c4 + 2], acc[i][j][4 * c4 + 3]};
                    *(f32x4*)(dst + row * 128 + wn * 64 + 32 * j + 8 * c4 + 4 * h) = o;
                }
        }
    }
};
struct ARowCmp {
    int row0; int colbase;
    DI long operator()(int r) const {
        const int R = row0 + r, bg = R >> 8; int i = R & 255; if (i > 254) i = 254;
        const int b = bg >> 1, g = bg & 1;
        return ((long)(b * SEQ + 16 * i)) * NA + colbase + g * 64;
    }
};

enum { FM_NONE = 0, FM_MOBA = 1, FM_CMP = 2, FM_SLC = 3, FM_WIN = 4, FM_RET = 5 };
constexpr int VSTR = 144;

template <int DK, int DV>
struct TileRegs { u32x4 k[DK / 32]; u32x4 v[DV / 32]; };

template <int DK, int DV>
DI void tile_load(TileRegs<DK, DV>& t, const bf16_t* __restrict__ Kp, long kstride, const bf16_t* __restrict__ Vt, long vstride, int key0, bool loadv) {
    const int tid = my_tid();
#pragma unroll
    for (int j = 0; j < DK / 32; ++j) {
        const int c = tid + 256 * j, row = c / (DK / 8), kc = c % (DK / 8);
        t.k[j] = *(const u32x4*)(Kp + (long)(key0 + row) * kstride + kc * 8);
    }
    if (loadv) {
#pragma unroll
        for (int j = 0; j < DV / 32; ++j) {
            const int c = tid + 256 * j, row = c >> 3, kc = c & 7;
            t.v[j] = *(const u32x4*)(Vt + (long)row * vstride + key0 + kc * 8);
        }
    }
}
template <int DK, int DV>
DI void tile_store(const TileRegs<DK, DV>& t, char* buf, bool storev) {
    constexpr int KSTR = (DK + 8) * 2;
    const int tid = my_tid();
#pragma unroll
    for (int j = 0; j < DK / 32; ++j) {
        const int c = tid + 256 * j, row = c / (DK / 8), kc = c % (DK / 8);
        *(u32x4*)(buf + row * KSTR + kc * 16) = t.k[j];
    }
    if (storev) {
#pragma unroll
        for (int j = 0; j < DV / 32; ++j) {
            const int c = tid + 256 * j, row = c >> 3, kc = c & 7;
            *(u32x4*)(buf + 64 * KSTR + row * VSTR + kc * 16) = t.v[j];
        }
    }
}

template <int MODE>
DI bool fpred(int key, int tq) {
    if (MODE == FM_NONE) return true;
    if (MODE == FM_CMP) return (16 * key + 31) <= tq;
    if (MODE == FM_WIN) return (key <= tq) && (key > tq - 512);
    return key <= tq;
}

DI void glds16(const void* g, unsigned lds_addr) {
    lds_addr = __builtin_amdgcn_readfirstlane(lds_addr);
    asm volatile("s_mov_b32 m0, %0\n\ts_nop 0\n\tglobal_load_lds_dwordx4 %1, off" ::"s"(lds_addr), "v"(g) : "memory", "m0");
}
template <int DK, int DV>
struct TileSrc { const bf16_t* k[DK / 32]; const bf16_t* v[DV / 32]; unsigned woff; };
template <int DK, int DV>
DI void tile_src_init(TileSrc<DK, DV>& ts, const bf16_t* __restrict__ Kp, long kstride, const bf16_t* __restrict__ Vt, long vstride) {
    constexpr int NK = DK / 8, NV = DV / 8;
    const int tid = my_tid(), lane = tid & 63, w = __builtin_amdgcn_readfirstlane(tid >> 6);
    ts.woff = (unsigned)w * 1024u;
#pragma unroll
    for (int i = 0; i < NK / 4; ++i) {
        const int g = w + 4 * i;
        int row, c;
        if (DK == 64) { row = 8 * g + (lane >> 3); c = (lane & 7) ^ ((row >> 1) & 7); }
        else { row = 4 * g + (lane >> 4); c = (lane & 15) ^ (row & 15); }
        ts.k[i] = Kp + (long)row * kstride + c * 8;
    }
#pragma unroll
    for (int i = 0; i < NV / 4; ++i) {
        const int g = w + 4 * i;
        const int row = 8 * g + (lane >> 3), c = (lane & 7) ^ ((row >> 1) & 7);
        ts.v[i] = Vt + (long)row * vstride + c * 8;
    }
}
template <int DK, int DV>
DI void tile_issue(char* stage, const TileSrc<DK, DV>& ts, long kstride, int key0) {
    constexpr int NK = DK / 8, NV = DV / 8;
    const unsigned sbase = (unsigned)(size_t)stage + ts.woff;
    const long koff = (long)key0 * kstride;
#pragma unroll
    for (int i = 0; i < NK / 4; ++i) glds16(ts.k[i] + koff, sbase + i * 4096);
#pragma unroll
    for (int i = 0; i < NV / 4; ++i) glds16(ts.v[i] + key0, sbase + NK * 1024 + i * 4096);
}
template <int N> DI void wait_vm() { asm volatile("s_waitcnt vmcnt(%0)" ::"n"(N) : "memory"); }

template <int DK, int DV, int MODE>
DI void flash(char* lds, const bf16x8 (&qf)[DK / 16], const bf16_t* __restrict__ Kp, long kstride, const bf16_t* __restrict__ Vt, long vstride,
              u64 tiles, u64 wtiles, int tq, u64 aux, float sc, float lg, f32x16 (&o)[DV / 32], float& m, float& l, int nst_cap = 4) {
    constexpr int NK = DK / 8, NV = DV / 8, NI = (NK + NV) / 4;
    constexpr int TB = (NK + NV) * 1024;
    constexpr int NSTMAX = (LDS_BYTES / TB) > 4 ? 4 : (LDS_BYTES / TB);
    const int NST = NSTMAX < nst_cap ? NSTMAX : nst_cap;
    const int lane = my_tid() & 63, r = lane & 31, h = lane >> 5;
    tiles = ((u64)(unsigned)__builtin_amdgcn_readfirstlane((unsigned)(tiles >> 32)) << 32) | (unsigned)__builtin_amdgcn_readfirstlane((unsigned)tiles);
    wtiles = ((u64)(unsigned)__builtin_amdgcn_readfirstlane((unsigned)(wtiles >> 32)) << 32) | (unsigned)__builtin_amdgcn_readfirstlane((unsigned)wtiles);
    u64 rem_i = tiles, rem_c = tiles;
    const int n = __builtin_popcountll(tiles);
    if (n == 0) return;
    TileSrc<DK, DV> ts;
    tile_src_init<DK, DV>(ts, Kp, kstride, Vt, vstride);
    int issued = 0, slot_i = 0, slot_c = 0;
#pragma unroll 1
    for (int a = 0; a < NST - 1; ++a) {
        if (rem_i) {
            const int t = __builtin_ctzll(rem_i); rem_i &= rem_i - 1;
            tile_issue<DK, DV>(lds + slot_i * TB, ts, kstride, t * 64);
            ++issued; slot_i = (slot_i + 1 == NST) ? 0 : slot_i + 1;
        }
    }
#pragma unroll 1
    for (int j = 0; j < n; ++j) {
        const int cur = __builtin_ctzll(rem_c); rem_c &= rem_c - 1;
        const int ahead = issued - 1 - j;
        if (ahead >= 2) wait_vm<2 * NI>(); else if (ahead == 1) wait_vm<NI>(); else wait_vm<0>();
        RAW_BARRIER();
        if (rem_i) {
            const int t = __builtin_ctzll(rem_i); rem_i &= rem_i - 1;
            tile_issue<DK, DV>(lds + slot_i * TB, ts, kstride, t * 64);
            ++issued; slot_i = (slot_i + 1 == NST) ? 0 : slot_i + 1;
        }
        const char* Ks = lds + slot_c * TB;
        const char* Vs = Ks + NK * 1024;
        slot_c = (slot_c + 1 == NST) ? 0 : slot_c + 1;
        if ((wtiles >> cur) & 1ull) {
            const int q0w = __builtin_amdgcn_readfirstlane(tq);
            const int kt0 = cur * 64;
            bool need_mask = false;
            if (MODE == FM_MOBA || MODE == FM_SLC || MODE == FM_RET) need_mask = (kt0 + 63 > q0w);
            if (MODE == FM_CMP) need_mask = (16 * (kt0 + 63) + 31 > q0w);
            if (MODE == FM_WIN) need_mask = (kt0 + 63 > q0w) || (kt0 <= q0w + 31 - 512);
            bool lane_on = true;
            if (MODE == FM_MOBA) lane_on = (((unsigned)aux >> (cur >> 2)) & 1u) != 0u;
            if (MODE == FM_SLC) lane_on = ((aux >> cur) & 1ull) != 0ull;
            f32x16 s[2];
            if (DK == 64) {
                bf16x8 kf[2][DK / 16];
#pragma unroll
                for (int t = 0; t < 2; ++t)
#pragma unroll
                    for (int kk = 0; kk < DK / 16; ++kk) {
                        const int krow = 32 * t + r;
                        kf[t][kk] = *(const bf16x8*)(Ks + krow * (DK * 2) + (((2 * kk + h) ^ ((krow >> 1) & 7)) * 16));
                    }
                __builtin_amdgcn_sched_barrier(0);
#pragma unroll
                for (int t = 0; t < 2; ++t) {
                    s[t] = zero16();
#pragma unroll
                    for (int kk = 0; kk < DK / 16; ++kk) s[t] = MFMA(kf[t][kk], qf[kk], s[t]);
                }
            } else {
#pragma unroll
                for (int t = 0; t < 2; ++t) {
                    bf16x8 kf[DK / 16];
#pragma unroll
                    for (int kk = 0; kk < DK / 16; ++kk) {
                        const int krow = 32 * t + r;
                        kf[kk] = *(const bf16x8*)(Ks + krow * (DK * 2) + (((2 * kk + h) ^ (krow & 15)) * 16));
                    }
                    s[t] = zero16();
#pragma unroll
                    for (int kk = 0; kk < DK / 16; ++kk) s[t] = MFMA(kf[kk], qf[kk], s[t]);
                    __builtin_amdgcn_sched_barrier(0);
                }
            }
            u32x4 vf0[2][DV / 32];
#pragma unroll
            for (int ss = 0; ss < 2; ++ss)
#pragma unroll
                for (int d = 0; d < DV / 32; ++d) {
                    const int vrow = 32 * d + r, vkey = (vrow >> 1) & 7, c0 = 2 * ss;
                    const u32x2 lo = *(const u32x2*)(Vs + vrow * 128 + ((c0 ^ vkey) * 16) + 8 * h);
                    const u32x2 hi = *(const u32x2*)(Vs + vrow * 128 + (((c0 + 1) ^ vkey) * 16) + 8 * h);
                    vf0[ss][d] = (u32x4){lo.x, lo.y, hi.x, hi.y};
                }
            __builtin_amdgcn_sched_barrier(0);
            if (MODE != FM_RET) {
                if (need_mask) {
#pragma unroll
                    for (int t = 0; t < 2; ++t)
#pragma unroll
                        for (int i = 0; i < 16; ++i)
                            if (!fpred<MODE>(kt0 + 32 * t + crow(i, h), tq)) s[t][i] = -INFINITY;
                }
                float mx0 = mx2(mx2(mx2(s[0][0], s[0][1]), mx2(s[0][2], s[0][3])), mx2(mx2(s[0][4], s[0][5]), mx2(s[0][6], s[0][7])));
                float mx1 = mx2(mx2(mx2(s[0][8], s[0][9]), mx2(s[0][10], s[0][11])), mx2(mx2(s[0][12], s[0][13]), mx2(s[0][14], s[0][15])));
                float mx2_ = mx2(mx2(mx2(s[1][0], s[1][1]), mx2(s[1][2], s[1][3])), mx2(mx2(s[1][4], s[1][5]), mx2(s[1][6], s[1][7])));
                float mx3 = mx2(mx2(mx2(s[1][8], s[1][9]), mx2(s[1][10], s[1][11])), mx2(mx2(s[1][12], s[1][13]), mx2(s[1][14], s[1][15])));
                float mx = mx2(mx2(mx0, mx1), mx2(mx2_, mx3));
                if (MODE == FM_MOBA || MODE == FM_SLC) mx = lane_on ? mx : -INFINITY;
                mx = xh_max(mx);
                const float mxs = mx * sc;
                if (__any(mxs > m + 8.f)) {
                    const float mn = fmaxf(m, mxs);
                    const float alpha = ex2(m - mn);
                    m = mn;
                    l *= alpha;
#pragma unroll
                    for (int d = 0; d < DV / 32; ++d)
#pragma unroll
                        for (int i = 0; i < 16; ++i) o[d][i] *= alpha;
                }
                float negm = -m;
                if (MODE == FM_MOBA || MODE == FM_SLC) negm = lane_on ? negm : -1e30f;
                float ps0 = 0.f, ps1 = 0.f;
#pragma unroll
                for (int t = 0; t < 2; ++t)
#pragma unroll
                    for (int i = 0; i < 16; i += 2) {
                        const float p0 = ex2(__builtin_fmaf(s[t][i], sc, negm));
                        const float p1 = ex2(__builtin_fmaf(s[t][i + 1], sc, negm));
                        s[t][i] = p0; s[t][i + 1] = p1;
                        ps0 += p0; ps1 += p1;
                    }
                l += ps0 + ps1;
            } else {
                const float g1 = sc, g2 = g1 * g1, g3 = g2 * g1, g4 = g2 * g2, g8 = g4 * g4;
#pragma unroll
                for (int t = 0; t < 2; ++t) {
                    float Ac = ex2(lg * (float)(tq - (kt0 + 32 * t) - 4 * h));
#pragma unroll
                    for (int c = 0; c < 4; ++c) {
                        s[t][4 * c] *= Ac; s[t][4 * c + 1] *= Ac * g1; s[t][4 * c + 2] *= Ac * g2; s[t][4 * c + 3] *= Ac * g3;
                        Ac *= g8;
                    }
                }
                if (need_mask) {
#pragma unroll
                    for (int t = 0; t < 2; ++t)
#pragma unroll
                        for (int i = 0; i < 16; ++i)
                            if (kt0 + 32 * t + crow(i, h) > tq) s[t][i] = 0.f;
                }
            }
            __builtin_amdgcn_sched_barrier(0);
            u32x4 vf1[2][DV / 32];
#pragma unroll
            for (int ss = 0; ss < 2; ++ss)
#pragma unroll
                for (int d = 0; d < DV / 32; ++d) {
                    const int vrow = 32 * d + r, vkey = (vrow >> 1) & 7, c0 = 4 + 2 * ss;
                    const u32x2 lo = *(const u32x2*)(Vs + vrow * 128 + ((c0 ^ vkey) * 16) + 8 * h);
                    const u32x2 hi = *(const u32x2*)(Vs + vrow * 128 + (((c0 + 1) ^ vkey) * 16) + 8 * h);
                    vf1[ss][d] = (u32x4){lo.x, lo.y, hi.x, hi.y};
                }
#pragma unroll
            for (int ss = 0; ss < 2; ++ss) {
                u32x4 pk = {pack2(s[0][8 * ss], s[0][8 * ss + 1]), pack2(s[0][8 * ss + 2], s[0][8 * ss + 3]),
                            pack2(s[0][8 * ss + 4], s[0][8 * ss + 5]), pack2(s[0][8 * ss + 6], s[0][8 * ss + 7])};
                const bf16x8 pf = __builtin_bit_cast(bf16x8, pk);
#pragma unroll
                for (int d = 0; d < DV / 32; ++d) o[d] = MFMA(__builtin_bit_cast(bf16x8, vf0[ss][d]), pf, o[d]);
            }
#pragma unroll
            for (int ss = 0; ss < 2; ++ss) {
                u32x4 pk = {pack2(s[1][8 * ss], s[1][8 * ss + 1]), pack2(s[1][8 * ss + 2], s[1][8 * ss + 3]),
                            pack2(s[1][8 * ss + 4], s[1][8 * ss + 5]), pack2(s[1][8 * ss + 6], s[1][8 * ss + 7])};
                const bf16x8 pf = __builtin_bit_cast(bf16x8, pk);
#pragma unroll
                for (int d = 0; d < DV / 32; ++d) o[d] = MFMA(__builtin_bit_cast(bf16x8, vf1[ss][d]), pf, o[d]);
            }
        }
    }
    RAW_BARRIER();
}

template <int DK>
DI void load_q(bf16x8 (&qf)[DK / 16], const bf16_t* qrow, int h) {
#pragma unroll
    for (int kk = 0; kk < DK / 16; ++kk) qf[kk] = *(const bf16x8*)(qrow + 16 * kk + 8 * h);
}

template <int DV>
DI void write_gated(const f32x16 (&o)[DV / 32], float scale, bf16_t* zbase, size_t row, int col0, int h, bool wr = true) {
    if (!wr) {
        float chk = 0.f;
#pragma unroll
        for (int d = 0; d < DV / 32; ++d)
#pragma unroll
            for (int i = 0; i < 16; ++i) chk += o[d][i];
        if (chk * scale == 1.2345e-30f) zbase[0] = 0;
        return;
    }
#pragma unroll
    for (int d = 0; d < DV / 32; ++d)
#pragma unroll
        for (int c4 = 0; c4 < 4; ++c4) {
            bf16_t* zp = zbase + kbm((int)row, col0 + 32 * d + 8 * c4 + 4 * h, NTOK);
            const u32x2 z = *(const u32x2*)zp;
            u32x2 ov = {pack2(o[d][4 * c4] * scale * bflo(z.x), o[d][4 * c4 + 1] * scale * bfhi(z.x)),
                        pack2(o[d][4 * c4 + 2] * scale * bflo(z.y), o[d][4 * c4 + 3] * scale * bfhi(z.y))};
            *(u32x2*)zp = ov;
        }
}

DI u64 range_bits(int lo, int hi) {
    const u64 a = (hi >= 63) ? ~0ull : ((2ull << hi) - 1ull);
    return a & ~((1ull << lo) - 1ull);
}

constexpr int KM_OFF = 65536, MISC_OFF = 69888;
DI void moba_item(const Params& p, char* lds, int b, int hh, int qt, bool wr = true) {
    const int tid = my_tid(), lane = tid & 63, w = tid >> 6, r = lane & 31, h = lane >> 5;
    const bf16_t* bufA = (const bf16_t*)(p.ws + OFF_BUFA);
    const bf16_t* vT = (const bf16_t*)(p.ws + OFF_VT);
    bf16_t* bufZ = (bf16_t*)(p.ws + OFF_BUFZ);
    const float* kmean = (const float*)(p.ws + OFF_KMEAN);
    const int q0w = qt * 128 + w * 32, tq = q0w + r, own = qt >> 1;
    *(f32x4*)(lds + KM_OFF + tid * 16) = *(const f32x4*)(kmean + (size_t)(b * 8 + hh) * 1024 + tid * 4);
    const bf16_t* qrow = bufA + (size_t)(b * SEQ + tq) * NA + CA_MQ + hh * 64;
    bf16x8 qf[4];
    load_q<64>(qf, qrow, h);
    __syncthreads();
    float gh[8];
#pragma unroll
    for (int mI = 0; mI < 8; ++mI) gh[mI] = 0.f;
#pragma unroll
    for (int c = 0; c < 8; ++c) {
        const u32x4 qv = *(const u32x4*)(qrow + 8 * c);
        const float q0 = bflo(qv.x), q1 = bfhi(qv.x), q2 = bflo(qv.y), q3 = bfhi(qv.y), q4 = bflo(qv.z), q5 = bfhi(qv.z), q6 = bflo(qv.w), q7 = bfhi(qv.w);
#pragma unroll
        for (int mI = 0; mI < 8; ++mI) {
            if (2 * mI < own) {
                const float* km = (const float*)(lds + KM_OFF) + (2 * mI + h) * 64 + c * 8;
                const f32x4 k0 = *(const f32x4*)km, k1 = *(const f32x4*)(km + 4);
                gh[mI] += q0 * k0.x + q1 * k0.y + q2 * k0.z + q3 * k0.w + q4 * k1.x + q5 * k1.y + q6 * k1.z + q7 * k1.w;
            }
        }
    }
    float g[16];
#pragma unroll
    for (int mI = 0; mI < 8; ++mI) {
        const float other = xh_other(gh[mI], h);
        g[2 * mI] = h ? other : gh[mI];
        g[2 * mI + 1] = h ? gh[mI] : other;
    }
    unsigned bm = 0;
#pragma unroll
    for (int pass = 0; pass < 3; ++pass) {
        float best = -INFINITY; int bi = -1;
#pragma unroll
        for (int n = 0; n < 15; ++n)
            if (n < own && !((bm >> n) & 1u) && g[n] > best) { best = g[n]; bi = n; }
        if (bi >= 0) bm |= 1u << bi;
    }
    bm |= 1u << own;
    unsigned um = bm;
    um |= __shfl_xor(um, 16, 64); um |= __shfl_xor(um, 8, 64); um |= __shfl_xor(um, 4, 64); um |= __shfl_xor(um, 2, 64); um |= __shfl_xor(um, 1, 64);
    um = __builtin_amdgcn_readfirstlane(um);
    u64 wt = 0;
#pragma unroll
    for (int n = 0; n < 16; ++n) if ((um >> n) & 1u) wt |= 0xFull << (4 * n);
    wt &= range_bits(0, (q0w + 31) >> 6);
    if (lane == 0) *(u64*)(lds + MISC_OFF + 8 * w) = wt;
    __syncthreads();
    const u64 tiles = *(const u64*)(lds + MISC_OFF) | *(const u64*)(lds + MISC_OFF + 8) | *(const u64*)(lds + MISC_OFF + 16) | *(const u64*)(lds + MISC_OFF + 24);
    f32x16 o[2]; o[0] = zero16(); o[1] = zero16();
    float m = -1e30f, l = 0.f;
    flash<64, 64, FM_MOBA>(lds, qf, bufA + (size_t)b * SEQ * NA + CA_MK + hh * 64, NA, vT + ((size_t)b * NVT + CV_MV + hh * 64) * SEQ, SEQ,
                           tiles, wt, tq, (u64)bm, 0.125f * LOG2E, 0.f, o, m, l);
    l = xh_sum(l);
    const float inv = l > 0.f ? 1.f / l : 0.f;
    write_gated<64>(o, inv, bufZ, (size_t)(b * SEQ + tq), 0 + hh * 64, h, wr);
}

constexpr int PART_OFF = 36864, SELM_OFF = 69632;
DI void nsa_item(const Params& p, char* lds, int b, int g, int qt32, bool wr = true) {
    const int tid = my_tid(), lane = tid & 63, w = tid >> 6, r = lane & 31, h = lane >> 5;
    const bf16_t* bufA = (const bf16_t*)(p.ws + OFF_BUFA);
    const bf16_t* vT = (const bf16_t*)(p.ws + OFF_VT);
    bf16_t* bufZ = (bf16_t*)(p.ws + OFF_BUFZ);
    const bf16_t* kc = (const bf16_t*)(p.ws + OFF_KC) + (size_t)(b * 2 + g) * 256 * 64;
    const bf16_t* vcT = (const bf16_t*)(p.ws + OFF_VCT) + (size_t)(b * 2 + g) * 64 * 256;
    const int q0 = qt32 * 32, tq = q0 + r, hq = g * 4 + w;
    const size_t tokrow = (size_t)(b * SEQ + tq);
    const bf16_t* qrow = bufA + tokrow * NA + CA_NQ + hq * 64;
    bf16x8 qf[4];
    load_q<64>(qf, qrow, h);
    const float sc = 0.125f * LOG2E;
    const bf16_t* gp = bufA + tokrow * NA + CA_GATE + hq * 3;
    const float g_cmp = bf2f(gp[0]), g_slc = bf2f(gp[1]), g_win = bf2f(gp[2]);
    f32x16 tot[2]; tot[0] = zero16(); tot[1] = zero16();
    const int ncmp_tiles = ((q0 >> 4) >> 6) + 1;
    const u64 ctiles = range_bits(0, ncmp_tiles - 1);
    float m = -1e30f, l = 0.f;
    {
        f32x16 o[2]; o[0] = zero16(); o[1] = zero16();
        flash<64, 64, FM_CMP>(lds, qf, kc, 64, vcT, 256, ctiles, ctiles, tq, 0ull, sc, 0.f, o, m, l);
        l = xh_sum(l);
        const float inv = l > 0.f ? 1.f / l : 0.f;
        l = inv;
#pragma unroll
        for (int d = 0; d < 2; ++d)
#pragma unroll
            for (int i = 0; i < 16; ++i) tot[d][i] = o[d][i] * (inv * g_cmp);
    }
#ifndef REP_IMP
#define REP_IMP 1
#endif
    for (int rimp = 0; rimp < REP_IMP; ++rimp) {
        float* part = (float*)(lds + w * 16384 + 8192) + r * 64;
#pragma unroll
        for (int j = 0; j < 32; ++j) part[2 * j + h] = 0.f;
        float prev = 0.f;
#pragma unroll 1
        for (int t4 = 0; t4 < ncmp_tiles; ++t4) {
#pragma unroll
            for (int t = 0; t < 2; ++t) {
                f32x16 s = zero16();
#pragma unroll
                for (int kk = 0; kk < 4; ++kk) {
                    const int krow = 32 * t + r;
                    const bf16x8 kf = *(const bf16x8*)(lds + t4 * 16384 + krow * 128 + (((2 * kk + h) ^ ((krow >> 1) & 7)) * 16));
                    s = MFMA(kf, qf[kk], s);
                }
                const int T = 2 * t4 + t;
#pragma unroll
                for (int c = 0; c < 4; ++c) {
                    float pv[4];
#pragma unroll
                    for (int e = 0; e < 4; ++e) {
                        const int key = 32 * T + 8 * c + 4 * h + e;
                        pv[e] = ((16 * key + 31) <= tq) ? ex2(s[4 * c + e] * sc - m) * l : 0.f;
                    }
                    const float A = 2.f * (pv[0] + pv[1] + pv[2]) + pv[3];
                    const float xch = xh_other(pv[3], h);
                    const float add = h ? xch : prev;
                    prev = xch;
                    part[8 * T + 2 * c + h] = A + add;
                }
            }
        }
        __syncthreads();
        const float* pbase = (const float*)(lds + 8192);
#ifndef REP_TOPK
#define REP_TOPK 1
#endif
#pragma unroll 1
        for (int rtk = 0; rtk < REP_TOPK; ++rtk)
#pragma unroll 1
        for (int qq = 8 * w; qq < 8 * w + 8; ++qq) {
            float v = pbase[qq * 64 + lane] + pbase[4096 + qq * 64 + lane] + pbase[2 * 4096 + qq * 64 + lane] + pbase[3 * 4096 + qq * 64 + lane];
            const int own = (q0 + qq) >> 6;
            if (lane == 0 || lane == own || lane == own - 1) v = INFINITY;
            if (lane > own) v = -INFINITY;
            const unsigned key = (v > 0.f) ? __float_as_uint(v) : 0u;
            unsigned T = 0u;
#pragma unroll
            for (int bit = 30; bit >= 0; --bit) {
                const unsigned cand = T | (1u << bit);
                const int cnt = __builtin_popcountll(__ballot(key >= cand));
                T = (cnt >= 16) ? cand : T;
            }
            u64 selm = __ballot(key > T), E = __ballot(key == T);
            int need = 16 - __builtin_popcountll(selm);
            while (need > 0 && E != 0ull) { const u64 low = E & (0ull - E); selm |= low; E ^= low; --need; }
            if (lane == 0) *(u64*)(lds + SELM_OFF + qq * 8) = selm;
        }
        __syncthreads();
    }
    const u64 sel = *(const u64*)(lds + SELM_OFF + r * 8);
    {
        unsigned ulo = (unsigned)sel, uhi = (unsigned)(sel >> 32);
#pragma unroll
        for (int off = 16; off >= 1; off >>= 1) { ulo |= __shfl_xor(ulo, off, 64); uhi |= __shfl_xor(uhi, off, 64); }
        ulo = __builtin_amdgcn_readfirstlane(ulo); uhi = __builtin_amdgcn_readfirstlane(uhi);
        const u64 stiles = (((u64)uhi << 32) | ulo) & range_bits(0, (q0 + 31) >> 6);
        f32x16 o[2]; o[0] = zero16(); o[1] = zero16();
        float m2 = -1e30f, l2 = 0.f;
        flash<64, 64, FM_SLC>(lds, qf, bufA + (size_t)b * SEQ * NA + CA_NKS + g * 64, NA, vT + ((size_t)b * NVT + CV_NVS + g * 64) * SEQ, SEQ,
                              stiles, stiles, tq, sel, sc, 0.f, o, m2, l2);
        l2 = xh_sum(l2);
        const float inv = l2 > 0.f ? 1.f / l2 : 0.f;
#pragma unroll
        for (int d = 0; d < 2; ++d)
#pragma unroll
            for (int i = 0; i < 16; ++i) tot[d][i] += o[d][i] * (inv * g_slc);
    }
    {
        const int lo = (q0 >= 511 ? (q0 - 511) : 0) >> 6;
        const u64 wtl = range_bits(lo, (q0 + 31) >> 6);
        f32x16 o[2]; o[0] = zero16(); o[1] = zero16();
        float m3 = -1e30f, l3 = 0.f;
        flash<64, 64, FM_WIN>(lds, qf, bufA + (size_t)b * SEQ * NA + CA_NKW + g * 64, NA, vT + ((size_t)b * NVT + CV_NVW + g * 64) * SEQ, SEQ,
                              wtl, wtl, tq, 0ull, sc, 0.f, o, m3, l3);
        l3 = xh_sum(l3);
        const float inv = l3 > 0.f ? 1.f / l3 : 0.f;
#pragma unroll
        for (int d = 0; d < 2; ++d)
#pragma unroll
            for (int i = 0; i < 16; ++i) tot[d][i] += o[d][i] * (inv * g_win);
    }
    write_gated<64>(tot, 1.f, bufZ, tokrow, 512 + hq * 64, h, wr);
}

DI void ret_item(const Params& p, char* lds, int layer, int b, int hh, int qt, bool wr = true) {
    const int tid = my_tid(), lane = tid & 63, w = tid >> 6, r = lane & 31, h = lane >> 5;
    const bf16_t* bufA = (const bf16_t*)(p.ws + OFF_BUFA);
    const bf16_t* vT = (const bf16_t*)(p.ws + OFF_VT);
    bf16_t* bufZ = (bf16_t*)(p.ws + OFF_BUFZ);
    const int q0b = qt * 128, q0w = q0b + w * 32, tq = q0w + r;
    const size_t tokrow = (size_t)(b * SEQ + tq);
    bf16x8 qf[4];
    load_q<64>(qf, bufA + tokrow * NA + CA_RQ + hh * 64, h);
    const float lg = ret_lg(hh);
    const int c = qt;
    constexpr int ST_OFF = 49152;
    {
        const int nch = (hh == 0) ? 5 : (hh == 1 ? 9 : (hh == 2 ? 17 : 31));
        const int nprev = c < nch ? c : nch;
        const int dv = tid >> 1, d0 = (tid & 1) * 32;
        const bf16_t* up = (const bf16_t*)(p.ws + OFF_U) + ((size_t)(b * 4 + hh) * 32) * 8192 + tid * 32;
        const float dec = ex2(lg * 128.f);
        f32x4 a[8];
#pragma unroll
        for (int q = 0; q < 8; ++q) a[q] = (f32x4){0.f, 0.f, 0.f, 0.f};
        float f = 1.f;
#pragma unroll 1
        for (int k = 0; k < nprev; k += 4) {
            u32x4 raw[4][4];
#pragma unroll
            for (int kk = 0; kk < 4; ++kk) {
                const int cp = (k + kk < nprev) ? (c - 1 - k - kk) : 0;
                const bf16_t* src = up + (size_t)cp * 8192;
#pragma unroll
                for (int q = 0; q < 4; ++q) raw[kk][q] = *(const u32x4*)(src + 8 * q);
            }
#pragma unroll
            for (int kk = 0; kk < 4; ++kk) {
                const float fw = (k + kk < nprev) ? f : 0.f;
#pragma unroll
                for (int q = 0; q < 4; ++q) {
                    const u32x4 rv = raw[kk][q];
                    a[2 * q] += (f32x4){bflo(rv.x), bfhi(rv.x), bflo(rv.y), bfhi(rv.y)} * fw;
                    a[2 * q + 1] += (f32x4){bflo(rv.z), bfhi(rv.z), bflo(rv.w), bfhi(rv.w)} * fw;
                }
                f *= dec;
            }
        }
#pragma unroll
        for (int q = 0; q < 4; ++q) {
            u32x4 pk = {pack2(a[2 * q].x, a[2 * q].y), pack2(a[2 * q].z, a[2 * q].w), pack2(a[2 * q + 1].x, a[2 * q + 1].y), pack2(a[2 * q + 1].z, a[2 * q + 1].w)};
            const int cidx = (d0 >> 3) + q;
            *(u32x4*)(lds + ST_OFF + dv * 128 + ((cidx ^ ((dv >> 1) & 7)) * 16)) = pk;
        }
    }
    __syncthreads();
    f32x16 o[4];
#pragma unroll
    for (int d = 0; d < 4; ++d) o[d] = zero16();
    if (c > 0) {
        const float cross = ex2(lg * (float)((tq & 127) + 1));
        const bf16_t* qrow = bufA + tokrow * NA + CA_RQ + hh * 64;
#pragma unroll
        for (int t = 0; t < 2; ++t)
#pragma unroll
            for (int ss = 0; ss < 2; ++ss) {
                const int dq = 32 * t + 16 * ss + 4 * h;
                const u32x2 qa = *(const u32x2*)(qrow + dq), qb = *(const u32x2*)(qrow + dq + 8);
                u32x4 pk = {pack2(bflo(qa.x) * cross, bfhi(qa.x) * cross), pack2(bflo(qa.y) * cross, bfhi(qa.y) * cross),
                            pack2(bflo(qb.x) * cross, bfhi(qb.x) * cross), pack2(bflo(qb.y) * cross, bfhi(qb.y) * cross)};
                const bf16x8 pf = __builtin_bit_cast(bf16x8, pk);
#pragma unroll
                for (int d = 0; d < 4; ++d) {
                    const int vrow = 32 * d + r, vkey = (vrow >> 1) & 7, c0 = 4 * t + 2 * ss;
                    const u32x2 lo2 = *(const u32x2*)(lds + ST_OFF + vrow * 128 + ((c0 ^ vkey) * 16) + 8 * h);
                    const u32x2 hi2 = *(const u32x2*)(lds + ST_OFF + vrow * 128 + (((c0 + 1) ^ vkey) * 16) + 8 * h);
                    u32x4 vv = {lo2.x, lo2.y, hi2.x, hi2.y};
                    o[d] = MFMA(__builtin_bit_cast(bf16x8, vv), pf, o[d]);
                }
            }
    }
    const u64 tiles = range_bits(2 * c, 2 * c + 1);
    const u64 wt = range_bits(2 * c, (q0w + 31) >> 6);
    float m = 0.f, l = 0.f;
    flash<64, 128, FM_RET>(lds, qf, bufA + (size_t)b * SEQ * NA + CA_RK + hh * 64, NA, vT + ((size_t)b * NVT + CV_RV + hh * 128) * SEQ, SEQ,
                           tiles, wt, tq, 0ull, ex2(-lg), lg, o, m, l, 2);
    float sm = 0.f;
#pragma unroll
    for (int d = 0; d < 4; ++d)
#pragma unroll
        for (int i = 0; i < 16; ++i) sm += o[d][i];
    sm = xh_sum(sm);
    const float mu = sm * (1.f / 128.f);
    float sq = 0.f;
#pragma unroll
    for (int d = 0; d < 4; ++d)
#pragma unroll
        for (int i = 0; i < 16; ++i) { const float c = o[d][i] - mu; o[d][i] = c; sq += c * c; }
    sq = xh_sum(sq);
    const float rs = rsqrtf(sq * (1.f / 128.f) + EPS);
    const float* gn = p.gn_g + layer * 512 + hh * 128;
#pragma unroll
    for (int d = 0; d < 4; ++d)
#pragma unroll
        for (int c4 = 0; c4 < 4; ++c4) {
            const f32x4 gv = *(const f32x4*)(gn + 32 * d + 8 * c4 + 4 * h);
            o[d][4 * c4] *= gv.x; o[d][4 * c4 + 1] *= gv.y; o[d][4 * c4 + 2] *= gv.z; o[d][4 * c4 + 3] *= gv.w;
        }
    write_gated<128>(o, rs, bufZ, tokrow, 1024 + hh * 128, h, wr);
}

DI void mem_item(const Params& p, char* lds, int b, int hh, int qt, bool wr = true) {
    const int tid = my_tid(), lane = tid & 63, w = tid >> 6, r = lane & 31, h = lane >> 5;
    const bf16_t* bufA = (const bf16_t*)(p.ws + OFF_BUFA);
    bf16_t* bufZ = (bf16_t*)(p.ws + OFF_BUFZ);
    const bf16_t* memK = (const bf16_t*)(p.ws + OFF_MEMK);
    const bf16_t* memVT = (const bf16_t*)(p.ws + OFF_MEMV);
    const int tq = qt * 128 + w * 32 + r;
    const size_t tokrow = (size_t)(b * SEQ + tq);
    bf16x8 qf[8];
    load_q<128>(qf, bufA + tokrow * NA + CA_CQ + hh * 128, h);
    f32x16 o[4];
#pragma unroll
    for (int d = 0; d < 4; ++d) o[d] = zero16();
    float m = -1e30f, l = 0.f;
    flash<128, 128, FM_NONE>(lds, qf, memK + (size_t)b * 256 * 512 + hh * 128, 512, memVT + ((size_t)b * 512 + hh * 128) * 256, 256,
                             0xFull, 0xFull, tq, 0ull, 0.08838834764831845f * LOG2E, 0.f, o, m, l);
    l = xh_sum(l);
    const float inv = l > 0.f ? 1.f / l : 0.f;
    write_gated<128>(o, inv, bufZ, tokrow, 1536 + hh * 128, h, wr);
}

DI void conv_w(const float* __restrict__ W, int ldw, bf16_t* __restrict__ WT, int K, int Ndst, bool mapped, long gtid, long gthreads, bool blocked = false) {
    const long total = (long)Ndst * (K / 8);
    for (long idx = gtid; idx < total; idx += gthreads) {
        const int n = (int)(idx % Ndst), kc = (int)(idx / Ndst);
        const int src = mapped ? in_col_src(n) : n;
        u32x4 o = {0u, 0u, 0u, 0u};
        if (src >= 0) {
            float v[8];
#pragma unroll
            for (int j = 0; j < 8; ++j) v[j] = W[(size_t)(kc * 8 + j) * ldw + src];
            o.x = pack2(v[0], v[1]); o.y = pack2(v[2], v[3]); o.z = pack2(v[4], v[5]); o.w = pack2(v[6], v[7]);
        }
        *(u32x4*)(WT + (blocked ? kbm(n, kc * 8, Ndst) : (size_t)n * K + kc * 8)) = o;
    }
}
DI void conv_layer_weights(const Params& p, int layer, long gtid, long gthreads) {
    conv_w(p.w_in + (size_t)layer * 1024 * 6424, 6424, (bf16_t*)(p.ws + OFF_WIN), 1024, NIN, true, gtid, gthreads, true);
    conv_w(p.w_out + (size_t)layer * 2048 * 1024, 1024, (bf16_t*)(p.ws + OFF_WOUT), 2048, 1024, false, gtid, gthreads, true);
    conv_w(p.w_mem + (size_t)layer * 1024 * 1024, 1024, (bf16_t*)(p.ws + OFF_WMEM), 1024, 1024, false, gtid, gthreads);
    conv_w(p.w1_k + (size_t)layer * 2048 * 128, 128, (bf16_t*)(p.ws + OFF_W1K), 2048, 128, false, gtid, gthreads);
    conv_w(p.w1_v + (size_t)layer * 2048 * 128, 128, (bf16_t*)(p.ws + OFF_W1V), 2048, 128, false, gtid, gthreads);
}
DI void cmp_bias(const Params& p, int layer, char* lds) {
    const int bb = blockIdx.x;
    if (bb >= 32) return;
    const int which = bb >> 4, pt = bb & 15;
    const float* pe = (which ? p.pe_v : p.pe_k) + (size_t)layer * 2048;
    const float* w1 = (which ? p.w1_v : p.w1_k) + (size_t)layer * 2048 * 128;
    float* part = (float*)(p.ws + OFF_BIAS) + (which * 16 + pt) * 128;
    const int tid = my_tid(), j = tid & 127, half = tid >> 7;
    float s0 = 0.f, s1 = 0.f, s2 = 0.f, s3 = 0.f;
    const int kb = pt * 128 + half * 64;
#pragma unroll 4
    for (int k = kb; k < kb + 64; k += 4) {
        s0 += pe[k] * w1[(size_t)k * 128 + j];
        s1 += pe[k + 1] * w1[(size_t)(k + 1) * 128 + j];
        s2 += pe[k + 2] * w1[(size_t)(k + 2) * 128 + j];
        s3 += pe[k + 3] * w1[(size_t)(k + 3) * 128 + j];
    }
    float* red = (float*)lds;
    red[tid] = (s0 + s1) + (s2 + s3);
    __syncthreads();
    if (tid < 128) part[tid] = red[tid] + red[tid + 128];
    __syncthreads();
}
DI void rms_rows(const float* __restrict__ X, const float* __restrict__ g, bf16_t* __restrict__ H, int nrows, bool blocked) {
    const int lane = my_tid() & 63, w = my_tid() >> 6;
    for (int row = blockIdx.x * 4 + w; row < nrows; row += gridDim.x * 4) {
        const float* xr = X + (size_t)row * DM;
        f32x4 v[4];
        float ss = 0.f;
#pragma unroll
        for (int j = 0; j < 4; ++j) { v[j] = *(const f32x4*)(xr + lane * 4 + 256 * j); ss += v[j].x * v[j].x + v[j].y * v[j].y + v[j].z * v[j].z + v[j].w * v[j].w; }
        ss = wave_sum(ss);
        const float rs = rsqrtf(ss * (1.f / DM) + EPS);
#pragma unroll
        for (int j = 0; j < 4; ++j) {
            const f32x4 gv = *(const f32x4*)(g + lane * 4 + 256 * j);
            u32x2 o = {pack2(v[j].x * rs * gv.x, v[j].y * rs * gv.y), pack2(v[j].z * rs * gv.z, v[j].w * rs * gv.w)};
            *(u32x2*)(H + (blocked ? kbm(row, lane * 4 + 256 * j, nrows) : (size_t)row * DM + lane * 4 + 256 * j)) = o;
        }
    }
}
DI void resid_rows(const float* __restrict__ Xold, const bf16_t* __restrict__ Y, const float* __restrict__ pg, float* __restrict__ Out,
                   const float* __restrict__ g_next, bf16_t* __restrict__ H) {
    const int lane = my_tid() & 63, w = my_tid() >> 6;
    for (int row = blockIdx.x * 4 + w; row < NTOK; row += gridDim.x * 4) {
        const bf16_t* yr = Y + (size_t)row * DM;
        const float* xr = Xold + (size_t)row * DM;
        f32x4 v[4], xv[4];
        float ss = 0.f;
#pragma unroll
        for (int j = 0; j < 4; ++j) { const u32x2 yy = *(const u32x2*)(yr + lane * 4 + 256 * j); v[j] = (f32x4){bflo(yy.x), bfhi(yy.x), bflo(yy.y), bfhi(yy.y)}; xv[j] = *(const f32x4*)(xr + lane * 4 + 256 * j); ss += v[j].x * v[j].x + v[j].y * v[j].y + v[j].z * v[j].z + v[j].w * v[j].w; }
        ss = wave_sum(ss);
        const float rs = rsqrtf(ss * (1.f / DM) + EPS);
        float s2 = 0.f;
#pragma unroll
        for (int j = 0; j < 4; ++j) {
            const f32x4 gv = *(const f32x4*)(pg + lane * 4 + 256 * j);
            xv[j].x += v[j].x * rs * gv.x; xv[j].y += v[j].y * rs * gv.y; xv[j].z += v[j].z * rs * gv.z; xv[j].w += v[j].w * rs * gv.w;
            *(f32x4*)(Out + (size_t)row * DM + lane * 4 + 256 * j) = xv[j];
            s2 += xv[j].x * xv[j].x + xv[j].y * xv[j].y + xv[j].z * xv[j].z + xv[j].w * xv[j].w;
        }
        if (g_next) {
            s2 = wave_sum(s2);
            const float r2 = rsqrtf(s2 * (1.f / DM) + EPS);
#pragma unroll
            for (int j = 0; j < 4; ++j) {
                const f32x4 gv = *(const f32x4*)(g_next + lane * 4 + 256 * j);
                u32x2 o = {pack2(xv[j].x * r2 * gv.x, xv[j].y * r2 * gv.y), pack2(xv[j].z * r2 * gv.z, xv[j].w * r2 * gv.w)};
                *(u32x2*)(H + kbm(row, lane * 4 + 256 * j, NTOK)) = o;
            }
        }
    }
}
DI void rope_table(const Params& p, long gtid, long gthreads) {
    f32x2* tab = (f32x2*)(p.ws + OFF_ROPE);
    for (long idx = gtid; idx < (long)SEQ * 32; idx += gthreads) {
        const int s = (int)(idx >> 5), i = (int)(idx & 31);
        const float invf = (float)(1.0 / pow(10000.0, (double)i / 31.0));
        const float ang = (float)s * invf;
        const double a = (double)ang;
        const double k = rint(a * 0.15915494309189535);
        const float rr = (float)(a - k * 6.283185307179586);
        f32x2 cs = {cosf(rr), sinf(rr)};
        tab[idx] = cs;
    }
}

#define XB_TMO      128
#define XB_XCNT(j)  (256  + 64 * (j))
#define XB_XSUB(j)  (1280 + 64 * (j))
#define XB_XGEN(j)  (2304 + 64 * (j))
#define XB_TOP      3328
#define XB_TOPGEN   3392
#define XCD_BAR_WORDS 3456
#define XB_SPIN_CAP (1u << 18)
#define LAS __attribute__((address_space(3)))
DI unsigned xb_ld(unsigned* p) { return __hip_atomic_load(p, __ATOMIC_RELAXED, __HIP_MEMORY_SCOPE_AGENT); }
DI unsigned xb_add(unsigned* p, unsigned v) { return __hip_atomic_fetch_add(p, v, __ATOMIC_RELAXED, __HIP_MEMORY_SCOPE_AGENT); }
DI unsigned xb_xcc_id() { return (unsigned)__builtin_amdgcn_s_getreg((3 << 11) | 20) & 0xFu; }
#define XB_SPIN(cond, bar) do { unsigned _sp = 0; while (cond) { __builtin_amdgcn_s_sleep(1); \
    if ((++_sp & 255u) == 0u) { if (xb_ld(&(bar)[XB_TMO])) break; if (_sp > XB_SPIN_CAP) { atomicAdd(&(bar)[XB_TMO], 1u); break; } } } } while (0)
struct XcdBarrier { unsigned* bar; unsigned x; volatile LAS unsigned* st; };
DI XcdBarrier xcd_barrier_post(unsigned* bar, volatile LAS unsigned* st) {
    XcdBarrier b; b.bar = bar; b.x = xb_xcc_id(); b.st = st;
    if (threadIdx.x == 0) (void)xb_add(&bar[XB_XCNT(b.x)], 1u);
    return b;
}
DI void xcd_barrier_complete(unsigned* bar, unsigned x, unsigned& nloc, unsigned& nx) {
    const unsigned G = gridDim.x * gridDim.y * gridDim.z;
    unsigned sum, cnt, mine, sp = 0u;
    for (;;) {
        sum = 0u; cnt = 0u; mine = 0u;
#pragma unroll
        for (unsigned j = 0; j < 16; ++j) { const unsigned c = xb_ld(&bar[XB_XCNT(j)]); sum += c; cnt += (c > 0u) ? 1u : 0u; mine = (j == x) ? c : mine; }
        if (sum == G) break;
        __builtin_amdgcn_s_sleep(1);
        if ((++sp & 255u) == 0u) { if (xb_ld(&bar[XB_TMO])) break; if (sp > XB_SPIN_CAP) { atomicAdd(&bar[XB_TMO], 1u); break; } }
    }
    nloc = mine > 0u ? mine : 1u; nx = cnt > 0u ? cnt : 1u;
}
DI void xcd_barrier(const XcdBarrier& b) {
    asm volatile("s_waitcnt vmcnt(0)" ::: "memory");
    __syncthreads();
    if (threadIdx.x == 0) {
        unsigned* bar = b.bar;
        __builtin_amdgcn_s_waitcnt(0);
        unsigned nloc = b.st[0], nx = b.st[1];
        if (nloc == 0u) { xcd_barrier_complete(bar, b.x, nloc, nx); b.st[0] = nloc; b.st[1] = nx; }
        const unsigned old = xb_add(&bar[XB_XSUB(b.x)], 1u);
        const unsigned gen = old / nloc;
        if (old + 1u == (gen + 1u) * nloc) {
            __builtin_amdgcn_fence(__ATOMIC_RELEASE, "agent");
            asm volatile("s_waitcnt vmcnt(0)" ::: "memory");
            const unsigned og = xb_add(&bar[XB_TOP], 1u);
            const unsigned tg = og / nx;
            if (og + 1u == (tg + 1u) * nx) xb_add(&bar[XB_TOPGEN], 1u);
            else XB_SPIN(xb_ld(&bar[XB_TOPGEN]) == tg, bar);
            __builtin_amdgcn_fence(__ATOMIC_ACQUIRE, "agent");
            xb_add(&bar[XB_XGEN(b.x)], 1u);
            asm volatile("s_waitcnt vmcnt(0)" ::: "memory");
        } else {
            XB_SPIN(xb_ld(&bar[XB_XGEN(b.x)]) == gen, bar);
            __builtin_amdgcn_fence(__ATOMIC_ACQUIRE, "agent");
            asm volatile("s_waitcnt vmcnt(0)" ::: "memory");
        }
    }
    __syncthreads();
}

__global__ __launch_bounds__(256, 2) void mega(Params p) {
    __shared__ __attribute__((aligned(16))) char lds[LDS_BYTES];
    __shared__ int s_item;
    __shared__ float s_bias[128];
    cg::grid_group grid = cg::this_grid();
    __shared__ uint4 xb_words;
    if (threadIdx.x == 0) xb_words = make_uint4(0u, 0u, 0u, 0u);
    __syncthreads();
    const XcdBarrier xb = xcd_barrier_post((unsigned*)(p.ws + OFF_BAR), (volatile LAS unsigned*)&xb_words);
#define GTID ((long)blockIdx.x * 256 + my_tid())
#define GTHREADS ((long)gridDim.x * 256)
    bf16_t* hbuf = (bf16_t*)(p.ws + OFF_H);
    unsigned* ctr = (unsigned*)(p.ws + OFF_CTR);

    if (GTID < 256) ctr[GTID] = 0u;
    for (int r0 = 0; r0 < REP0; ++r0) {
#ifndef SKIP_CONV
    conv_layer_weights(p, 0, GTID, GTHREADS);
#endif
    rope_table(p, GTID, GTHREADS);
#ifndef SKIP_BIAS
    cmp_bias(p, 0, lds);
#endif
    rms_rows(p.x, p.pre_g, hbuf, NTOK, true);
    rms_rows(p.mem, p.mem_g, (bf16_t*)(p.ws + OFF_MEMN), 2048, false);
    if (p.ws == nullptr) grid.sync();
    xcd_barrier(xb);
    }

#ifdef EXTRA_SYNCS
    for (int es = 0; es < EXTRA_SYNCS; ++es) grid.sync();
#endif
#pragma unroll 1
    for (int layer = 0; layer < 2; ++layer) {
        for (int r123 = 0; r123 < REP123; ++r123) {
        for (int r1 = 0; r1 < REP1; ++r1) {
#ifndef SKIP_P1
        {
            const bf16_t* winT = (const bf16_t*)(p.ws + OFF_WIN);
            const f32x2* rope = (const f32x2*)(p.ws + OFF_ROPE);
            const int xcd = blockIdx.x & 7, li = blockIdx.x >> 3, nb = (gridDim.x + 7 - xcd) >> 3;
#pragma unroll 1
            for (int q = li; q < 832; q += nb) {
                const int q1 = q / 208, q2 = q - q1 * 208;
                int nt, ml;
                if (q2 < 192) { const int ng = q2 >> 6, in = q2 & 63; nt = 8 * ng + (in & 7); ml = in >> 3; }
                else { const int q3 = q2 - 192; nt = 24 + (q3 & 1); ml = q3 >> 1; }
                const int mt = 32 * xcd + 8 * q1 + ml;
                const bf16_t* A = hbuf + (size_t)mt * 128 * 32;
                const bf16_t* Bt = winT + (size_t)nt * 256 * 32;
                if (nt >= 12 && nt < 17) {
                    EpiVT e{(bf16_t*)(p.ws + OFF_VT), NVT, SEQ, mt * 128, nt * 256 - 3072};
                    gemm_wide<false>(lds, A, ARowLin{32}, Bt, 32, 16, e, (long)NTOK * 32, (long)NIN * 32);
                } else {
                    EpiRow e;
                    e.rope = rope; e.row0 = mt * 128;
                    if (nt < 12) { e.dst = (bf16_t*)(p.ws + OFF_BUFA); e.ld = NA; e.col0 = nt * 256; e.mode = (nt == 8) ? EM_ROPEQ : ((nt == 9) ? EM_ROPEK : EM_PLAIN); e.rkt = (nt == 9) ? (bf16_t*)(p.ws + OFF_RKT) : nullptr; }
                    else if (nt < 25) { e.dst = (bf16_t*)(p.ws + OFF_BUFZ); e.ld = NZ; e.col0 = (nt - 17) * 256; e.mode = EM_SILU; e.zblk = true; }
                    else { e.dst = (bf16_t*)(p.ws + OFF_BUFA); e.ld = NA; e.col0 = CA_GATE; e.mode = EM_GATE; }
                    gemm_wide<true>(lds, A, ARowLin{32}, Bt, 32, 16, e, (long)NTOK * 32, (long)NIN * 32);
                }
            }
        }
#endif
        xcd_barrier(xb);
        }
        for (int r2 = 0; r2 < REP2; ++r2) {
#ifndef SKIP_P2
        {
            const bf16_t* bufA = (const bf16_t*)(p.ws + OFF_BUFA);
            float* kmean = (float*)(p.ws + OFF_KMEAN);
            const int n_km = 8 * 16 * 4, n_cmp = 256, n_mem = 16 * 4, n_u = 8 * 4 * 32;
#pragma unroll 1
            for (int t = blockIdx.x; t < n_cmp + n_km + n_mem + n_u; t += gridDim.x) {
                if (t >= n_cmp + n_km + n_mem) {
                    const int u = t - (n_cmp + n_km + n_mem), c = u & 31, bh = u >> 5, b = bh >> 2, hh = bh & 3;
                    const int tid = my_tid(), lane = tid & 63, w = tid >> 6, r = lane & 31, h = lane >> 5;
                    const bf16_t* vtp = (const bf16_t*)(p.ws + OFF_VT) + ((size_t)b * NVT + CV_RV + hh * 128 + 32 * w + r) * SEQ + c * 128 + 8 * h;
                    const bf16_t* ktp = (const bf16_t*)(p.ws + OFF_RKT) + ((size_t)(b * 4 + hh) * 64 + r) * SEQ + c * 128 + 8 * h;
                    f32x16 u0 = zero16(), u1 = zero16();
#pragma unroll
                    for (int kk = 0; kk < 8; ++kk) {
                        const bf16x8 xf = *(const bf16x8*)(vtp + 16 * kk);
                        const bf16x8 y0 = *(const bf16x8*)(ktp + 16 * kk), y1 = *(const bf16x8*)(ktp + (size_t)32 * SEQ + 16 * kk);
                        u0 = MFMA(xf, y0, u0); u1 = MFMA(xf, y1, u1);
                    }
                    bf16_t* up = (bf16_t*)(p.ws + OFF_U) + (size_t)u * 8192;
#pragma unroll
                    for (int i = 0; i < 16; ++i) {
                        up[(32 * w + crow(i, h)) * 64 + r] = (bf16_t)(pack2(u0[i], 0.f) & 0xffffu);
                        up[(32 * w + crow(i, h)) * 64 + 32 + r] = (bf16_t)(pack2(u1[i], 0.f) & 0xffffu);
                    }
                } else if (t >= n_cmp + n_km) {
                    const int u = t - n_cmp - n_km, mt = u >> 2, nt = u & 3;
                    const bf16_t* A = (const bf16_t*)(p.ws + OFF_MEMN) + (size_t)mt * 128 * 1024;
                    const bf16_t* Bt = (const bf16_t*)(p.ws + OFF_WMEM) + (size_t)nt * 256 * 1024;
                    if (nt >= 2) {
                        EpiVT e{(bf16_t*)(p.ws + OFF_MEMV), 512, 256, mt * 128, nt * 256 - 512};
                        gemm_wide<false>(lds, A, ARowLin{1024}, Bt, 1024, 16, e);
                    } else {
                        EpiRow e; e.rope = nullptr; e.row0 = mt * 128; e.dst = (bf16_t*)(p.ws + OFF_MEMK); e.ld = 512; e.col0 = nt * 256; e.mode = EM_PLAIN;
                        gemm_wide<true>(lds, A, ARowLin{1024}, Bt, 1024, 16, e);
                    }
                } else if (t < n_cmp) {
                    const int tileid = t >> 2, split = t & 3, isv = tileid >> 5, mt = tileid & 31;
                    float* cpart = (float*)(p.ws + OFF_CPART) + (size_t)tileid * 4 * 64 * 256;
                    {
                        EpiPart ep{cpart + (size_t)split * 64 * 256};
                        gemm_tile<true>(lds, bufA + (size_t)split * 8 * NA, ARowCmp{mt * 128, isv ? CA_NVC : CA_NKC}, NA,
                                        (const bf16_t*)(p.ws + (isv ? OFF_W1V : OFF_W1K)) + split * 512, 2048, 8, ep);
                    }
                    __threadfence();
                    __syncthreads();
                    if (my_tid() == 0) s_item = (int)atomicAdd(ctr + 64 + layer * 64 + tileid, 1u);
                    __syncthreads();
                    const bool last = (s_item == 3);
                    __syncthreads();
                    if (!last) continue;
                    __threadfence();
                    float* lbias = s_bias;
                    if (my_tid() < 128) {
                        const float* part = (const float*)(p.ws + OFF_BIAS) + isv * 16 * 128 + my_tid();
                        float bsum = 0.f;
#pragma unroll
                        for (int q = 0; q < 16; ++q) bsum += part[q * 128];
                        lbias[my_tid()] = bsum;
                    }
                    __syncthreads();
                    {
                        const int tid2 = my_tid(), row = tid2 >> 1, c0 = (tid2 & 1) * 64;
                        const float* pp = cpart + row * 128 + c0;
#pragma unroll 4
                        for (int cg = 0; cg < 16; ++cg) {
                            const f32x4 a0 = *(const f32x4*)(pp + cg * 4), a1 = *(const f32x4*)(pp + 16384 + cg * 4);
                            const f32x4 a2 = *(const f32x4*)(pp + 2 * 16384 + cg * 4), a3 = *(const f32x4*)(pp + 3 * 16384 + cg * 4);
                            const f32x4 sm = ((a0 + a1) + a2) + a3;
                            const f32x4 bv = *(const f32x4*)(lbias + c0 + cg * 4);
                            u32x2 o = {pack2(silu_f(sm.x + bv.x), silu_f(sm.y + bv.y)), pack2(silu_f(sm.z + bv.z), silu_f(sm.w + bv.w))};
                            *(u32x2*)(lds + row * HSTR + (c0 + cg * 4) * 2) = o;
                        }
                    }
                    __syncthreads();
                    const float* w2 = (isv ? p.w2_v : p.w2_k) + (size_t)layer * 128 * 64;
                    const int tid = my_tid(); const int c = tid & 63, rg = tid >> 6;
                    float* w2s = (float*)(lds + 36864);
#pragma unroll
                    for (int q = 0; q < 8; ++q) *(f32x4*)(w2s + (q * 256 + tid) * 4) = *(const f32x4*)(w2 + (q * 256 + tid) * 4);
                    __syncthreads();
                    float a32[32];
#pragma unroll
                    for (int rr = 0; rr < 32; ++rr) a32[rr] = 0.f;
#pragma unroll 2
                    for (int k = 0; k < 128; k += 2) {
                        const float w0 = w2s[k * 64 + c], w1 = w2s[(k + 1) * 64 + c];
#pragma unroll
                        for (int rr = 0; rr < 32; ++rr) {
                            const unsigned u = *(const unsigned*)(lds + (rg * 32 + rr) * HSTR + k * 2);
                            a32[rr] += bflo(u) * w0 + bfhi(u) * w1;
                        }
                    }
                    bf16_t* kcb = (bf16_t*)(p.ws + OFF_KC);
                    bf16_t* vcb = (bf16_t*)(p.ws + OFF_VCT);
#pragma unroll
                    for (int rr = 0; rr < 32; ++rr) {
                        const int R = mt * 128 + rg * 32 + rr, bg = R >> 8, i = R & 255;
                        const bf16_t val = (bf16_t)(pack2(a32[rr], 0.f) & 0xffffu);
                        if (isv) vcb[((size_t)bg * 64 + c) * 256 + i] = val; else kcb[((size_t)bg * 256 + i) * 64 + c] = val;
                    }
                    __syncthreads();
                } else {
                    const int u = t - n_cmp, qd = u & 3, n = (u >> 2) & 15, b = u >> 6;
                    const int tid = my_tid(); const int cp = tid & 63, kg = tid >> 6;
                    const bf16_t* src = bufA + (size_t)(b * SEQ + n * 256 + kg * 64) * NA + CA_MK + qd * 128 + 2 * cp;
                    float s0 = 0.f, s1 = 0.f;
                    for (int k = 0; k < 64; ++k) { const unsigned uu = *(const unsigned*)(src + (size_t)k * NA); s0 += bflo(uu); s1 += bfhi(uu); }
                    float* red = (float*)lds;
                    red[kg * 128 + 2 * cp] = s0; red[kg * 128 + 2 * cp + 1] = s1;
                    __syncthreads();
                    if (tid < 128) {
                        const float sum = red[tid] + red[128 + tid] + red[256 + tid] + red[384 + tid];
                        const int hh = qd * 2 + (tid >> 6), d = tid & 63;
                        kmean[((size_t)(b * 8 + hh) * 16 + n) * 64 + d] = sum * (1.f / 256.f);
                    }
                    __syncthreads();
                }
            }
        }
#endif
        xcd_barrier(xb);
        }
#ifndef SKIP_P3
        {
            int qsel = blockIdx.x & 7, qtried = 0;
#pragma unroll 1
            while (true) {
                if (my_tid() == 0) s_item = (int)atomicAdd(ctr + layer * 32 + r123 * 16 + qsel, 1u);
                __syncthreads();
                const int id = s_item;
                __syncthreads();
                if (id >= 768) { if (++qtried >= 8) break; qsel = (qsel + 1) & 7; continue; }
                const int b = qsel;
                if (id < 256) {
#ifndef SKIP_NSA
                    for (int rp = 0; rp < REP_NSA; ++rp) nsa_item(p, lds, b, id >> 7, 127 - (id & 127), rp == REP_NSA - 1);
#endif
                } else if (id < 512) {
#ifndef SKIP_MOBA
                    const int u = id - 256; for (int rp = 0; rp < REP_MOBA; ++rp) moba_item(p, lds, b, u >> 5, 31 - (u & 31), rp == REP_MOBA - 1);
#endif
                } else if (id < 640) {
#ifndef SKIP_RET
                    const int u = id - 512; for (int rp = 0; rp < REP_RET; ++rp) ret_item(p, lds, layer, b, u >> 5, 31 - (u & 31), rp == REP_RET - 1);
#endif
                } else {
#ifndef SKIP_MEM
                    const int u = id - 640; for (int rp = 0; rp < REP_MEM; ++rp) mem_item(p, lds, b, u >> 5, u & 31, rp == REP_MEM - 1);
#endif
                }
            }
        }
#endif
        xcd_barrier(xb);
        }
        for (int r4 = 0; r4 < REP4; ++r4) {
#ifndef SKIP_P4
        {
            const bf16_t* bufZ = (const bf16_t*)(p.ws + OFF_BUFZ);
            const bf16_t* woT = (const bf16_t*)(p.ws + OFF_WOUT);
            const int xcd = blockIdx.x & 7, li = blockIdx.x >> 3, nb = (gridDim.x + 7 - xcd) >> 3;
#pragma unroll 1
            for (int q = li; q < 128; q += nb) {
                const int mt = 32 * xcd + (q >> 2), nt = q & 3;
                EpiY e{(bf16_t*)(p.ws + OFF_Y), mt * 128, nt * 256};
                gemm_wide<true>(lds, bufZ + (size_t)mt * 128 * 32, ARowLin{32}, woT + (size_t)nt * 256 * 32, 32, 32, e, (long)NTOK * 32, (long)1024 * 32);
            }
        }
#endif
        xcd_barrier(xb);
        }
        {
            const float* xold = layer == 0 ? p.x : p.out;
            resid_rows(xold, (const bf16_t*)(p.ws + OFF_Y), p.post_g + layer * DM, p.out, layer == 0 ? p.pre_g + DM : nullptr, hbuf);
            if (layer == 0) {
                conv_layer_weights(p, 1, GTID, GTHREADS);
                cmp_bias(p, 1, lds);
                rms_rows(p.mem, p.mem_g + DM, (bf16_t*)(p.ws + OFF_MEMN), 2048, false);
                xcd_barrier(xb);
            }
        }
    }
}

extern "C" void kernel_launch(void* const* d_in, const int* in_sizes, int n_in, void* d_out, int out_size, void* d_ws, size_t ws_size, hipStream_t stream) {
    static int grid_blocks = 0;
    if (!grid_blocks) {
        int dev = 0, cus = 0, per_cu = 0;
        hipGetDevice(&dev);
        hipDeviceGetAttribute(&cus, hipDeviceAttributeMultiprocessorCount, dev);
        hipOccupancyMaxActiveBlocksPerMultiprocessor(&per_cu, mega, 256, 0);
        if (per_cu < 1) per_cu = 1;
        if (per_cu > 2) per_cu = 2;
#ifdef FORCE_PER_CU
        per_cu = FORCE_PER_CU;
#endif
        grid_blocks = cus * per_cu;
    }
    if (ws_size < WS_NEED) fprintf(stderr, "workspace too small: %zu < %zu\n", ws_size, (size_t)WS_NEED);
    Params p{};
    p.x = (const float*)d_in[0]; p.mem = (const float*)d_in[1]; p.pre_g = (const float*)d_in[2]; p.post_g = (const float*)d_in[3];
    p.mem_g = (const float*)d_in[4]; p.w_in = (const float*)d_in[5]; p.w_mem = (const float*)d_in[6]; p.pe_k = (const float*)d_in[7];
    p.w1_k = (const float*)d_in[8]; p.w2_k = (const float*)d_in[9]; p.pe_v = (const float*)d_in[10]; p.w1_v = (const float*)d_in[11];
    p.w2_v = (const float*)d_in[12]; p.gn_g = (const float*)d_in[13]; p.w_out = (const float*)d_in[14];
    p.out = (float*)d_out; p.ws = (char*)d_ws;
    (void)hipMemsetAsync((char*)d_ws + OFF_BAR, 0, XCD_BAR_WORDS * 4, stream);
    void* args[] = {&p};
    hipError_t e = hipLaunchCooperativeKernel((void*)mega, dim3(grid_blocks), dim3(256), args, 0, stream);
    if (e != hipSuccess) fprintf(stderr, "cooperative launch failed: %s (grid %d)\n", hipGetErrorString(e), grid_blocks);
}
```

```cpp
#include <hip/hip_runtime.h>
#include <hip/hip_cooperative_groups.h>
#include <stdint.h>
#include <cstdio>
namespace cg = cooperative_groups;

typedef unsigned short bf16_t;
typedef short bf16x8 __attribute__((ext_vector_type(8)));
typedef float f32x16 __attribute__((ext_vector_type(16)));
typedef float f32x4 __attribute__((ext_vector_type(4)));
typedef float f32x2 __attribute__((ext_vector_type(2)));
typedef unsigned u32x4 __attribute__((ext_vector_type(4)));
typedef unsigned u32x2 __attribute__((ext_vector_type(2)));
typedef __bf16 bf16v2 __attribute__((ext_vector_type(2)));
typedef unsigned long long u64;
#define DI __device__ __forceinline__
#define MFMA(a, b, c) __builtin_amdgcn_mfma_f32_32x32x16_bf16((a), (b), (c), 0, 0, 0)

constexpr int SEQ = 4096, DM = 1024, NTOK = 32768;
constexpr int NA = 3096;
constexpr int NZ = 2048;
constexpr int NVT = 1280;
constexpr int NIN = 6656;
constexpr float EPS = 1e-6f;
DI size_t kbm(int row, int k, int nrows) { return ((size_t)(k >> 5) * nrows + row) * 32 + (k & 31); }
constexpr float LOG2E = 1.4426950408889634f;

constexpr int CA_MQ = 0, CA_MK = 512, CA_NQ = 1024, CA_NKC = 1536, CA_NVC = 1664, CA_NKS = 1792, CA_NKW = 1920,
              CA_RQ = 2048, CA_RK = 2304, CA_CQ = 2560, CA_GATE = 3072;
constexpr int CV_MV = 0, CV_NVS = 512, CV_NVW = 640, CV_RV = 768;

constexpr size_t OFF_BUFA = 0;
constexpr size_t OFF_VT   = OFF_BUFA + (size_t)NTOK * NA * 2;
constexpr size_t OFF_BUFZ = OFF_VT + (size_t)8 * NVT * SEQ * 2;
constexpr size_t OFF_H    = OFF_BUFZ + (size_t)NTOK * NZ * 2;
constexpr size_t OFF_WIN  = OFF_H + (size_t)NTOK * DM * 2;
constexpr size_t OFF_WOUT = OFF_WIN + (size_t)NIN * 1024 * 2;
constexpr size_t OFF_WMEM = OFF_WOUT + (size_t)1024 * 2048 * 2;
constexpr size_t OFF_W1K  = OFF_WMEM + (size_t)1024 * 1024 * 2;
constexpr size_t OFF_W1V  = OFF_W1K + (size_t)128 * 2048 * 2;
constexpr size_t OFF_ROPE = OFF_W1V + (size_t)128 * 2048 * 2;
constexpr size_t OFF_MEMN = OFF_ROPE + (size_t)SEQ * 32 * 8;
constexpr size_t OFF_MEMK = OFF_MEMN + (size_t)2048 * 1024 * 2;
constexpr size_t OFF_MEMV = OFF_MEMK + (size_t)2048 * 512 * 2;
constexpr size_t OFF_BIAS = OFF_MEMV + (size_t)8 * 512 * 256 * 2;
constexpr size_t OFF_CTR  = OFF_BIAS + 16384;
constexpr size_t OFF_BAR  = OFF_CTR + 1024;
constexpr size_t OFF_RKT  = OFF_BAR + 16384;
constexpr size_t WS_NEED  = OFF_RKT + (size_t)8 * 4 * 64 * SEQ * 2;
constexpr size_t OFF_KMEAN = OFF_H;
constexpr size_t OFF_KC    = OFF_KMEAN + (size_t)8 * 8 * 16 * 64 * 4;
constexpr size_t OFF_VCT   = OFF_KC + (size_t)16 * 256 * 64 * 2;
constexpr size_t OFF_U = OFF_H + ((size_t)24 << 20);
constexpr size_t OFF_CPART = OFF_H + ((size_t)4 << 20);
constexpr size_t OFF_Y = OFF_BUFA;

constexpr int LDS_BYTES = 73728;
#ifndef REP1
#define REP1 1
#endif
#ifndef REP_NSA
#define REP_NSA 1
#endif
#ifndef REP_MOBA
#define REP_MOBA 1
#endif
#ifndef REP_RET
#define REP_RET 1
#endif
#ifndef REP_MEM
#define REP_MEM 1
#endif
#ifndef REP0
#define REP0 1
#endif
#ifndef REP2
#define REP2 1
#endif
#ifndef REP4
#define REP4 1
#endif
#ifndef REP123
#define REP123 1
#endif

struct Params {
    const float *x, *mem, *pre_g, *post_g, *mem_g, *w_in, *w_mem, *pe_k, *w1_k, *w2_k, *pe_v, *w1_v, *w2_v, *gn_g, *w_out;
    float* out;
    char* ws;
};

DI int my_tid() { int t = threadIdx.x; asm volatile("" : "+v"(t)); return t; }
DI unsigned pack2(float a, float b) { f32x2 v = {a, b}; bf16v2 r = __builtin_convertvector(v, bf16v2); return __builtin_bit_cast(unsigned, r); }
DI float bflo(unsigned u) { return __uint_as_float(u << 16); }
DI float bfhi(unsigned u) { return __uint_as_float(u & 0xffff0000u); }
DI float bf2f(bf16_t v) { return __uint_as_float(((unsigned)v) << 16); }
DI int crow(int reg, int h) { return (reg & 3) + 8 * (reg >> 2) + 4 * h; }
DI float ex2(float x) { return __builtin_amdgcn_exp2f(x); }
DI float ret_lg(int hh) { return (hh == 0) ? -0.045803688f : (hh == 1 ? -0.022720077f : (hh == 2 ? -0.011315314f : -0.0056465633f)); }
DI float mx2(float a, float b) { return __builtin_amdgcn_fmed3f(a, b, INFINITY); }
DI float shx(float v, int m) { return __shfl_xor(v, m, 64); }
DI float xh_max(float v) { auto rr = __builtin_amdgcn_permlane32_swap(__float_as_uint(v), __float_as_uint(v), false, false); return __builtin_amdgcn_fmed3f(__uint_as_float(rr[0]), __uint_as_float(rr[1]), INFINITY); }
DI float xh_sum(float v) { auto rr = __builtin_amdgcn_permlane32_swap(__float_as_uint(v), __float_as_uint(v), false, false); return __uint_as_float(rr[0]) + __uint_as_float(rr[1]); }
DI float xh_other(float v, int h) { auto rr = __builtin_amdgcn_permlane32_swap(__float_as_uint(v), __float_as_uint(v), false, false); return h ? __uint_as_float(rr[0]) : __uint_as_float(rr[1]); }
DI u32x4 pair_swap(u32x2 a, u32x2 b) {
    auto r0 = __builtin_amdgcn_permlane32_swap(a.x, b.x, false, false);
    auto r1 = __builtin_amdgcn_permlane32_swap(a.y, b.y, false, false);
    return (u32x4){r0[0], r1[0], r0[1], r1[1]};
}
DI float wave_sum(float v) { v = xh_sum(v); v += shx(v, 16); v += shx(v, 8); v += shx(v, 4); v += shx(v, 2); v += shx(v, 1); return v; }
DI float silu_f(float v) { return v * __builtin_amdgcn_rcpf(1.f + __expf(-v)); }
DI float sigm_f(float v) { return __builtin_amdgcn_rcpf(1.f + __expf(-v)); }
DI f32x16 zero16() { f32x16 z; for (int i = 0; i < 16; ++i) z[i] = 0.f; return z; }

DI int in_col_src(int n) {
    if (n < 1024) return n;
    if (n < 1920) return n + 512;
    if (n < 2048) return n + 640;
    if (n < 2560) return n + 792;
    if (n < 3072) return n + 1304;
    if (n < 3584) return n - 2048;
    if (n < 3712) return n - 1152;
    if (n < 3840) return n - 1024;
    if (n < 4352) return n - 488;
    if (n < 6400) return n + 24;
    if (n < 6424) return n - 3584;
    return -1;
}

constexpr int GSTR = 144;
constexpr int GBUF = 36864;
constexpr int GBOFF = 18432;

DI void glds16(const void* g, unsigned lds_addr);
template <int N> DI void wait_vm();
#define RAW_BARRIER() do { asm volatile("s_waitcnt lgkmcnt(0)" ::: "memory"); __builtin_amdgcn_s_barrier(); asm volatile("" ::: "memory"); } while (0)
template <bool SWAP, class AOff, class Epi>
DI void gemm_tile(char* lds, const bf16_t* __restrict__ A, AOff aoff, long a_kstride, const bf16_t* __restrict__ Bt, long ldb, int nk64, Epi epi) {
    constexpr int TB = 16384, NI = 4;
    const int tid = my_tid(), lane = tid & 63, w = __builtin_amdgcn_readfirstlane(tid >> 6), r = lane & 31, h = lane >> 5;
    const int wm = w >> 1, wn = w & 1;
    const int nk = nk64 * 2;
    const int lr = lane >> 2, ls = lane & 3;
    const bf16_t* ap[2];
    const bf16_t* bp[2];
#pragma unroll
    for (int i = 0; i < 2; ++i) {
        const int row = 16 * (w + 4 * i) + lr, c = ls ^ ((row >> 2) & 3);
        ap[i] = A + aoff(row) + c * 8;
        bp[i] = Bt + (long)row * ldb + c * 8;
    }
    const unsigned sbase = (unsigned)(size_t)lds;
    f32x16 acc[2][2];
#pragma unroll
    for (int i = 0; i < 2; ++i)
#pragma unroll
        for (int j = 0; j < 2; ++j) acc[i][j] = zero16();
    int issued = 0;
#pragma unroll 1
    for (int a = 0; a < 3; ++a) {
        if (issued < nk) {
            const long ko_a = (long)(issued >> 1) * a_kstride + (issued & 1) * 32, ko_b = (long)issued * 32;
            const unsigned st = sbase + (issued & 3) * TB + w * 1024;
            glds16(ap[0] + ko_a, st); glds16(bp[0] + ko_b, st + 8192);
            glds16(ap[1] + ko_a, st + 4096); glds16(bp[1] + ko_b, st + 8192 + 4096);
            ++issued;
        }
    }
    const int fa = (wm * 64 + r) * 64, fb = 8192 + (wn * 64 + r) * 64, sw = (r >> 2) & 3;
#pragma unroll 1
    for (int kb = 0; kb < nk; ++kb) {
        const int ahead = issued - 1 - kb;
        if (ahead >= 2) wait_vm<2 * NI>(); else if (ahead == 1) wait_vm<NI>(); else wait_vm<0>();
        RAW_BARRIER();
        if (issued < nk) {
            const long ko_a = (long)(issued >> 1) * a_kstride + (issued & 1) * 32, ko_b = (long)issued * 32;
            const unsigned st = sbase + (issued & 3) * TB + w * 1024;
            glds16(ap[0] + ko_a, st); glds16(bp[0] + ko_b, st + 8192);
            glds16(ap[1] + ko_a, st + 4096); glds16(bp[1] + ko_b, st + 8192 + 4096);
            ++issued;
        }
        const char* cur = lds + (kb & 3) * TB;
        bf16x8 af[2][2], bfr[2][2];
#pragma unroll
        for (int kk = 0; kk < 2; ++kk) {
            const int so = ((2 * kk + h) ^ sw) * 16;
#pragma unroll
            for (int i = 0; i < 2; ++i) af[kk][i] = *(const bf16x8*)(cur + fa + i * 2048 + so);
#pragma unroll
            for (int j = 0; j < 2; ++j) bfr[kk][j] = *(const bf16x8*)(cur + fb + j * 2048 + so);
        }
#pragma unroll
        for (int kk = 0; kk < 2; ++kk)
#pragma unroll
            for (int i = 0; i < 2; ++i)
#pragma unroll
                for (int j = 0; j < 2; ++j) acc[i][j] = SWAP ? MFMA(bfr[kk][j], af[kk][i], acc[i][j]) : MFMA(af[kk][i], bfr[kk][j], acc[i][j]);
    }
    RAW_BARRIER();
    epi(acc, wm, wn, r, h);
}

template <bool SWAP, class AOff, class Epi>
DI void gemm_wide(char* lds, const bf16_t* __restrict__ A, AOff aoff, const bf16_t* __restrict__ Bt, long ldb, int nk64, Epi epi, long a_ks = 32, long b_ks = 32) {
    constexpr int TB = 24576, NI = 6;
    const int tid = my_tid(), lane = tid & 63, w = __builtin_amdgcn_readfirstlane(tid >> 6), r = lane & 31, h = lane >> 5;
    const int wm = w >> 1, wn = w & 1;
    const int nk = nk64 * 2;
    const int lr = lane >> 2, ls = lane & 3;
    const bf16_t* ap[2];
    const bf16_t* bp[4];
#pragma unroll
    for (int i = 0; i < 2; ++i) { const int row = 16 * (w + 4 * i) + lr, c = ls ^ ((row >> 2) & 3); ap[i] = A + aoff(row) + c * 8; }
#pragma unroll
    for (int i = 0; i < 4; ++i) { const int row = 16 * (w + 4 * i) + lr, c = ls ^ ((row >> 2) & 3); bp[i] = Bt + (long)row * ldb + c * 8; }
    const unsigned sbase = (unsigned)(size_t)lds;
    f32x16 acc[2][4];
#pragma unroll
    for (int i = 0; i < 2; ++i)
#pragma unroll
        for (int j = 0; j < 4; ++j) acc[i][j] = zero16();
    int issued = 0, si = 0;
#pragma unroll 1
    for (int a = 0; a < 2; ++a) {
        if (issued < nk) {
            const long ko = (long)issued * a_ks, kob = (long)issued * b_ks;
            const unsigned st = sbase + si * TB + w * 1024;
            glds16(ap[0] + ko, st); glds16(ap[1] + ko, st + 4096);
            glds16(bp[0] + kob, st + 8192); glds16(bp[1] + kob, st + 8192 + 4096); glds16(bp[2] + kob, st + 8192 + 8192); glds16(bp[3] + kob, st + 8192 + 12288);
            ++issued; si = (si == 2) ? 0 : si + 1;
        }
    }
    const int fa = (wm * 64 + r) * 64, fb = 8192 + (wn * 128 + r) * 64, sw = (r >> 2) & 3;
    int sc_ = 0;
#pragma unroll 1
    for (int kb = 0; kb < nk; ++kb) {
        if (issued - 1 - kb >= 1) wait_vm<NI>(); else wait_vm<0>();
        RAW_BARRIER();
        const char* cur = lds + sc_ * TB;
        sc_ = (sc_ == 2) ? 0 : sc_ + 1;
        bf16x8 af[2][2], bfr[2][4];
#pragma unroll
        for (int kk = 0; kk < 2; ++kk) {
            const int so = ((2 * kk + h) ^ sw) * 16;
#pragma unroll
            for (int i = 0; i < 2; ++i) af[kk][i] = *(const bf16x8*)(cur + fa + i * 2048 + so);
#pragma unroll
            for (int j = 0; j < 4; ++j) bfr[kk][j] = *(const bf16x8*)(cur + fb + j * 2048 + so);
        }
        if (issued < nk) {
            const long ko = (long)issued * a_ks, kob = (long)issued * b_ks;
            const unsigned st = sbase + si * TB + w * 1024;
            glds16(ap[0] + ko, st); glds16(ap[1] + ko, st + 4096);
            glds16(bp[0] + kob, st + 8192); glds16(bp[1] + kob, st + 8192 + 4096); glds16(bp[2] + kob, st + 8192 + 8192); glds16(bp[3] + kob, st + 8192 + 12288);
            ++issued; si = (si == 2) ? 0 : si + 1;
        }
#pragma unroll
        for (int kk = 0; kk < 2; ++kk)
#pragma unroll
            for (int i = 0; i < 2; ++i)
#pragma unroll
                for (int j = 0; j < 4; ++j) acc[i][j] = SWAP ? MFMA(bfr[kk][j], af[kk][i], acc[i][j]) : MFMA(af[kk][i], bfr[kk][j], acc[i][j]);
    }
    RAW_BARRIER();
    epi(acc, wm, wn, r, h);
}

struct ARowLin { long ld; DI long operator()(int r) const { return (long)r * ld; } };

enum { EM_PLAIN = 0, EM_ROPEQ = 1, EM_ROPEK = 2, EM_SILU = 3, EM_GATE = 4 };
struct EpiRow {
    bf16_t* dst; long ld; int row0; int col0; int mode; const f32x2* rope; bool zblk = false; bf16_t* rkt = nullptr;
    template <int NJ> DI void operator()(f32x16 (&acc)[2][NJ], int wm, int wn, int r, int h) const {
#pragma unroll
        for (int i = 0; i < 2; ++i) {
            const int row = row0 + wm * 64 + 32 * i + r;
            if (mode == EM_ROPEQ || mode == EM_ROPEK) {
                const int pos = row & (SEQ - 1);
                const float scl = (mode == EM_ROPEK) ? 0.125f : 1.f;
#pragma unroll
                for (int jp = 0; jp < NJ; jp += 2)
#pragma unroll
                for (int c4 = 0; c4 < 4; ++c4) {
                    float n1[4], n2[4];
#pragma unroll
                    for (int e = 0; e < 4; ++e) {
                        const int d = 8 * c4 + 4 * h + e;
                        const f32x2 cs = rope[pos * 32 + d];
                        const float t1 = acc[i][jp][4 * c4 + e], t2 = acc[i][jp + 1][4 * c4 + e];
                        n1[e] = (t1 * cs.x - t2 * cs.y) * scl;
                        n2[e] = (t1 * cs.y + t2 * cs.x) * scl;
                    }
                    bf16_t* d1 = dst + (long)row * ld + col0 + wn * (32 * NJ) + 32 * jp + 8 * c4 + 4 * h;
                    u32x2 o1 = {pack2(n1[0], n1[1]), pack2(n1[2], n1[3])};
                    u32x2 o2 = {pack2(n2[0], n2[1]), pack2(n2[2], n2[3])};
                    *(u32x2*)d1 = o1;
                    *(u32x2*)(d1 + 32) = o2;
                    if (mode == EM_ROPEK && rkt != nullptr) {
                        const int hh = (wn * (32 * NJ) + 32 * jp) >> 6;
                        const float wgt = ex2(ret_lg(hh) * (float)(127 - (pos & 127)));
                        bf16_t* tp = rkt + ((size_t)((row >> 12) * 4 + hh) * 64 + 8 * c4 + 4 * h) * SEQ + pos;
#pragma unroll
                        for (int e = 0; e < 4; ++e) {
                            tp[(size_t)e * SEQ] = (bf16_t)(pack2(n1[e] * wgt, 0.f) & 0xffffu);
                            tp[(size_t)(e + 32) * SEQ] = (bf16_t)(pack2(n2[e] * wgt, 0.f) & 0xffffu);
                        }
                    }
                }
            } else if (mode == EM_GATE) {
#pragma unroll
                for (int c4 = 0; c4 < 3; ++c4) {
                    if (wn == 0) {
                        const int cl = 8 * c4 + 4 * h;
                        float v[4];
#pragma unroll
                        for (int e = 0; e < 4; ++e) v[e] = sigm_f(acc[i][0][4 * c4 + e]);
                        u32x2 o = {pack2(v[0], v[1]), pack2(v[2], v[3])};
                        *(u32x2*)(dst + (size_t)((long)row * ld + col0 + cl)) = o;
                    }
                }
            } else {
#pragma unroll
                for (int j = 0; j < NJ; ++j)
#pragma unroll
                    for (int c4 = 0; c4 < 4; c4 += 2) {
                        u32x2 pk[2];
#pragma unroll
                        for (int g = 0; g < 2; ++g) {
                            float v[4];
#pragma unroll
                            for (int e = 0; e < 4; ++e) v[e] = (mode == EM_SILU) ? silu_f(acc[i][j][4 * (c4 + g) + e]) : acc[i][j][4 * (c4 + g) + e];
                            pk[g] = (u32x2){pack2(v[0], v[1]), pack2(v[2], v[3])};
                        }
                        const u32x4 o = pair_swap(pk[0], pk[1]);
                        const int cl = wn * (32 * NJ) + 32 * j + 8 * c4 + 8 * h;
                        *(u32x4*)(dst + (zblk ? kbm(row, col0 + cl, NTOK) : (size_t)((long)row * ld + col0 + cl))) = o;
                    }
            }
        }
    }
};
struct EpiVT {
    bf16_t* dst; int ncols; int seq; int row0; int col0;
    template <int NJ> DI void operator()(f32x16 (&acc)[2][NJ], int wm, int wn, int r, int h) const {
#pragma unroll
        for (int i = 0; i < 2; ++i)
#pragma unroll
            for (int j = 0; j < NJ; ++j) {
                const int col = col0 + wn * (32 * NJ) + 32 * j + r;
#pragma unroll
                for (int c4 = 0; c4 < 4; ++c4) {
                    const int row = row0 + wm * 64 + 32 * i + 8 * c4 + 4 * h;
                    const int b = row / seq, s = row - b * seq;
                    u32x2 o = {pack2(acc[i][j][4 * c4], acc[i][j][4 * c4 + 1]), pack2(acc[i][j][4 * c4 + 2], acc[i][j][4 * c4 + 3])};
                    *(u32x2*)(dst + ((long)b * ncols + col) * seq + s) = o;
                }
            }
    }
};
struct EpiY {
    bf16_t* dst; int row0; int col0;
    template <int NJ> DI void operator()(f32x16 (&acc)[2][NJ], int wm, int wn, int r, int h) const {
#pragma unroll
        for (int i = 0; i < 2; ++i) {
            const int row = row0 + wm * 64 + 32 * i + r;
#pragma unroll
            for (int j = 0; j < NJ; ++j)
#pragma unroll
                for (int c4 = 0; c4 < 4; c4 += 2) {
                    const u32x2 a = {pack2(acc[i][j][4 * c4], acc[i][j][4 * c4 + 1]), pack2(acc[i][j][4 * c4 + 2], acc[i][j][4 * c4 + 3])};
                    const u32x2 b = {pack2(acc[i][j][4 * c4 + 4], acc[i][j][4 * c4 + 5]), pack2(acc[i][j][4 * c4 + 6], acc[i][j][4 * c4 + 7])};
                    const u32x4 o = pair_swap(a, b);
                    *(u32x4*)(dst + (long)row * DM + col0 + wn * (32 * NJ) + 32 * j + 8 * c4 + 8 * h) = o;
                }
        }
    }
};
constexpr int HSTR = 272;
struct EpiCmp {
    char* lds; const float* bias;
    DI void operator()(f32x16 (&acc)[2][2], int wm, int wn, int r, int h) const {
#pragma unroll
        for (int i = 0; i < 2; ++i) {
            const int row = wm * 64 + 32 * i + r;
#pragma unroll
            for (int j = 0; j < 2; ++j)
#pragma unroll
                for (int c4 = 0; c4 < 4; ++c4) {
                    const int cl = wn * 64 + 32 * j + 8 * c4 + 4 * h;
                    float v[4];
#pragma unroll
                    for (int e = 0; e < 4; ++e) v[e] = silu_f(acc[i][j][4 * c4 + e] + bias[cl + e]);
                    u32x2 o = {pack2(v[0], v[1]), pack2(v[2], v[3])};
                    *(u32x2*)(lds + row * HSTR + cl * 2) = o;
                }
        }
    }
};
struct EpiPart {
    float* dst;
    DI void operator()(f32x16 (&acc)[2][2], int wm, int wn, int r, int h) const {
#pragma unroll
        for (int i = 0; i < 2; ++i) {
            const int row = wm * 64 + 32 * i + r;
#pragma unroll
            for (int j = 0; j < 2; ++j)
#pragma unroll
                for (int c4 = 0; c4 < 4; ++c4) {
                    f32x4 o = {acc[i][j][4 * c4], acc[i][j][4 * c4 + 1], acc[i][j][4 * c4 + 2], acc[i][j][4 * c4 + 3]};
                    *(f32x4*)(dst + row * 128 + wn * 64 + 32 * j + 8 * c4 + 4 * h) = o;
                }
        }
    }
};
struct ARowCmp {
    int row0; int colbase;
    DI long operator()(int r) const {
        const int R = row0 + r, bg = R >> 8; int i = R & 255; if (i > 254) i = 254;
        const int b = bg >> 1, g = bg & 1;
        return ((long)(b * SEQ + 16 * i)) * NA + colbase + g * 64;
    }
};

enum { FM_NONE = 0, FM_MOBA = 1, FM_CMP = 2, FM_SLC = 3, FM_WIN = 4, FM_RET = 5 };
constexpr int VSTR = 144;

template <int DK, int DV>
struct TileRegs { u32x4 k[DK / 32]; u32x4 v[DV / 32]; };

template <int DK, int DV>
DI void tile_load(TileRegs<DK, DV>& t, const bf16_t* __restrict__ Kp, long kstride, const bf16_t* __restrict__ Vt, long vstride, int key0, bool loadv) {
    const int tid = my_tid();
#pragma unroll
    for (int j = 0; j < DK / 32; ++j) {
        const int c = tid + 256 * j, row = c / (DK / 8), kc = c % (DK / 8);
        t.k[j] = *(const u32x4*)(Kp + (long)(key0 + row) * kstride + kc * 8);
    }
    if (loadv) {
#pragma unroll
        for (int j = 0; j < DV / 32; ++j) {
            const int c = tid + 256 * j, row = c >> 3, kc = c & 7;
            t.v[j] = *(const u32x4*)(Vt + (long)row * vstride + key0 + kc * 8);
        }
    }
}
template <int DK, int DV>
DI void tile_store(const TileRegs<DK, DV>& t, char* buf, bool storev) {
    constexpr int KSTR = (DK + 8) * 2;
    const int tid = my_tid();
#pragma unroll
    for (int j = 0; j < DK / 32; ++j) {
        const int c = tid + 256 * j, row = c / (DK / 8), kc = c % (DK / 8);
        *(u32x4*)(buf + row * KSTR + kc * 16) = t.k[j];
    }
    if (storev) {
#pragma unroll
        for (int j = 0; j < DV / 32; ++j) {
            const int c = tid + 256 * j, row = c >> 3, kc = c & 7;
            *(u32x4*)(buf + 64 * KSTR + row * VSTR + kc * 16) = t.v[j];
        }
    }
}

template <int MODE>
DI bool fpred(int key, int tq) {
    if (MODE == FM_NONE) return true;
    if (MODE == FM_CMP) return (16 * key + 31) <= tq;
    if (MODE == FM_WIN) return (key <= tq) && (key > tq - 512);
    return key <= tq;
}

DI void glds16(const void* g, unsigned lds_addr) {
    lds_addr = __builtin_amdgcn_readfirstlane(lds_addr);
    asm volatile("s_mov_b32 m0, %0\n\ts_nop 0\n\tglobal_load_lds_dwordx4 %1, off" ::"s"(lds_addr), "v"(g) : "memory", "m0");
}
template <int DK, int DV>
struct TileSrc { const bf16_t* k[DK / 32]; const bf16_t* v[DV / 32]; unsigned woff; };
template <int DK, int DV>
DI void tile_src_init(TileSrc<DK, DV>& ts, const bf16_t* __restrict__ Kp, long kstride, const bf16_t* __restrict__ Vt, long vstride) {
    constexpr int NK = DK / 8, NV = DV / 8;
    const int tid = my_tid(), lane = tid & 63, w = __builtin_amdgcn_readfirstlane(tid >> 6);
    ts.woff = (unsigned)w * 1024u;
#pragma unroll
    for (int i = 0; i < NK / 4; ++i) {
        const int g = w + 4 * i;
        int row, c;
        if (DK == 64) { row = 8 * g + (lane >> 3); c = (lane & 7) ^ ((row >> 1) & 7); }
        else { row = 4 * g + (lane >> 4); c = (lane & 15) ^ (row & 15); }
        ts.k[i] = Kp + (long)row * kstride + c * 8;
    }
#pragma unroll
    for (int i = 0; i < NV / 4; ++i) {
        const int g = w + 4 * i;
        const int row = 8 * g + (lane >> 3), c = (lane & 7) ^ ((row >> 1) & 7);
        ts.v[i] = Vt + (long)row * vstride + c * 8;
    }
}
template <int DK, int DV>
DI void tile_issue(char* stage, const TileSrc<DK, DV>& ts, long kstride, int key0) {
    constexpr int NK = DK / 8, NV = DV / 8;
    const unsigned sbase = (unsigned)(size_t)stage + ts.woff;
    const long koff = (long)key0 * kstride;
#pragma unroll
    for (int i = 0; i < NK / 4; ++i) glds16(ts.k[i] + koff, sbase + i * 4096);
#pragma unroll
    for (int i = 0; i < NV / 4; ++i) glds16(ts.v[i] + key0, sbase + NK * 1024 + i * 4096);
}
template <int N> DI void wait_vm() { asm volatile("s_waitcnt vmcnt(%0)" ::"n"(N) : "memory"); }

template <int DK, int DV, int MODE>
DI void flash(char* lds, const bf16x8 (&qf)[DK / 16], const bf16_t* __restrict__ Kp, long kstride, const bf16_t* __restrict__ Vt, long vstride,
              u64 tiles, u64 wtiles, int tq, u64 aux, float sc, float lg, f32x16 (&o)[DV / 32], float& m, float& l, int nst_cap = 4) {
    constexpr int NK = DK / 8, NV = DV / 8, NI = (NK + NV) / 4;
    constexpr int TB = (NK + NV) * 1024;
    constexpr int NSTMAX = (LDS_BYTES / TB) > 4 ? 4 : (LDS_BYTES / TB);
    const int NST = NSTMAX < nst_cap ? NSTMAX : nst_cap;
    const int lane = my_tid() & 63, r = lane & 31, h = lane >> 5;
    tiles = ((u64)(unsigned)__builtin_amdgcn_readfirstlane((unsigned)(tiles >> 32)) << 32) | (unsigned)__builtin_amdgcn_readfirstlane((unsigned)tiles);
    wtiles = ((u64)(unsigned)__builtin_amdgcn_readfirstlane((unsigned)(wtiles >> 32)) << 32) | (unsigned)__builtin_amdgcn_readfirstlane((unsigned)wtiles);
    u64 rem_i = tiles, rem_c = tiles;
    const int n = __builtin_popcountll(tiles);
    if (n == 0) return;
    TileSrc<DK, DV> ts;
    tile_src_init<DK, DV>(ts, Kp, kstride, Vt, vstride);
    int issued = 0, slot_i = 0, slot_c = 0;
#pragma unroll 1
    for (int a = 0; a < NST - 1; ++a) {
        if (rem_i) {
            const int t = __builtin_ctzll(rem_i); rem_i &= rem_i - 1;
            tile_issue<DK, DV>(lds + slot_i * TB, ts, kstride, t * 64);
            ++issued; slot_i = (slot_i + 1 == NST) ? 0 : slot_i + 1;
        }
    }
#pragma unroll 1
    for (int j = 0; j < n; ++j) {
        const int cur = __builtin_ctzll(rem_c); rem_c &= rem_c - 1;
        const int ahead = issued - 1 - j;
        if (ahead >= 2) wait_vm<2 * NI>(); else if (ahead == 1) wait_vm<NI>(); else wait_vm<0>();
        RAW_BARRIER();
        if (rem_i) {
            const int t = __builtin_ctzll(rem_i); rem_i &= rem_i - 1;
            tile_issue<DK, DV>(lds + slot_i * TB, ts, kstride, t * 64);
            ++issued; slot_i = (slot_i + 1 == NST) ? 0 : slot_i + 1;
        }
        const char* Ks = lds + slot_c * TB;
        const char* Vs = Ks + NK * 1024;
        slot_c = (slot_c + 1 == NST) ? 0 : slot_c + 1;
        if ((wtiles >> cur) & 1ull) {
            const int q0w = __builtin_amdgcn_readfirstlane(tq);
            const int kt0 = cur * 64;
            bool need_mask = false;
            if (MODE == FM_MOBA || MODE == FM_SLC || MODE == FM_RET) need_mask = (kt0 + 63 > q0w);
            if (MODE == FM_CMP) need_mask = (16 * (kt0 + 63) + 31 > q0w);
            if (MODE == FM_WIN) need_mask = (kt0 + 63 > q0w) || (kt0 <= q0w + 31 - 512);
            bool lane_on = true;
            if (MODE == FM_MOBA) lane_on = (((unsigned)aux >> (cur >> 2)) & 1u) != 0u;
            if (MODE == FM_SLC) lane_on = ((aux >> cur) & 1ull) != 0ull;
            f32x16 s[2];
            if (DK == 64) {
                bf16x8 kf[2][DK / 16];
#pragma unroll
                for (int t = 0; t < 2; ++t)
#pragma unroll
                    for (int kk = 0; kk < DK / 16; ++kk) {
                        const int krow = 32 * t + r;
                        kf[t][kk] = *(const bf16x8*)(Ks + krow * (DK * 2) + (((2 * kk + h) ^ ((krow >> 1) & 7)) * 16));
                    }
                __builtin_amdgcn_sched_barrier(0);
#pragma unroll
                for (int t = 0; t < 2; ++t) {
                    s[t] = zero16();
#pragma unroll
                    for (int kk = 0; kk < DK / 16; ++kk) s[t] = MFMA(kf[t][kk], qf[kk], s[t]);
                }
            } else {
#pragma unroll
                for (int t = 0; t < 2; ++t) {
                    bf16x8 kf[DK / 16];
#pragma unroll
                    for (int kk = 0; kk < DK / 16; ++kk) {
                        const int krow = 32 * t + r;
                        kf[kk] = *(const bf16x8*)(Ks + krow * (DK * 2) + (((2 * kk + h) ^ (krow & 15)) * 16));
                    }
                    s[t] = zero16();
#pragma unroll
                    for (int kk = 0; kk < DK / 16; ++kk) s[t] = MFMA(kf[kk], qf[kk], s[t]);
                    __builtin_amdgcn_sched_barrier(0);
                }
            }
            u32x4 vf0[2][DV / 32];
#pragma unroll
            for (int ss = 0; ss < 2; ++ss)
#pragma unroll
                for (int d = 0; d < DV / 32; ++d) {
                    const int vrow = 32 * d + r, vkey = (vrow >> 1) & 7, c0 = 2 * ss;
                    const u32x2 lo = *(const u32x2*)(Vs + vrow * 128 + ((c0 ^ vkey) * 16) + 8 * h);
                    const u32x2 hi = *(const u32x2*)(Vs + vrow * 128 + (((c0 + 1) ^ vkey) * 16) + 8 * h);
                    vf0[ss][d] = (u32x4){lo.x, lo.y, hi.x, hi.y};
                }
            __builtin_amdgcn_sched_barrier(0);
            if (MODE != FM_RET) {
                if (need_mask) {
#pragma unroll
                    for (int t = 0; t < 2; ++t)
#pragma unroll
                        for (int i = 0; i < 16; ++i)
                            if (!fpred<MODE>(kt0 + 32 * t + crow(i, h), tq)) s[t][i] = -INFINITY;
                }
                float mx0 = mx2(mx2(mx2(s[0][0], s[0][1]), mx2(s[0][2], s[0][3])), mx2(mx2(s[0][4], s[0][5]), mx2(s[0][6], s[0][7])));
                float mx1 = mx2(mx2(mx2(s[0][8], s[0][9]), mx2(s[0][10], s[0][11])), mx2(mx2(s[0][12], s[0][13]), mx2(s[0][14], s[0][15])));
                float mx2_ = mx2(mx2(mx2(s[1][0], s[1][1]), mx2(s[1][2], s[1][3])), mx2(mx2(s[1][4], s[1][5]), mx2(s[1][6], s[1][7])));
                float mx3 = mx2(mx2(mx2(s[1][8], s[1][9]), mx2(s[1][10], s[1][11])), mx2(mx2(s[1][12], s[1][13]), mx2(s[1][14], s[1][15])));
                float mx = mx2(mx2(mx0, mx1), mx2(mx2_, mx3));
                if (MODE == FM_MOBA || MODE == FM_SLC) mx = lane_on ? mx : -INFINITY;
                mx = xh_max(mx);
                const float mxs = mx * sc;
                if (__any(mxs > m + 8.f)) {
                    const float mn = fmaxf(m, mxs);
                    const float alpha = ex2(m - mn);
                    m = mn;
                    l *= alpha;
#pragma unroll
                    for (int d = 0; d < DV / 32; ++d)
#pragma unroll
                        for (int i = 0; i < 16; ++i) o[d][i] *= alpha;
                }
                float negm = -m;
                if (MODE == FM_MOBA || MODE == FM_SLC) negm = lane_on ? negm : -1e30f;
                float ps0 = 0.f, ps1 = 0.f;
#pragma unroll
                for (int t = 0; t < 2; ++t)
#pragma unroll
                    for (int i = 0; i < 16; i += 2) {
                        const float p0 = ex2(__builtin_fmaf(s[t][i], sc, negm));
                        const float p1 = ex2(__builtin_fmaf(s[t][i + 1], sc, negm));
                        s[t][i] = p0; s[t][i + 1] = p1;
                        ps0 += p0; ps1 += p1;
                    }
                l += ps0 + ps1;
            } else {
                const float g1 = sc, g2 = g1 * g1, g3 = g2 * g1, g4 = g2 * g2, g8 = g4 * g4;
#pragma unroll
                for (int t = 0; t < 2; ++t) {
                    float Ac = ex2(lg * (float)(tq - (kt0 + 32 * t) - 4 * h));
#pragma unroll
                    for (int c = 0; c < 4; ++c) {
                        s[t][4 * c] *= Ac; s[t][4 * c + 1] *= Ac * g1; s[t][4 * c + 2] *= Ac * g2; s[t][4 * c + 3] *= Ac * g3;
                        Ac *= g8;
                    }
                }
                if (need_mask) {
#pragma unroll
                    for (int t = 0; t < 2; ++t)
#pragma unroll
                        for (int i = 0; i < 16; ++i)
                            if (kt0 + 32 * t + crow(i, h) > tq) s[t][i] = 0.f;
                }
            }
            __builtin_amdgcn_sched_barrier(0);
            u32x4 vf1[2][DV / 32];
#pragma unroll
            for (int ss = 0; ss < 2; ++ss)
#pragma unroll
                for (int d = 0; d < DV / 32; ++d) {
                    const int vrow = 32 * d + r, vkey = (vrow >> 1) & 7, c0 = 4 + 2 * ss;
                    const u32x2 lo = *(const u32x2*)(Vs + vrow * 128 + ((c0 ^ vkey) * 16) + 8 * h);
                    const u32x2 hi = *(const u32x2*)(Vs + vrow * 128 + (((c0 + 1) ^ vkey) * 16) + 8 * h);
                    vf1[ss][d] = (u32x4){lo.x, lo.y, hi.x, hi.y};
                }
#pragma unroll
            for (int ss = 0; ss < 2; ++ss) {
                u32x4 pk = {pack2(s[0][8 * ss], s[0][8 * ss + 1]), pack2(s[0][8 * ss + 2], s[0][8 * ss + 3]),
                            pack2(s[0][8 * ss + 4], s[0][8 * ss + 5]), pack2(s[0][8 * ss + 6], s[0][8 * ss + 7])};
                const bf16x8 pf = __builtin_bit_cast(bf16x8, pk);
#pragma unroll
                for (int d = 0; d < DV / 32; ++d) o[d] = MFMA(__builtin_bit_cast(bf16x8, vf0[ss][d]), pf, o[d]);
            }
#pragma unroll
            for (int ss = 0; ss < 2; ++ss) {
                u32x4 pk = {pack2(s[1][8 * ss], s[1][8 * ss + 1]), pack2(s[1][8 * ss + 2], s[1][8 * ss + 3]),
                            pack2(s[1][8 * ss + 4], s[1][8 * ss + 5]), pack2(s[1][8 * ss + 6], s[1][8 * ss + 7])};
                const bf16x8 pf = __builtin_bit_cast(bf16x8, pk);
#pragma unroll
                for (int d = 0; d < DV / 32; ++d) o[d] = MFMA(__builtin_bit_cast(bf16x8, vf1[ss][d]), pf, o[d]);
            }
        }
    }
    RAW_BARRIER();
}

template <int DK>
DI void load_q(bf16x8 (&qf)[DK / 16], const bf16_t* qrow, int h) {
#pragma unroll
    for (int kk = 0; kk < DK / 16; ++kk) qf[kk] = *(const bf16x8*)(qrow + 16 * kk + 8 * h);
}

template <int DV>
DI void write_gated(const f32x16 (&o)[DV / 32], float scale, bf16_t* zbase, size_t row, int col0, int h, bool wr = true) {
    if (!wr) {
        float chk = 0.f;
#pragma unroll
        for (int d = 0; d < DV / 32; ++d)
#pragma unroll
            for (int i = 0; i < 16; ++i) chk += o[d][i];
        if (chk * scale == 1.2345e-30f) zbase[0] = 0;
        return;
    }
#pragma unroll
    for (int d = 0; d < DV / 32; ++d)
#pragma unroll
        for (int c4 = 0; c4 < 4; ++c4) {
            bf16_t* zp = zbase + kbm((int)row, col0 + 32 * d + 8 * c4 + 4 * h, NTOK);
            const u32x2 z = *(const u32x2*)zp;
            u32x2 ov = {pack2(o[d][4 * c4] * scale * bflo(z.x), o[d][4 * c4 + 1] * scale * bfhi(z.x)),
                        pack2(o[d][4 * c4 + 2] * scale * bflo(z.y), o[d][4 * c4 + 3] * scale * bfhi(z.y))};
            *(u32x2*)zp = ov;
        }
}

DI u64 range_bits(int lo, int hi) {
    const u64 a = (hi >= 63) ? ~0ull : ((2ull << hi) - 1ull);
    return a & ~((1ull << lo) - 1ull);
}

constexpr int KM_OFF = 65536, MISC_OFF = 69888;
DI void moba_item(const Params& p, char* lds, int b, int hh, int qt, bool wr = true) {
    const int tid = my_tid(), lane = tid & 63, w = tid >> 6, r = lane & 31, h = lane >> 5;
    const bf16_t* bufA = (const bf16_t*)(p.ws + OFF_BUFA);
    const bf16_t* vT = (const bf16_t*)(p.ws + OFF_VT);
    bf16_t* bufZ = (bf16_t*)(p.ws + OFF_BUFZ);
    const float* kmean = (const float*)(p.ws + OFF_KMEAN);
    const int q0w = qt * 128 + w * 32, tq = q0w + r, own = qt >> 1;
    *(f32x4*)(lds + KM_OFF + tid * 16) = *(const f32x4*)(kmean + (size_t)(b * 8 + hh) * 1024 + tid * 4);
    const bf16_t* qrow = bufA + (size_t)(b * SEQ + tq) * NA + CA_MQ + hh * 64;
    bf16x8 qf[4];
    load_q<64>(qf, qrow, h);
    __syncthreads();
    float gh[8];
#pragma unroll
    for (int mI = 0; mI < 8; ++mI) gh[mI] = 0.f;
#pragma unroll
    for (int c = 0; c < 8; ++c) {
        const u32x4 qv = *(const u32x4*)(qrow + 8 * c);
        const float q0 = bflo(qv.x), q1 = bfhi(qv.x), q2 = bflo(qv.y), q3 = bfhi(qv.y), q4 = bflo(qv.z), q5 = bfhi(qv.z), q6 = bflo(qv.w), q7 = bfhi(qv.w);
#pragma unroll
        for (int mI = 0; mI < 8; ++mI) {
            if (2 * mI < own) {
                const float* km = (const float*)(lds + KM_OFF) + (2 * mI + h) * 64 + c * 8;
                const f32x4 k0 = *(const f32x4*)km, k1 = *(const f32x4*)(km + 4);
                gh[mI] += q0 * k0.x + q1 * k0.y + q2 * k0.z + q3 * k0.w + q4 * k1.x + q5 * k1.y + q6 * k1.z + q7 * k1.w;
            }
        }
    }
    float g[16];
#pragma unroll
    for (int mI = 0; mI < 8; ++mI) {
        const float other = xh_other(gh[mI], h);
        g[2 * mI] = h ? other : gh[mI];
        g[2 * mI + 1] = h ? gh[mI] : other;
    }
    unsigned bm = 0;
#pragma unroll
    for (int pass = 0; pass < 3; ++pass) {
        float best = -INFINITY; int bi = -1;
#pragma unroll
        for (int n = 0; n < 15; ++n)
            if (n < own && !((bm >> n) & 1u) && g[n] > best) { best = g[n]; bi = n; }
        if (bi >= 0) bm |= 1u << bi;
    }
    bm |= 1u << own;
    unsigned um = bm;
    um |= __shfl_xor(um, 16, 64); um |= __shfl_xor(um, 8, 64); um |= __shfl_xor(um, 4, 64); um |= __shfl_xor(um, 2, 64); um |= __shfl_xor(um, 1, 64);
    um = __builtin_amdgcn_readfirstlane(um);
    u64 wt = 0;
#pragma unroll
    for (int n = 0; n < 16; ++n) if ((um >> n) & 1u) wt |= 0xFull << (4 * n);
    wt &= range_bits(0, (q0w + 31) >> 6);
    if (lane == 0) *(u64*)(lds + MISC_OFF + 8 * w) = wt;
    __syncthreads();
    const u64 tiles = *(const u64*)(lds + MISC_OFF) | *(const u64*)(lds + MISC_OFF + 8) | *(const u64*)(lds + MISC_OFF + 16) | *(const u64*)(lds + MISC_OFF + 24);
    f32x16 o[2]; o[0] = zero16(); o[1] = zero16();
    float m = -1e30f, l = 0.f;
    flash<64, 64, FM_MOBA>(lds, qf, bufA + (size_t)b * SEQ * NA + CA_MK + hh * 64, NA, vT + ((size_t)b * NVT + CV_MV + hh * 64) * SEQ, SEQ,
                           tiles, wt, tq, (u64)bm, 0.125f * LOG2E, 0.f, o, m, l);
    l = xh_sum(l);
    const float inv = l > 0.f ? 1.f / l : 0.f;
    write_gated<64>(o, inv, bufZ, (size_t)(b * SEQ + tq), 0 + hh * 64, h, wr);
}

constexpr int PART_OFF = 36864, SELM_OFF = 69632;
DI void nsa_item(const Params& p, char* lds, int b, int g, int qt32, bool wr = true) {
    const int tid = my_tid(), lane = tid & 63, w = tid >> 6, r = lane & 31, h = lane >> 5;
    const bf16_t* bufA = (const bf16_t*)(p.ws + OFF_BUFA);
    const bf16_t* vT = (const bf16_t*)(p.ws + OFF_VT);
    bf16_t* bufZ = (bf16_t*)(p.ws + OFF_BUFZ);
    const bf16_t* kc = (const bf16_t*)(p.ws + OFF_KC) + (size_t)(b * 2 + g) * 256 * 64;
    const bf16_t* vcT = (const bf16_t*)(p.ws + OFF_VCT) + (size_t)(b * 2 + g) * 64 * 256;
    const int q0 = qt32 * 32, tq = q0 + r, hq = g * 4 + w;
    const size_t tokrow = (size_t)(b * SEQ + tq);
    const bf16_t* qrow = bufA + tokrow * NA + CA_NQ + hq * 64;
    bf16x8 qf[4];
    load_q<64>(qf, qrow, h);
    const float sc = 0.125f * LOG2E;
    const bf16_t* gp = bufA + tokrow * NA + CA_GATE + hq * 3;
    const float g_cmp = bf2f(gp[0]), g_slc = bf2f(gp[1]), g_win = bf2f(gp[2]);
    f32x16 tot[2]; tot[0] = zero16(); tot[1] = zero16();
    const int ncmp_tiles = ((q0 >> 4) >> 6) + 1;
    const u64 ctiles = range_bits(0, ncmp_tiles - 1);
    float m = -1e30f, l = 0.f;
    {
        f32x16 o[2]; o[0] = zero16(); o[1] = zero16();
        flash<64, 64, FM_CMP>(lds, qf, kc, 64, vcT, 256, ctiles, ctiles, tq, 0ull, sc, 0.f, o, m, l);
        l = xh_sum(l);
        const float inv = l > 0.f ? 1.f / l : 0.f;
        l = inv;
#pragma unroll
        for (int d = 0; d < 2; ++d)
#pragma unroll
            for (int i = 0; i < 16; ++i) tot[d][i] = o[d][i] * (inv * g_cmp);
    }
#ifndef REP_IMP
#define REP_IMP 1
#endif
    for (int rimp = 0; rimp < REP_IMP; ++rimp) {
        float* part = (float*)(lds + w * 16384 + 8192) + r * 64;
#pragma unroll
        for (int j = 0; j < 32; ++j) part[2 * j + h] = 0.f;
        float prev = 0.f;
#pragma unroll 1
        for (int t4 = 0; t4 < ncmp_tiles; ++t4) {
#pragma unroll
            for (int t = 0; t < 2; ++t) {
                f32x16 s = zero16();
#pragma unroll
                for (int kk = 0; kk < 4; ++kk) {
                    const int krow = 32 * t + r;
                    const bf16x8 kf = *(const bf16x8*)(lds + t4 * 16384 + krow * 128 + (((2 * kk + h) ^ ((krow >> 1) & 7)) * 16));
                    s = MFMA(kf, qf[kk], s);
                }
                const int T = 2 * t4 + t;
#pragma unroll
                for (int c = 0; c < 4; ++c) {
                    float pv[4];
#pragma unroll
                    for (int e = 0; e < 4; ++e) {
                        const int key = 32 * T + 8 * c + 4 * h + e;
                        pv[e] = ((16 * key + 31) <= tq) ? ex2(s[4 * c + e] * sc - m) * l : 0.f;
                    }
                    const float A = 2.f * (pv[0] + pv[1] + pv[2]) + pv[3];
                    const float xch = xh_other(pv[3], h);
                    const float add = h ? xch : prev;
                    prev = xch;
                    part[8 * T + 2 * c + h] = A + add;
                }
            }
        }
        __syncthreads();
        const float* pbase = (const float*)(lds + 8192);
#ifndef REP_TOPK
#define REP_TOPK 1
#endif
#pragma unroll 1
        for (int rtk = 0; rtk < REP_TOPK; ++rtk)
#pragma unroll 1
        for (int qq = 8 * w; qq < 8 * w + 8; ++qq) {
            float v = pbase[qq * 64 + lane] + pbase[4096 + qq * 64 + lane] + pbase[2 * 4096 + qq * 64 + lane] + pbase[3 * 4096 + qq * 64 + lane];
            const int own = (q0 + qq) >> 6;
            if (lane == 0 || lane == own || lane == own - 1) v = INFINITY;
            if (lane > own) v = -INFINITY;
            const unsigned key = (v > 0.f) ? __float_as_uint(v) : 0u;
            unsigned T = 0u;
#pragma unroll
            for (int bit = 30; bit >= 0; --bit) {
                const unsigned cand = T | (1u << bit);
                const int cnt = __builtin_popcountll(__ballot(key >= cand));
                T = (cnt >= 16) ? cand : T;
            }
            u64 selm = __ballot(key > T), E = __ballot(key == T);
            int need = 16 - __builtin_popcountll(selm);
            while (need > 0 && E != 0ull) { const u64 low = E & (0ull - E); selm |= low; E ^= low; --need; }
            if (lane == 0) *(u64*)(lds + SELM_OFF + qq * 8) = selm;
        }
        __syncthreads();
    }
    const u64 sel = *(const u64*)(lds + SELM_OFF + r * 8);
    {
        unsigned ulo = (unsigned)sel, uhi = (unsigned)(sel >> 32);
#pragma unroll
        for (int off = 16; off >= 1; off >>= 1) { ulo |= __shfl_xor(ulo, off, 64); uhi |= __shfl_xor(uhi, off, 64); }
        ulo = __builtin_amdgcn_readfirstlane(ulo); uhi = __builtin_amdgcn_readfirstlane(uhi);
        const u64 stiles = (((u64)uhi << 32) | ulo) & range_bits(0, (q0 + 31) >> 6);
        f32x16 o[2]; o[0] = zero16(); o[1] = zero16();
        float m2 = -1e30f, l2 = 0.f;
        flash<64, 64, FM_SLC>(lds, qf, bufA + (size_t)b * SEQ * NA + CA_NKS + g * 64, NA, vT + ((size_t)b * NVT + CV_NVS + g * 64) * SEQ, SEQ,
                              stiles, stiles, tq, sel, sc, 0.f, o, m2, l2);
        l2 = xh_sum(l2);
        const float inv = l2 > 0.f ? 1.f / l2 : 0.f;
#pragma unroll
        for (int d = 0; d < 2; ++d)
#pragma unroll
            for (int i = 0; i < 16; ++i) tot[d][i] += o[d][i] * (inv * g_slc);
    }
    {
        const int lo = (q0 >= 511 ? (q0 - 511) : 0) >> 6;
        const u64 wtl = range_bits(lo, (q0 + 31) >> 6);
        f32x16 o[2]; o[0] = zero16(); o[1] = zero16();
        float m3 = -1e30f, l3 = 0.f;
        flash<64, 64, FM_WIN>(lds, qf, bufA + (size_t)b * SEQ * NA + CA_NKW + g * 64, NA, vT + ((size_t)b * NVT + CV_NVW + g * 64) * SEQ, SEQ,
                              wtl, wtl, tq, 0ull, sc, 0.f, o, m3, l3);
        l3 = xh_sum(l3);
        const float inv = l3 > 0.f ? 1.f / l3 : 0.f;
#pragma unroll
        for (int d = 0; d < 2; ++d)
#pragma unroll
            for (int i = 0; i < 16; ++i) tot[d][i] += o[d][i] * (inv * g_win);
    }
    write_gated<64>(tot, 1.f, bufZ, tokrow, 512 + hq * 64, h, wr);
}

DI void ret_item(const Params& p, char* lds, int layer, int b, int hh, int qt, bool wr = true) {
    const int tid = my_tid(), lane = tid & 63, w = tid >> 6, r = lane & 31, h = lane >> 5;
    const bf16_t* bufA = (const bf16_t*)(p.ws + OFF_BUFA);
    const bf16_t* vT = (const bf16_t*)(p.ws + OFF_VT);
    bf16_t* bufZ = (bf16_t*)(p.ws + OFF_BUFZ);
    const int q0b = qt * 128, q0w = q0b + w * 32, tq = q0w + r;
    const size_t tokrow = (size_t)(b * SEQ + tq);
    bf16x8 qf[4];
    load_q<64>(qf, bufA + tokrow * NA + CA_RQ + hh * 64, h);
    const float lg = ret_lg(hh);
    const int c = qt;
    constexpr int ST_OFF = 49152;
    {
        const int nch = (hh == 0) ? 5 : (hh == 1 ? 9 : (hh == 2 ? 17 : 31));
        const int nprev = c < nch ? c : nch;
        const int dv = tid >> 1, d0 = (tid & 1) * 32;
        const bf16_t* up = (const bf16_t*)(p.ws + OFF_U) + ((size_t)(b * 4 + hh) * 32) * 8192 + tid * 32;
        const float dec = ex2(lg * 128.f);
        f32x4 a[8];
#pragma unroll
        for (int q = 0; q < 8; ++q) a[q] = (f32x4){0.f, 0.f, 0.f, 0.f};
        float f = 1.f;
#pragma unroll 1
        for (int k = 0; k < nprev; k += 4) {
            u32x4 raw[4][4];
#pragma unroll
            for (int kk = 0; kk < 4; ++kk) {
                const int cp = (k + kk < nprev) ? (c - 1 - k - kk) : 0;
                const bf16_t* src = up + (size_t)cp * 8192;
#pragma unroll
                for (int q = 0; q < 4; ++q) raw[kk][q] = *(const u32x4*)(src + 8 * q);
            }
#pragma unroll
            for (int kk = 0; kk < 4; ++kk) {
                const float fw = (k + kk < nprev) ? f : 0.f;
#pragma unroll
                for (int q = 0; q < 4; ++q) {
                    const u32x4 rv = raw[kk][q];
                    a[2 * q] += (f32x4){bflo(rv.x), bfhi(rv.x), bflo(rv.y), bfhi(rv.y)} * fw;
                    a[2 * q + 1] += (f32x4){bflo(rv.z), bfhi(rv.z), bflo(rv.w), bfhi(rv.w)} * fw;
                }
                f *= dec;
            }
        }
#pragma unroll
        for (int q = 0; q < 4; ++q) {
            u32x4 pk = {pack2(a[2 * q].x, a[2 * q].y), pack2(a[2 * q].z, a[2 * q].w), pack2(a[2 * q + 1].x, a[2 * q + 1].y), pack2(a[2 * q + 1].z, a[2 * q + 1].w)};
            const int cidx = (d0 >> 3) + q;
            *(u32x4*)(lds + ST_OFF + dv * 128 + ((cidx ^ ((dv >> 1) & 7)) * 16)) = pk;
        }
    }
    __syncthreads();
    f32x16 o[4];
#pragma unroll
    for (int d = 0; d < 4; ++d) o[d] = zero16();
    if (c > 0) {
        const float cross = ex2(lg * (float)((tq & 127) + 1));
        const bf16_t* qrow = bufA + tokrow * NA + CA_RQ + hh * 64;
#pragma unroll
        for (int t = 0; t < 2; ++t)
#pragma unroll
            for (int ss = 0; ss < 2; ++ss) {
                const int dq = 32 * t + 16 * ss + 4 * h;
                const u32x2 qa = *(const u32x2*)(qrow + dq), qb = *(const u32x2*)(qrow + dq + 8);
                u32x4 pk = {pack2(bflo(qa.x) * cross, bfhi(qa.x) * cross), pack2(bflo(qa.y) * cross, bfhi(qa.y) * cross),
                            pack2(bflo(qb.x) * cross, bfhi(qb.x) * cross), pack2(bflo(qb.y) * cross, bfhi(qb.y) * cross)};
                const bf16x8 pf = __builtin_bit_cast(bf16x8, pk);
#pragma unroll
                for (int d = 0; d < 4; ++d) {
                    const int vrow = 32 * d + r, vkey = (vrow >> 1) & 7, c0 = 4 * t + 2 * ss;
                    const u32x2 lo2 = *(const u32x2*)(lds + ST_OFF + vrow * 128 + ((c0 ^ vkey) * 16) + 8 * h);
                    const u32x2 hi2 = *(const u32x2*)(lds + ST_OFF + vrow * 128 + (((c0 + 1) ^ vkey) * 16) + 8 * h);
                    u32x4 vv = {lo2.x, lo2.y, hi2.x, hi2.y};
                    o[d] = MFMA(__builtin_bit_cast(bf16x8, vv), pf, o[d]);
                }
            }
    }
    const u64 tiles = range_bits(2 * c, 2 * c + 1);
    const u64 wt = range_bits(2 * c, (q0w + 31) >> 6);
    float m = 0.f, l = 0.f;
    flash<64, 128, FM_RET>(lds, qf, bufA + (size_t)b * SEQ * NA + CA_RK + hh * 64, NA, vT + ((size_t)b * NVT + CV_RV + hh * 128) * SEQ, SEQ,
                           tiles, wt, tq, 0ull, ex2(-lg), lg, o, m, l, 2);
    float sm = 0.f;
#pragma unroll
    for (int d = 0; d < 4; ++d)
#pragma unroll
        for (int i = 0; i < 16; ++i) sm += o[d][i];
    sm = xh_sum(sm);
    const float mu = sm * (1.f / 128.f);
    float sq = 0.f;
#pragma unroll
    for (int d = 0; d < 4; ++d)
#pragma unroll
        for (int i = 0; i < 16; ++i) { const float c = o[d][i] - mu; o[d][i] = c; sq += c * c; }
    sq = xh_sum(sq);
    const float rs = rsqrtf(sq * (1.f / 128.f) + EPS);
    const float* gn = p.gn_g + layer * 512 + hh * 128;
#pragma unroll
    for (int d = 0; d < 4; ++d)
#pragma unroll
        for (int c4 = 0; c4 < 4; ++c4) {
            const f32x4 gv = *(const f32x4*)(gn + 32 * d + 8 * c4 + 4 * h);
            o[d][4 * c4] *= gv.x; o[d][4 * c4 + 1] *= gv.y; o[d][4 * c4 + 2] *= gv.z; o[d][4 * c4 + 3] *= gv.w;
        }
    write_gated<128>(o, rs, bufZ, tokrow, 1024 + hh * 128, h, wr);
}

DI void mem_item(const Params& p, char* lds, int b, int hh, int qt, bool wr = true) {
    const int tid = my_tid(), lane = tid & 63, w = tid >> 6, r = lane & 31, h = lane >> 5;
    const bf16_t* bufA = (const bf16_t*)(p.ws + OFF_BUFA);
    bf16_t* bufZ = (bf16_t*)(p.ws + OFF_BUFZ);
    const bf16_t* memK = (const bf16_t*)(p.ws + OFF_MEMK);
    const bf16_t* memVT = (const bf16_t*)(p.ws + OFF_MEMV);
    const int tq = qt * 128 + w * 32 + r;
    const size_t tokrow = (size_t)(b * SEQ + tq);
    bf16x8 qf[8];
    load_q<128>(qf, bufA + tokrow * NA + CA_CQ + hh * 128, h);
    f32x16 o[4];
#pragma unroll
    for (int d = 0; d < 4; ++d) o[d] = zero16();
    float m = -1e30f, l = 0.f;
    flash<128, 128, FM_NONE>(lds, qf, memK + (size_t)b * 256 * 512 + hh * 128, 512, memVT + ((size_t)b * 512 + hh * 128) * 256, 256,
                             0xFull, 0xFull, tq, 0ull, 0.08838834764831845f * LOG2E, 0.f, o, m, l);
    l = xh_sum(l);
    const float inv = l > 0.f ? 1.f / l : 0.f;
    write_gated<128>(o, inv, bufZ, tokrow, 1536 + hh * 128, h, wr);
}

DI void conv_w(const float* __restrict__ W, int ldw, bf16_t* __restrict__ WT, int K, int Ndst, bool mapped, long gtid, long gthreads, bool blocked = false) {
    const long total = (long)Ndst * (K / 8);
    for (long idx = gtid; idx < total; idx += gthreads) {
        const int n = (int)(idx % Ndst), kc = (int)(idx / Ndst);
        const int src = mapped ? in_col_src(n) : n;
        u32x4 o = {0u, 0u, 0u, 0u};
        if (src >= 0) {
            float v[8];
#pragma unroll
            for (int j = 0; j < 8; ++j) v[j] = W[(size_t)(kc * 8 + j) * ldw + src];
            o.x = pack2(v[0], v[1]); o.y = pack2(v[2], v[3]); o.z = pack2(v[4], v[5]); o.w = pack2(v[6], v[7]);
        }
        *(u32x4*)(WT + (blocked ? kbm(n, kc * 8, Ndst) : (size_t)n * K + kc * 8)) = o;
    }
}
DI void conv_layer_weights(const Params& p, int layer, long gtid, long gthreads) {
    conv_w(p.w_in + (size_t)layer * 1024 * 6424, 6424, (bf16_t*)(p.ws + OFF_WIN), 1024, NIN, true, gtid, gthreads, true);
    conv_w(p.w_out + (size_t)layer * 2048 * 1024, 1024, (bf16_t*)(p.ws + OFF_WOUT), 2048, 1024, false, gtid, gthreads, true);
    conv_w(p.w_mem + (size_t)layer * 1024 * 1024, 1024, (bf16_t*)(p.ws + OFF_WMEM), 1024, 1024, false, gtid, gthreads);
    conv_w(p.w1_k + (size_t)layer * 2048 * 128, 128, (bf16_t*)(p.ws + OFF_W1K), 2048, 128, false, gtid, gthreads);
    conv_w(p.w1_v + (size_t)layer * 2048 * 128, 128, (bf16_t*)(p.ws + OFF_W1V), 2048, 128, false, gtid, gthreads);
}
DI void cmp_bias(const Params& p, int layer, char* lds) {
    const int bb = blockIdx.x;
    if (bb >= 32) return;
    const int which = bb >> 4, pt = bb & 15;
    const float* pe = (which ? p.pe_v : p.pe_k) + (size_t)layer * 2048;
    const float* w1 = (which ? p.w1_v : p.w1_k) + (size_t)layer * 2048 * 128;
    float* part = (float*)(p.ws + OFF_BIAS) + (which * 16 + pt) * 128;
    const int tid = my_tid(), j = tid & 127, half = tid >> 7;
    float s0 = 0.f, s1 = 0.f, s2 = 0.f, s3 = 0.f;
    const int kb = pt * 128 + half * 64;
#pragma unroll 4
    for (int k = kb; k < kb + 64; k += 4) {
        s0 += pe[k] * w1[(size_t)k * 128 + j];
        s1 += pe[k + 1] * w1[(size_t)(k + 1) * 128 + j];
        s2 += pe[k + 2] * w1[(size_t)(k + 2) * 128 + j];
        s3 += pe[k + 3] * w1[(size_t)(k + 3) * 128 + j];
    }
    float* red = (float*)lds;
    red[tid] = (s0 + s1) + (s2 + s3);
    __syncthreads();
    if (tid < 128) part[tid] = red[tid] + red[tid + 128];
    __syncthreads();
}
DI void rms_rows(const float* __restrict__ X, const float* __restrict__ g, bf16_t* __restrict__ H, int nrows, bool blocked) {
    const int lane = my_tid() & 63, w = my_tid() >> 6;
    for (int row = blockIdx.x * 4 + w; row < nrows; row += gridDim.x * 4) {
        const float* xr = X + (size_t)row * DM;
        f32x4 v[4];
        float ss = 0.f;
#pragma unroll
        for (int j = 0; j < 4; ++j) { v[j] = *(const f32x4*)(xr + lane * 4 + 256 * j); ss += v[j].x * v[j].x + v[j].y * v[j].y + v[j].z * v[j].z + v[j].w * v[j].w; }
        ss = wave_sum(ss);
        const float rs = rsqrtf(ss * (1.f / DM) + EPS);
#pragma unroll
        for (int j = 0; j < 4; ++j) {
            const f32x4 gv = *(const f32x4*)(g + lane * 4 + 256 * j);
            u32x2 o = {pack2(v[j].x * rs * gv.x, v[j].y * rs * gv.y), pack2(v[j].z * rs * gv.z, v[j].w * rs * gv.w)};
            *(u32x2*)(H + (blocked ? kbm(row, lane * 4 + 256 * j, nrows) : (size_t)row * DM + lane * 4 + 256 * j)) = o;
        }
    }
}
DI void resid_rows(const float* __restrict__ Xold, const bf16_t* __restrict__ Y, const float* __restrict__ pg, float* __restrict__ Out,
                   const float* __restrict__ g_next, bf16_t* __restrict__ H) {
    const int lane = my_tid() & 63, w = my_tid() >> 6;
    for (int row = blockIdx.x * 4 + w; row < NTOK; row += gridDim.x * 4) {
        const bf16_t* yr = Y + (size_t)row * DM;
        const float* xr = Xold + (size_t)row * DM;
        f32x4 v[4], xv[4];
        float ss = 0.f;
#pragma unroll
        for (int j = 0; j < 4; ++j) { const u32x2 yy = *(const u32x2*)(yr + lane * 4 + 256 * j); v[j] = (f32x4){bflo(yy.x), bfhi(yy.x), bflo(yy.y), bfhi(yy.y)}; xv[j] = *(const f32x4*)(xr + lane * 4 + 256 * j); ss += v[j].x * v[j].x + v[j].y * v[j].y + v[j].z * v[j].z + v[j].w * v[j].w; }
        ss = wave_sum(ss);
        const float rs = rsqrtf(ss * (1.f / DM) + EPS);
        float s2 = 0.f;
#pragma unroll
        for (int j = 0; j < 4; ++j) {
            const f32x4 gv = *(const f32x4*)(pg + lane * 4 + 256 * j);
            xv[j].x += v[j].x * rs * gv.x; xv[j].y += v[j].y * rs * gv.y; xv[j].z += v[j].z * rs * gv.z; xv[j].w += v[j].w * rs * gv.w;
            *(f32x4*)(Out + (size_t)row * DM + lane * 4 + 256 * j) = xv[j];
            s2 += xv[j].x * xv[j].x + xv[j].y * xv[j].y + xv[j].z * xv[j].z + xv[j].w * xv[j].w;
        }
        if (g_next) {
            s2 = wave_sum(s2);
            const float r2 = rsqrtf(s2 * (1.f / DM) + EPS);
#pragma unroll
            for (int j = 0; j < 4; ++j) {
                const f32x4 gv = *(const f32x4*)(g_next + lane * 4 + 256 * j);
                u32x2 o = {pack2(xv[j].x * r2 * gv.x, xv[j].y * r2 * gv.y), pack2(xv[j].z * r2 * gv.z, xv[j].w * r2 * gv.w)};
                *(u32x2*)(H + kbm(row, lane * 4 + 256 * j, NTOK)) = o;
            }
        }
    }
}
DI void rope_table(const Params& p, long gtid, long gthreads) {
    f32x2* tab = (f32x2*)(p.ws + OFF_ROPE);
    for (long idx = gtid; idx < (long)SEQ * 32; idx += gthreads) {
        const int s = (int)(idx >> 5), i = (int)(idx & 31);
        const float invf = (float)(1.0 / pow(10000.0, (double)i / 31.0));
        const float ang = (float)s * invf;
        const double a = (double)ang;
        const double k = rint(a * 0.15915494309189535);
        const float rr = (float)(a - k * 6.283185307179586);
        f32x2 cs = {cosf(rr), sinf(rr)};
        tab[idx] = cs;
    }
}

#define XB_TMO      128
#define XB_XCNT(j)  (256  + 64 * (j))
#define XB_XSUB(j)  (1280 + 64 * (j))
#define XB_XGEN(j)  (2304 + 64 * (j))
#define XB_TOP      3328
#define XB_TOPGEN   3392
#define XCD_BAR_WORDS 3456
#define XB_SPIN_CAP (1u << 18)
#define LAS __attribute__((address_space(3)))
DI unsigned xb_ld(unsigned* p) { return __hip_atomic_load(p, __ATOMIC_RELAXED, __HIP_MEMORY_SCOPE_AGENT); }
DI unsigned xb_add(unsigned* p, unsigned v) { return __hip_atomic_fetch_add(p, v, __ATOMIC_RELAXED, __HIP_MEMORY_SCOPE_AGENT); }
DI unsigned xb_xcc_id() { return (unsigned)__builtin_amdgcn_s_getreg((3 << 11) | 20) & 0xFu; }
#define XB_SPIN(cond, bar) do { unsigned _sp = 0; while (cond) { __builtin_amdgcn_s_sleep(1); \
    if ((++_sp & 255u) == 0u) { if (xb_ld(&(bar)[XB_TMO])) break; if (_sp > XB_SPIN_CAP) { atomicAdd(&(bar)[XB_TMO], 1u); break; } } } } while (0)
struct XcdBarrier { unsigned* bar; unsigned x; volatile LAS unsigned* st; };
DI XcdBarrier xcd_barrier_post(unsigned* bar, volatile LAS unsigned* st) {
    XcdBarrier b; b.bar = bar; b.x = xb_xcc_id(); b.st = st;
    if (threadIdx.x == 0) (void)xb_add(&bar[XB_XCNT(b.x)], 1u);
    return b;
}
DI void xcd_barrier_complete(unsigned* bar, unsigned x, unsigned& nloc, unsigned& nx) {
    const unsigned G = gridDim.x * gridDim.y * gridDim.z;
    unsigned sum, cnt, mine, sp = 0u;
    for (;;) {
        sum = 0u; cnt = 0u; mine = 0u;
#pragma unroll
        for (unsigned j = 0; j < 16; ++j) { const unsigned c = xb_ld(&bar[XB_XCNT(j)]); sum += c; cnt += (c > 0u) ? 1u : 0u; mine = (j == x) ? c : mine; }
        if (sum == G) break;
        __builtin_amdgcn_s_sleep(1);
        if ((++sp & 255u) == 0u) { if (xb_ld(&bar[XB_TMO])) break; if (sp > XB_SPIN_CAP) { atomicAdd(&bar[XB_TMO], 1u); break; } }
    }
    nloc = mine > 0u ? mine : 1u; nx = cnt > 0u ? cnt : 1u;
}
DI void xcd_barrier(const XcdBarrier& b) {
    asm volatile("s_waitcnt vmcnt(0)" ::: "memory");
    __syncthreads();
    if (threadIdx.x == 0) {
        unsigned* bar = b.bar;
        __builtin_amdgcn_s_waitcnt(0);
        unsigned nloc = b.st[0], nx = b.st[1];
        if (nloc == 0u) { xcd_barrier_complete(bar, b.x, nloc, nx); b.st[0] = nloc; b.st[1] = nx; }
        const unsigned old = xb_add(&bar[XB_XSUB(b.x)], 1u);
        const unsigned gen = old / nloc;
        if (old + 1u == (gen + 1u) * nloc) {
            __builtin_amdgcn_fence(__ATOMIC_RELEASE, "agent");
            asm volatile("s_waitcnt vmcnt(0)" ::: "memory");
            const unsigned og = xb_add(&bar[XB_TOP], 1u);
            const unsigned tg = og / nx;
            if (og + 1u == (tg + 1u) * nx) xb_add(&bar[XB_TOPGEN], 1u);
            else XB_SPIN(xb_ld(&bar[XB_TOPGEN]) == tg, bar);
            __builtin_amdgcn_fence(__ATOMIC_ACQUIRE, "agent");
            xb_add(&bar[XB_XGEN(b.x)], 1u);
            asm volatile("s_waitcnt vmcnt(0)" ::: "memory");
        } else {
            XB_SPIN(xb_ld(&bar[XB_XGEN(b.x)]) == gen, bar);
            __builtin_amdgcn_fence(__ATOMIC_ACQUIRE, "agent");
            asm volatile("s_waitcnt vmcnt(0)" ::: "memory");
        }
    }
    __syncthreads();
}

__global__ __launch_bounds__(256, 2) void mega(Params p) {
    __shared__ __attribute__((aligned(16))) char lds[LDS_BYTES];
    __shared__ int s_item;
    __shared__ float s_bias[128];
    cg::grid_group grid = cg::this_grid();
    __shared__ uint4 xb_words;
    if (threadIdx.x == 0) xb_words = make_uint4(0u, 0u, 0u, 0u);
    __syncthreads();
    const XcdBarrier xb = xcd_barrier_post((unsigned*)(p.ws + OFF_BAR), (volatile LAS unsigned*)&xb_words);
#define GTID ((long)blockIdx.x * 256 + my_tid())
#define GTHREADS ((long)gridDim.x * 256)
    bf16_t* hbuf = (bf16_t*)(p.ws + OFF_H);
    unsigned* ctr = (unsigned*)(p.ws + OFF_CTR);

    if (GTID < 256) ctr[GTID] = 0u;
    for (int r0 = 0; r0 < REP0; ++r0) {
#ifndef SKIP_CONV
    conv_layer_weights(p, 0, GTID, GTHREADS);
#endif
    rope_table(p, GTID, GTHREADS);
#ifndef SKIP_BIAS
    cmp_bias(p, 0, lds);
#endif
    rms_rows(p.x, p.pre_g, hbuf, NTOK, true);
    rms_rows(p.mem, p.mem_g, (bf16_t*)(p.ws + OFF_MEMN), 2048, false);
    if (p.ws == nullptr) grid.sync();
    xcd_barrier(xb);
    }

#ifdef EXTRA_SYNCS
    for (int es = 0; es < EXTRA_SYNCS; ++es) grid.sync();
#endif
#pragma unroll 1
    for (int layer = 0; layer < 2; ++layer) {
        for (int r123 = 0; r123 < REP123; ++r123) {
        for (int r1 = 0; r1 < REP1; ++r1) {
#ifndef SKIP_P1
        {
            const bf16_t* winT = (const bf16_t*)(p.ws + OFF_WIN);
            const f32x2* rope = (const f32x2*)(p.ws + OFF_ROPE);
            const int xcd = blockIdx.x & 7, li = blockIdx.x >> 3, nb = (gridDim.x + 7 - xcd) >> 3;
#pragma unroll 1
            for (int q = li; q < 832; q += nb) {
                const int q1 = q / 208, q2 = q - q1 * 208;
                int nt, ml;
                if (q2 < 192) { const int ng = q2 >> 6, in = q2 & 63; nt = 8 * ng + (in & 7); ml = in >> 3; }
                else { const int q3 = q2 - 192; nt = 24 + (q3 & 1); ml = q3 >> 1; }
                const int mt = 32 * xcd + 8 * q1 + ml;
                const bf16_t* A = hbuf + (size_t)mt * 128 * 32;
                const bf16_t* Bt = winT + (size_t)nt * 256 * 32;
                if (nt >= 12 && nt < 17) {
                    EpiVT e{(bf16_t*)(p.ws + OFF_VT), NVT, SEQ, mt * 128, nt * 256 - 3072};
                    gemm_wide<false>(lds, A, ARowLin{32}, Bt, 32, 16, e, (long)NTOK * 32, (long)NIN * 32);
                } else {
                    EpiRow e;
                    e.rope = rope; e.row0 = mt * 128;
                    if (nt < 12) { e.dst = (bf16_t*)(p.ws + OFF_BUFA); e.ld = NA; e.col0 = nt * 256; e.mode = (nt == 8) ? EM_ROPEQ : ((nt == 9) ? EM_ROPEK : EM_PLAIN); e.rkt = (nt == 9) ? (bf16_t*)(p.ws + OFF_RKT) : nullptr; }
                    else if (nt < 25) { e.dst = (bf16_t*)(p.ws + OFF_BUFZ); e.ld = NZ; e.col0 = (nt - 17) * 256; e.mode = EM_SILU; e.zblk = true; }
                    else { e.dst = (bf16_t*)(p.ws + OFF_BUFA); e.ld = NA; e.col0 = CA_GATE; e.mode = EM_GATE; }
                    gemm_wide<true>(lds, A, ARowLin{32}, Bt, 32, 16, e, (long)NTOK * 32, (long)NIN * 32);
                }
            }
        }
#endif
        xcd_barrier(xb);
        }
        for (int r2 = 0; r2 < REP2; ++r2) {
#ifndef SKIP_P2
        {
            const bf16_t* bufA = (const bf16_t*)(p.ws + OFF_BUFA);
            float* kmean = (float*)(p.ws + OFF_KMEAN);
            const int n_km = 8 * 16 * 4, n_cmp = 256, n_mem = 16 * 4, n_u = 8 * 4 * 32;
#pragma unroll 1
            for (int t = blockIdx.x; t < n_cmp + n_km + n_mem + n_u; t += gridDim.x) {
                if (t >= n_cmp + n_km + n_mem) {
                    const int u = t - (n_cmp + n_km + n_mem), c = u & 31, bh = u >> 5, b = bh >> 2, hh = bh & 3;
                    const int tid = my_tid(), lane = tid & 63, w = tid >> 6, r = lane & 31, h = lane >> 5;
                    const bf16_t* vtp = (const bf16_t*)(p.ws + OFF_VT) + ((size_t)b * NVT + CV_RV + hh * 128 + 32 * w + r) * SEQ + c * 128 + 8 * h;
                    const bf16_t* ktp = (const bf16_t*)(p.ws + OFF_RKT) + ((size_t)(b * 4 + hh) * 64 + r) * SEQ + c * 128 + 8 * h;
                    f32x16 u0 = zero16(), u1 = zero16();
#pragma unroll
                    for (int kk = 0; kk < 8; ++kk) {
                        const bf16x8 xf = *(const bf16x8*)(vtp + 16 * kk);
                        const bf16x8 y0 = *(const bf16x8*)(ktp + 16 * kk), y1 = *(const bf16x8*)(ktp + (size_t)32 * SEQ + 16 * kk);
                        u0 = MFMA(xf, y0, u0); u1 = MFMA(xf, y1, u1);
                    }
                    bf16_t* up = (bf16_t*)(p.ws + OFF_U) + (size_t)u * 8192;
#pragma unroll
                    for (int i = 0; i < 16; ++i) {
                        up[(32 * w + crow(i, h)) * 64 + r] = (bf16_t)(pack2(u0[i], 0.f) & 0xffffu);
                        up[(32 * w + crow(i, h)) * 64 + 32 + r] = (bf16_t)(pack2(u1[i], 0.f) & 0xffffu);
                    }
                } else if (t >= n_cmp + n_km) {
                    const int u = t - n_cmp - n_km, mt = u >> 2, nt = u & 3;
                    const bf16_t* A = (const bf16_t*)(p.ws + OFF_MEMN) + (size_t)mt * 128 * 1024;
                    const bf16_t* Bt = (const bf16_t*)(p.ws + OFF_WMEM) + (size_t)nt * 256 * 1024;
                    if (nt >= 2) {
                        EpiVT e{(bf16_t*)(p.ws + OFF_MEMV), 512, 256, mt * 128, nt * 256 - 512};
                        gemm_wide<false>(lds, A, ARowLin{1024}, Bt, 1024, 16, e);
                    } else {
                        EpiRow e; e.rope = nullptr; e.row0 = mt * 128; e.dst = (bf16_t*)(p.ws + OFF_MEMK); e.ld = 512; e.col0 = nt * 256; e.mode = EM_PLAIN;
                        gemm_wide<true>(lds, A, ARowLin{1024}, Bt, 1024, 16, e);
                    }
                } else if (t < n_cmp) {
                    const int tileid = t >> 2, split = t & 3, isv = tileid >> 5, mt = tileid & 31;
                    float* cpart = (float*)(p.ws + OFF_CPART) + (size_t)tileid * 4 * 64 * 256;
                    {
                        EpiPart ep{cpart + (size_t)split * 64 * 256};
                        gemm_tile<true>(lds, bufA + (size_t)split * 8 * NA, ARowCmp{mt * 128, isv ? CA_NVC : CA_NKC}, NA,
                                        (const bf16_t*)(p.ws + (isv ? OFF_W1V : OFF_W1K)) + split * 512, 2048, 8, ep);
                    }
                    __threadfence();
                    __syncthreads();
                    if (my_tid() == 0) s_item = (int)atomicAdd(ctr + 64 + layer * 64 + tileid, 1u);
                    __syncthreads();
                    const bool last = (s_item == 3);
                    __syncthreads();
                    if (!last) continue;
                    __threadfence();
                    float* lbias = s_bias;
                    if (my_tid() < 128) {
                        const float* part = (const float*)(p.ws + OFF_BIAS) + isv * 16 * 128 + my_tid();
                        float bsum = 0.f;
#pragma unroll
                        for (int q = 0; q < 16; ++q) bsum += part[q * 128];
                        lbias[my_tid()] = bsum;
                    }
                    __syncthreads();
                    {
                        const int tid2 = my_tid(), row = tid2 >> 1, c0 = (tid2 & 1) * 64;
                        const float* pp = cpart + row * 128 + c0;
#pragma unroll 4
                        for (int cg = 0; cg < 16; ++cg) {
                            const f32x4 a0 = *(const f32x4*)(pp + cg * 4), a1 = *(const f32x4*)(pp + 16384 + cg * 4);
                            const f32x4 a2 = *(const f32x4*)(pp + 2 * 16384 + cg * 4), a3 = *(const f32x4*)(pp + 3 * 16384 + cg * 4);
                            const f32x4 sm = ((a0 + a1) + a2) + a3;
                            const f32x4 bv = *(const f32x4*)(lbias + c0 + cg * 4);
                            u32x2 o = {pack2(silu_f(sm.x + bv.x), silu_f(sm.y + bv.y)), pack2(silu_f(sm.z + bv.z), silu_f(sm.w + bv.w))};
                            *(u32x2*)(lds + row * HSTR + (c0 + cg * 4) * 2) = o;
                        }
                    }
                    __syncthreads();
                    const float* w2 = (isv ? p.w2_v : p.w2_k) + (size_t)layer * 128 * 64;
                    const int tid = my_tid(); const int c = tid & 63, rg = tid >> 6;
                    float* w2s = (float*)(lds + 36864);
#pragma unroll
                    for (int q = 0; q < 8; ++q) *(f32x4*)(w2s + (q * 256 + tid) * 4) = *(const f32x4*)(w2 + (q * 256 + tid) * 4);
                    __syncthreads();
                    float a32[32];
#pragma unroll
                    for (int rr = 0; rr < 32; ++rr) a32[rr] = 0.f;
#pragma unroll 2
                    for (int k = 0; k < 128; k += 2) {
                        const float w0 = w2s[k * 64 + c], w1 = w2s[(k + 1) * 64 + c];
#pragma unroll
                        for (int rr = 0; rr < 32; ++rr) {
                            const unsigned u = *(const unsigned*)(lds + (rg * 32 + rr) * HSTR + k * 2);
                            a32[rr] += bflo(u) * w0 + bfhi(u) * w1;
                        }
                    }
                    bf16_t* kcb = (bf16_t*)(p.ws + OFF_KC);
                    bf16_t* vcb = (bf16_t*)(p.ws + OFF_VCT);
#pragma unroll
                    for (int rr = 0; rr < 32; ++rr) {
                        const int R = mt * 128 + rg * 32 + rr, bg = R >> 8, i = R & 255;
                        const bf16_t val = (bf16_t)(pack2(a32[rr], 0.f) & 0xffffu);
                        if (isv) vcb[((size_t)bg * 64 + c) * 256 + i] = val; else kcb[((size_t)bg * 256 + i) * 64 + c] = val;
                    }
                    __syncthreads();
                } else {
                    const int u = t - n_cmp, qd = u & 3, n = (u >> 2) & 15, b = u >> 6;
                    const int tid = my_tid(); const int cp = tid & 63, kg = tid >> 6;
                    const bf16_t* src = bufA + (size_t)(b * SEQ + n * 256 + kg * 64) * NA + CA_MK + qd * 128 + 2 * cp;
                    float s0 = 0.f, s1 = 0.f;
                    for (int k = 0; k < 64; ++k) { const unsigned uu = *(const unsigned*)(src + (size_t)k * NA); s0 += bflo(uu); s1 += bfhi(uu); }
                    float* red = (float*)lds;
                    red[kg * 128 + 2 * cp] = s0; red[kg * 128 + 2 * cp + 1] = s1;
                    __syncthreads();
                    if (tid < 128) {
                        const float sum = red[tid] + red[128 + tid] + red[256 + tid] + red[384 + tid];
                        const int hh = qd * 2 + (tid >> 6), d = tid & 63;
                        kmean[((size_t)(b * 8 + hh) * 16 + n) * 64 + d] = sum * (1.f / 256.f);
                    }
                    __syncthreads();
                }
            }
        }
#endif
        xcd_barrier(xb);
        }
#ifndef SKIP_P3
        {
            int qsel = blockIdx.x & 7, qtried = 0;
#pragma unroll 1
            while (true) {
                if (my_tid() == 0) s_item = (int)atomicAdd(ctr + layer * 32 + r123 * 16 + qsel, 1u);
                __syncthreads();
                const int id = s_item;
                __syncthreads();
                if (id >= 768) { if (++qtried >= 8) break; qsel = (qsel + 1) & 7; continue; }
                const int b = qsel;
                if (id < 256) {
#ifndef SKIP_NSA
                    for (int rp = 0; rp < REP_NSA; ++rp) nsa_item(p, lds, b, id >> 7, 127 - (id & 127), rp == REP_NSA - 1);
#endif
                } else if (id < 512) {
#ifndef SKIP_MOBA
                    const int u = id - 256; for (int rp = 0; rp < REP_MOBA; ++rp) moba_item(p, lds, b, u >> 5, 31 - (u & 31), rp == REP_MOBA - 1);
#endif
                } else if (id < 640) {
#ifndef SKIP_RET
                    const int u = id - 512; for (int rp = 0; rp < REP_RET; ++rp) ret_item(p, lds, layer, b, u >> 5, 31 - (u & 31), rp == REP_RET - 1);
#endif
                } else {
#ifndef SKIP_MEM
                    const int u = id - 640; for (int rp = 0; rp < REP_MEM; ++rp) mem_item(p, lds, b, u >> 5, u & 31, rp == REP_MEM - 1);
#endif
                }
            }
        }
#endif
        xcd_barrier(xb);
        }
        for (int r4 = 0; r4 < REP4; ++r4) {
#ifndef SKIP_P4
        {
            const bf16_t* bufZ = (const bf16_t*)(p.ws + OFF_BUFZ);
            const bf16_t* woT = (const bf16_t*)(p.ws + OFF_WOUT);
            const int xcd = blockIdx.x & 7, li = blockIdx.x >> 3, nb = (gridDim.x + 7 - xcd) >> 3;
#pragma unroll 1
            for (int q = li; q < 128; q += nb) {
                const int mt = 32 * xcd + (q >> 2), nt = q & 3;
                EpiY e{(bf16_t*)(p.ws + OFF_Y), mt * 128, nt * 256};
                gemm_wide<true>(lds, bufZ + (size_t)mt * 128 * 32, ARowLin{32}, woT + (size_t)nt * 256 * 32, 32, 32, e, (long)NTOK * 32, (long)1024 * 32);
            }
        }
#endif
        xcd_barrier(xb);
        }
        {
            const float* xold = layer == 0 ? p.x : p.out;
            resid_rows(xold, (const bf16_t*)(p.ws + OFF_Y), p.post_g + layer * DM, p.out, layer == 0 ? p.pre_g + DM : nullptr, hbuf);
            if (layer == 0) {
                conv_layer_weights(p, 1, GTID, GTHREADS);
                cmp_bias(p, 1, lds);
                rms_rows(p.mem, p.mem_g + DM, (bf16_t*)(p.ws + OFF_MEMN), 2048, false);
                xcd_barrier(xb);
            }
        }
    }
}

extern "C" void kernel_launch(void* const* d_in, const int* in_sizes, int n_in, void* d_out, int out_size, void* d_ws, size_t ws_size, hipStream_t stream) {
    static int grid_blocks = 0;
    if (!grid_blocks) {
        int dev = 0, cus = 0, per_cu = 0;
        hipGetDevice(&dev);
        hipDeviceGetAttribute(&cus, hipDeviceAttributeMultiprocessorCount, dev);
        hipOccupancyMaxActiveBlocksPerMultiprocessor(&per_cu, mega, 256, 0);
        if (per_cu < 1) per_cu = 1;
        if (per_cu > 2) per_cu = 2;
#ifdef FORCE_PER_CU
        per_cu = FORCE_PER_CU;
#endif
        grid_blocks = cus * per_cu;
    }
    if (ws_size < WS_NEED) fprintf(stderr, "workspace too small: %zu < %zu\n", ws_size, (size_t)WS_NEED);
    Params p{};
    p.x = (const float*)d_in[0]; p.mem = (const float*)d_in[1]; p.pre_g = (const float*)d_in[2]; p.post_g = (const float*)d_in[3];
    p.mem_g = (const float*)d_in[4]; p.w_in = (const float*)d_in[5]; p.w_mem = (const float*)d_in[6]; p.pe_k = (const float*)d_in[7];
    p.w1_k = (const float*)d_in[8]; p.w2_k = (const float*)d_in[9]; p.pe_v = (const float*)d_in[10]; p.w1_v = (const float*)d_in[11];
    p.w2_v = (const float*)d_in[12]; p.gn_g = (const float*)d_in[13]; p.w_out = (const float*)d_in[14];
    p.out = (float*)d_out; p.ws = (char*)d_ws;
    (void)hipMemsetAsync((char*)d_ws + OFF_BAR, 0, XCD_BAR_WORDS * 4, stream);
    void* args[] = {&p};
    hipError_t e = hipLaunchCooperativeKernel((void*)mega, dim3(grid_blocks), dim3(256), args, 0, stream);
    if (e != hipSuccess) fprintf(stderr, "cooperative launch failed: %s (grid %d)\n", hipGetErrorString(e), grid_blocks);
}
```
